# Optimizing an MI355X kernel written in HIP

```python
import math
import jax, jax.numpy as jnp
from jax import lax
import numpy as np

D_MODEL = 1024
BATCH = 8
SEQ = 2048
DEPTH = 1

CONV_WIDTH = D_MODEL
CONV_K = 3
N_HEADS = 8
HEAD_DIM = D_MODEL // (2 * N_HEADS)
V_DIM = 2 * HEAD_DIM
ATTN_QK = N_HEADS * 2 * HEAD_DIM
ATTN_V = N_HEADS * V_DIM
ROT_DIM = HEAD_DIM // 4
ROPE_THETA = 500000.0
Q_BLOCK = 128
N_KEYS = 128
N_EXPERTS = N_KEYS * N_KEYS
PK_HEADS = 8
PK_DIM = 256
PK_HALF = PK_DIM // 2
PK_TOPK = 16
PEER_CHUNK = 128
ALPHA = (2 * DEPTH) ** 0.25
BETA = (8 * DEPTH) ** -0.25
LN_EPS = 1e-5
IN_WIDTHS = (CONV_WIDTH, CONV_WIDTH, CONV_WIDTH, ATTN_QK, ATTN_QK, ATTN_V, 2 * D_MODEL)

kernel_name = "hybrid_conv_diffattn_peer_deepnorm"


def _layernorm(x, g, b):
    xf = x.astype(jnp.float32)
    mu = jnp.mean(xf, axis=-1, keepdims=True)
    var = jnp.mean(jnp.square(xf - mu), axis=-1, keepdims=True)
    y = (xf - mu) * lax.rsqrt(var + LN_EPS) * g.astype(jnp.float32) + b.astype(jnp.float32)
    return y.astype(x.dtype)


def _rmsnorm(x, g):
    xf = x.astype(jnp.float32)
    y = xf * lax.rsqrt(jnp.mean(jnp.square(xf), axis=-1, keepdims=True) + LN_EPS)
    return y * g.astype(jnp.float32)


def _partial_rope(t, cos, sin):
    half = ROT_DIM // 2
    c = cos[:, :, None, None, :]
    s = sin[:, :, None, None, :]
    r1 = t[..., :half].astype(jnp.float32)
    r2 = t[..., half:ROT_DIM].astype(jnp.float32)
    rot = jnp.concatenate([r1 * c - r2 * s, r2 * c + r1 * s], axis=-1).astype(t.dtype)
    return jnp.concatenate([rot, t[..., ROT_DIM:]], axis=-1)


def _short_conv_mixer(h, b_gate, c_gate, conv_w, conv_b):
    z = c_gate * h
    seq = z.shape[1]
    zp = jnp.pad(z, ((0, 0), (CONV_K - 1, 0), (0, 0)))
    y = conv_b + sum(conv_w[j] * zp[:, j:j + seq] for j in range(CONV_K))
    return b_gate * y


def _diff_attention(q, k, v, lam):
    bsz, seq = q.shape[0], q.shape[1]
    nblk = seq // Q_BLOCK
    scale = HEAD_DIM ** -0.5
    kf = k.astype(jnp.float32)
    vf = v.astype(jnp.float32)
    qb = q.reshape(bsz, nblk, Q_BLOCK, N_HEADS, 2, HEAD_DIM).transpose(1, 0, 2, 3, 4, 5)
    kpos = jnp.arange(seq)

    def block(args):
        q_blk, start = args
        s = jnp.einsum('bqhcd,bkhcd->bhcqk', q_blk.astype(jnp.float32), kf) * scale
        qpos = start + jnp.arange(Q_BLOCK)
        mask = kpos[None, :] <= qpos[:, None]
        s = jnp.where(mask, s, -jnp.inf)
        p = jax.nn.softmax(s, axis=-1)
        a = p[:, :, 0] - lam * p[:, :, 1]
        return jnp.einsum('bhqk,bkhe->bqhe', a, vf)

    out = lax.map(block, (qb, jnp.arange(nblk) * Q_BLOCK))
    return out.transpose(1, 0, 2, 3, 4).reshape(bsz, seq, N_HEADS, V_DIM)


def _peer(x, w_pq, sub_keys, u_tab, v_tab):
    bsz, seq, dm = x.shape
    xt = x.reshape(-1, PEER_CHUNK, dm)

    def chunk(xc):
        q = (xc @ w_pq).reshape(PEER_CHUNK, PK_HEADS, 2, PK_HALF)
        s = jnp.einsum('thcd,hcnd->thcn', q.astype(jnp.float32), sub_keys.astype(jnp.float32))
        s1, i1 = lax.top_k(s[:, :, 0], PK_TOPK)
        s2, i2 = lax.top_k(s[:, :, 1], PK_TOPK)
        cand = (s1[..., :, None] + s2[..., None, :]).reshape(PEER_CHUNK, PK_HEADS, PK_TOPK * PK_TOPK)
        top_s, top_i = lax.top_k(cand, PK_TOPK)
        e_idx = (jnp.take_along_axis(i1, top_i // PK_TOPK, axis=-1) * N_KEYS
                 + jnp.take_along_axis(i2, top_i % PK_TOPK, axis=-1))
        g = jax.nn.softmax(top_s, axis=-1)
        u_sel = u_tab[e_idx]
        v_sel = v_tab[e_idx]
        act = jax.nn.gelu(jnp.einsum('thkd,td->thk', u_sel, xc).astype(jnp.float32), approximate=False)
        w = (g * act).astype(xc.dtype)
        return jnp.einsum('thk,thkd->td', w, v_sel)

    return lax.map(chunk, xt).reshape(bsz, seq, dm)


def setup_inputs(seed: int = 0) -> dict:
    key = jax.random.key(seed)
    ks = jax.random.split(key, 24)
    f32 = jnp.float32
    D = D_MODEL
    sd = D ** -0.5
    nrm = lambda k, shape, s: jax.random.normal(k, shape, f32) * s
    x = jax.random.normal(ks[0], (BATCH, SEQ, D), f32)
    offs = jax.random.randint(ks[1], (BATCH, 1), 0, 4096, dtype=jnp.int32)
    positions = offs + jnp.arange(SEQ, dtype=jnp.int32)[None, :]
    w_in = jnp.concatenate([
        nrm(ks[2], (DEPTH, D, 3 * CONV_WIDTH + 2 * ATTN_QK), sd),
        nrm(ks[3], (DEPTH, D, ATTN_V), sd * BETA),
        nrm(ks[4], (DEPTH, D, 2 * D), sd)], axis=-1)
    return {
        "x": x,
        "positions": positions,
        "w_in": w_in,
        "conv_w": nrm(ks[5], (DEPTH, CONV_K, CONV_WIDTH), CONV_K ** -0.5),
        "conv_b": nrm(ks[6], (DEPTH, CONV_WIDTH), 0.02),
        "gate_b": nrm(ks[7], (DEPTH, 2 * D), 0.1),
        "lambda_q1": nrm(ks[8], (DEPTH, HEAD_DIM), 0.1),
        "lambda_k1": nrm(ks[9], (DEPTH, HEAD_DIM), 0.1),
        "lambda_q2": nrm(ks[10], (DEPTH, HEAD_DIM), 0.1),
        "lambda_k2": nrm(ks[11], (DEPTH, HEAD_DIM), 0.1),
        "subln_g": 1.0 + nrm(ks[12], (DEPTH, V_DIM), 0.02),
        "w_conv_out": nrm(ks[13], (DEPTH, CONV_WIDTH, D), CONV_WIDTH ** -0.5),
        "w_attn_out": nrm(ks[14], (DEPTH, ATTN_V, D), ATTN_V ** -0.5),
        "w_o": nrm(ks[15], (DEPTH, D, D), sd * BETA),
        "ln1_g": 1.0 + nrm(ks[16], (DEPTH, D), 0.02),
        "ln1_b": nrm(ks[17], (DEPTH, D), 0.02),
        "w_pq": nrm(ks[18], (DEPTH, D, PK_HEADS * PK_DIM), sd),
        "sub_keys": nrm(ks[19], (DEPTH, PK_HEADS, 2, N_KEYS, PK_HALF), PK_HALF ** -0.5),
        "u_tab": nrm(ks[20], (DEPTH, N_EXPERTS, D), sd),
        "v_tab": nrm(ks[21], (DEPTH, N_EXPERTS, D), BETA),
        "ln2_g": 1.0 + nrm(ks[22], (DEPTH, D), 0.02),
        "ln2_b": nrm(ks[23], (DEPTH, D), 0.02),
    }


def reference(x, positions, w_in, conv_w, conv_b, gate_b, lambda_q1, lambda_k1, lambda_q2, lambda_k2,
              subln_g, w_conv_out, w_attn_out, w_o, ln1_g, ln1_b, w_pq, sub_keys, u_tab, v_tab,
              ln2_g, ln2_b):
    bsz, seq, _ = x.shape
    split_points = np.cumsum(IN_WIDTHS)[:-1].tolist()
    inv_freq = ROPE_THETA ** (-jnp.arange(0, ROT_DIM, 2, dtype=jnp.float32) / ROT_DIM)
    ang = positions.astype(jnp.float32)[..., None] * inv_freq
    cos, sin = jnp.cos(ang), jnp.sin(ang)
    for l in range(DEPTH):
        proj = x @ w_in[l]
        h, bg, cg, q, k, v, gates = jnp.split(proj, split_points, axis=-1)
        y_conv = _short_conv_mixer(h, bg, cg, conv_w[l], conv_b[l])
        q = _partial_rope(q.reshape(bsz, seq, N_HEADS, 2, HEAD_DIM), cos, sin)
        k = _partial_rope(k.reshape(bsz, seq, N_HEADS, 2, HEAD_DIM), cos, sin)
        lam_init = 0.8 - 0.6 * math.exp(-0.3 * l)
        lam = (jnp.exp(jnp.sum(lambda_q1[l].astype(jnp.float32) * lambda_k1[l].astype(jnp.float32)))
               - jnp.exp(jnp.sum(lambda_q2[l].astype(jnp.float32) * lambda_k2[l].astype(jnp.float32)))
               + lam_init)
        o = _diff_attention(q, k, v.reshape(bsz, seq, N_HEADS, V_DIM), lam)
        o = _rmsnorm(o, subln_g[l]) * (1.0 - lam_init)
        y_attn = o.reshape(bsz, seq, ATTN_V).astype(x.dtype)
        g = jax.nn.sigmoid(gates + gate_b[l])
        g_conv, g_attn = g[..., :D_MODEL], g[..., D_MODEL:]
        merged = g_conv * (y_conv @ w_conv_out[l]) + g_attn * (y_attn @ w_attn_out[l])
        x = _layernorm(ALPHA * x + merged @ w_o[l], ln1_g[l], ln1_b[l])
        x = _layernorm(ALPHA * x + _peer(x, w_pq[l], sub_keys[l], u_tab[l], v_tab[l]), ln2_g[l], ln2_b[l])
    return x
```

```cpp
#include <hip/hip_runtime.h>
#include <hip/hip_cooperative_groups.h>
#include <cstdio>
#include <cstdint>
namespace cg = cooperative_groups;
namespace pg8 {
#define PG8_LAS __attribute__((address_space(3)))
typedef unsigned short bf16_t;
typedef short bf16x8 __attribute__((ext_vector_type(8)));
typedef float f32x4 __attribute__((ext_vector_type(4)));
typedef unsigned u32x4 __attribute__((ext_vector_type(4)));
constexpr int BM = 256, BK = 64, HALF = 128, HTB = HALF * BK * 2  , STAGE_BYTES = 8 * HTB, NXCD = 8, WGM = 8;

__host__ __device__ __forceinline__ int lds_byte(int r, int c) { const int st = (r >> 4) * 2 + (c >> 5), rr = r & 15, cc = c & 31, ob = rr * 64 + cc * 2; return st * 1024 + (ob ^ (((ob >> 9) & 1) << 5)); }
__host__ __device__ __forceinline__ void stage_rc(int b, int& R, int& C) { const int st = b / 1024, sb = b % 1024, swz = sb ^ (((sb >> 9) & 1) << 5); R = (st >> 1) * 16 + swz / 64; C = (st & 1) * 32 + (swz % 64) / 2; }
__host__ __device__ __forceinline__ int perm32(int rho) { const int n = rho >> 4, i = rho & 15; return 8 * (i >> 2) + 4 * n + (i & 3); }

struct Unit { int pm, pn; };
struct Gemm { const bf16_t* A; const bf16_t* Bt; int M, N, K; };

struct StaticOrder {
    int nM, nN, nwg, G, c;
    __host__ __device__ void init(int M, int N, int G_, int c_) { nM = M / BM; nN = N / BM; nwg = nM * nN; G = G_; c = c_; }
    __host__ __device__ bool next(int i, Unit& u) const {
        const long L = (long)i * G + c; if (L >= nwg) return false;
        int wgid = (int)L; { const int q = nwg / NXCD, r = nwg % NXCD, xcd = wgid % NXCD, off = wgid / NXCD; wgid = (xcd < r ? xcd * (q + 1) : r * (q + 1) + (xcd - r) * q) + off; }
        const int nig = WGM * nN, gid = wgid / nig, fm = gid * WGM, gsz = (nM - fm) < WGM ? (nM - fm) : WGM;
        u.pm = fm + ((wgid % nig) % gsz); u.pn = (wgid % nig) / gsz; return true;
    }
    __device__ __forceinline__ void a_ready(const Unit&) const {}
    __device__ __forceinline__ void done(const Unit&) const {}
};


__device__ __forceinline__ unsigned cvt_pk_bf16(float lo, float hi) { unsigned r; asm volatile("v_cvt_pk_bf16_f32 %0, %1, %2" : "=v"(r) : "v"(lo), "v"(hi)); return r; }
__device__ __forceinline__ void store8(bf16_t* p, f32x4 v0, f32x4 v1) {
    u32x4 w; w.x = cvt_pk_bf16(v0[0], v0[1]); w.y = cvt_pk_bf16(v0[2], v0[3]); w.z = cvt_pk_bf16(v1[0], v1[1]); w.w = cvt_pk_bf16(v1[2], v1[3]);
    *(u32x4*)p = w;
}
__device__ __forceinline__ void load8(const bf16_t* p, f32x4& v0, f32x4& v1) {
    const u32x4 w = *(const u32x4*)p;
    v0[0] = __uint_as_float(w.x << 16); v0[1] = __uint_as_float(w.x & 0xffff0000u); v0[2] = __uint_as_float(w.y << 16); v0[3] = __uint_as_float(w.y & 0xffff0000u);
    v1[0] = __uint_as_float(w.z << 16); v1[1] = __uint_as_float(w.z & 0xffff0000u); v1[2] = __uint_as_float(w.w << 16); v1[3] = __uint_as_float(w.w & 0xffff0000u);
}
constexpr float QSCALE = 0.125f * 1.4426950408889634f;

struct EpiProj {
    static constexpr bool PERM = true, AFTER_DRAIN = false;
    bf16_t *Z, *BG, *Q, *Kk, *V, *G; const float* gate_b; const float* CS;
    __device__ __forceinline__ void operator()(const f32x4 (&acc)[2][2][4][2], const Unit& u, int wr, int wc, int fr, int fq) const {
        const int row0 = u.pm * BM + wr * 64 + fr, pn = u.pn, cw = wc * 32 + 8 * fq;
        if (pn < 8) {
#pragma unroll
            for (int ai = 0; ai < 2; ++ai)
#pragma unroll
                for (int m = 0; m < 4; ++m) { const size_t row = row0 + ai * HALF + m * 16;
                    store8(Z + row * 1024 + pn * 128 + cw, acc[ai][0][m][0] * acc[ai][1][m][0], acc[ai][0][m][1] * acc[ai][1][m][1]); }
        } else if (pn < 12) {
#pragma unroll
            for (int ai = 0; ai < 2; ++ai)
#pragma unroll
                for (int m = 0; m < 4; ++m) { const size_t row = row0 + ai * HALF + m * 16;
#pragma unroll
                    for (int bj = 0; bj < 2; ++bj) store8(BG + row * 1024 + (pn - 8) * 256 + bj * HALF + cw, acc[ai][bj][m][0], acc[ai][bj][m][1]); }
        } else if (pn < 20) {
            const bool isq = pn < 16; bf16_t* dst = isq ? Q : Kk; const int cb = ((pn - 12) & 3) * 256; const float sc = isq ? QSCALE : 1.0f;
            const bool rot = ((wc & 1) == 0) && (fq < 2);
#pragma unroll
            for (int ai = 0; ai < 2; ++ai)
#pragma unroll
                for (int m = 0; m < 4; ++m) { const size_t row = row0 + ai * HALF + m * 16;
                    f32x4 c4 = *(const f32x4*)(CS + row * 16 + 4 * (fq & 1)), s4 = *(const f32x4*)(CS + row * 16 + 8 + 4 * (fq & 1));
                    if (!rot) { c4 = (f32x4){1.f, 1.f, 1.f, 1.f}; s4 = (f32x4){0.f, 0.f, 0.f, 0.f}; }
#pragma unroll
                    for (int bj = 0; bj < 2; ++bj) { const f32x4 v0 = acc[ai][bj][m][0], v1 = acc[ai][bj][m][1]; f32x4 o0, o1;
                        o0[0] = v0[0] * c4[0] - v0[1] * s4[0]; o0[1] = v0[1] * c4[0] + v0[0] * s4[0];
                        o0[2] = v0[2] * c4[1] - v0[3] * s4[1]; o0[3] = v0[3] * c4[1] + v0[2] * s4[1];
                        o1[0] = v1[0] * c4[2] - v1[1] * s4[2]; o1[1] = v1[1] * c4[2] + v1[0] * s4[2];
                        o1[2] = v1[2] * c4[3] - v1[3] * s4[3]; o1[3] = v1[3] * c4[3] + v1[2] * s4[3];
                        store8(dst + row * 1024 + cb + bj * HALF + cw, o0 * sc, o1 * sc); } }
        } else if (pn < 24) {
#pragma unroll
            for (int ai = 0; ai < 2; ++ai)
#pragma unroll
                for (int m = 0; m < 4; ++m) { const size_t row = row0 + ai * HALF + m * 16;
#pragma unroll
                    for (int bj = 0; bj < 2; ++bj) store8(V + row * 1024 + (pn - 20) * 256 + bj * HALF + cw, acc[ai][bj][m][0], acc[ai][bj][m][1]); }
        } else {
            f32x4 bv[2][2];
#pragma unroll
            for (int bj = 0; bj < 2; ++bj)
#pragma unroll
                for (int n = 0; n < 2; ++n) bv[bj][n] = *(const f32x4*)(gate_b + (pn - 24) * 256 + bj * HALF + cw + 4 * n);
#pragma unroll
            for (int ai = 0; ai < 2; ++ai)
#pragma unroll
                for (int m = 0; m < 4; ++m) { const size_t row = row0 + ai * HALF + m * 16;
#pragma unroll
                    for (int bj = 0; bj < 2; ++bj) { f32x4 g0 = acc[ai][bj][m][0] + bv[bj][0], g1 = acc[ai][bj][m][1] + bv[bj][1];
#pragma unroll
                        for (int i = 0; i < 4; ++i) { g0[i] = 1.0f / (1.0f + __expf(-g0[i])); g1[i] = 1.0f / (1.0f + __expf(-g1[i])); }
                        store8(G + row * 2048 + (pn - 24) * 256 + bj * HALF + cw, g0, g1); } }
        }
    }
};
struct EpiGate1 {
    static constexpr bool PERM = true, AFTER_DRAIN = false;
    const bf16_t* G; bf16_t* T1;
    __device__ __forceinline__ void operator()(const f32x4 (&acc)[2][2][4][2], const Unit& u, int wr, int wc, int fr, int fq) const {
        const int row0 = u.pm * BM + wr * 64 + fr, col0 = u.pn * BM + wc * 32 + 8 * fq;
#pragma unroll
        for (int ai = 0; ai < 2; ++ai)
#pragma unroll
            for (int m = 0; m < 4; ++m) { const size_t row = row0 + ai * HALF + m * 16;
#pragma unroll
                for (int bj = 0; bj < 2; ++bj) { f32x4 g0, g1; load8(G + row * 2048 + col0 + bj * HALF, g0, g1);
                    store8(T1 + row * 1024 + col0 + bj * HALF, acc[ai][bj][m][0] * g0, acc[ai][bj][m][1] * g1); } }
    }
};
struct EpiGate2 {
    static constexpr bool PERM = true, AFTER_DRAIN = false;
    const bf16_t* G; const bf16_t* T1; bf16_t* MG;
    __device__ __forceinline__ void operator()(const f32x4 (&acc)[2][2][4][2], const Unit& u, int wr, int wc, int fr, int fq) const {
        const int row0 = u.pm * BM + wr * 64 + fr, col0 = u.pn * BM + wc * 32 + 8 * fq;
#pragma unroll
        for (int ai = 0; ai < 2; ++ai)
#pragma unroll
            for (int m = 0; m < 4; ++m) { const size_t row = row0 + ai * HALF + m * 16;
#pragma unroll
                for (int bj = 0; bj < 2; ++bj) { f32x4 g0, g1, t0, t1; load8(G + row * 2048 + 1024 + col0 + bj * HALF, g0, g1); load8(T1 + row * 1024 + col0 + bj * HALF, t0, t1);
                    store8(MG + row * 1024 + col0 + bj * HALF, t0 + acc[ai][bj][m][0] * g0, t1 + acc[ai][bj][m][1] * g1); } }
    }
};
template <bool HAS_BASE, int ldc> struct EpiF32 {
    static constexpr bool PERM = false, AFTER_DRAIN = false;
    static constexpr float alpha = 1.189207115002721f;
    const float* base; float* O;
    __device__ __forceinline__ void operator()(const f32x4 (&acc)[2][2][4][2], const Unit& u, int wr, int wc, int fr, int fq) const {
        const int row0 = u.pm * BM + wr * 64 + fr, col0 = u.pn * BM + wc * 32 + 4 * fq;
#pragma unroll
        for (int ai = 0; ai < 2; ++ai)
#pragma unroll
            for (int m = 0; m < 4; ++m) { const size_t row = row0 + ai * HALF + m * 16;
#pragma unroll
                for (int bj = 0; bj < 2; ++bj)
#pragma unroll
                    for (int n = 0; n < 2; ++n) { const size_t o = row * ldc + col0 + bj * HALF + n * 16; f32x4 v = acc[ai][bj][m][n];
                        if constexpr (HAS_BASE) v = v + alpha * *(const f32x4*)(base + o);
                        *(f32x4*)(O + o) = v; } }
    }
};

template <class Epi, class Sched, bool ALIGN_EPI = false, bool SP2 = false>
__device__ __forceinline__ void gemm_phase(PG8_LAS unsigned char* lds, const Gemm g, const Sched& S, const Epi& E) {
    const int tid = threadIdx.x, wid = __builtin_amdgcn_readfirstlane(tid >> 6), lane = tid & 63, wr = wid >> 2, wc = wid & 3, fr = lane & 15, fq = lane >> 4;
    const int K = g.K, nt = K / BK;
    unsigned voffA[2], voffB[2];
#pragma unroll
    for (int i = 0; i < 2; ++i) { int R, C; stage_rc(tid * 16 + i * 8192, R, C); const int Rb = Epi::PERM ? ((R & ~31) + perm32(R & 31)) : R;
        voffA[i] = (unsigned)(R * K + C) * 2u; voffB[i] = (unsigned)(Rb * K + C) * 2u; }
    const size_t kstep = (size_t)(BK * 2);
    const size_t hstep = (size_t)HALF * K * 2;
    const size_t tstep = 2 * hstep;
    const unsigned ldsw = (unsigned)wid * 1024u;
    const int aoff = lds_byte(wr * 64 + fr, fq * 8), boff = lds_byte(wc * 32 + fr, fq * 8);
#define PG8_SA(b, h) (((b) * 2 + (h)) * HTB)
#define PG8_SB(b, h) ((4 + (b) * 2 + (h)) * HTB)
#define PG8_STAGE(bufoff, gbase, voff) do { _Pragma("unroll") for (int _i = 0; _i < 2; ++_i) \
        __builtin_amdgcn_global_load_lds((const unsigned*)((const char*)(gbase) + (voff)[_i]), (PG8_LAS unsigned*)(lds + (bufoff) + ldsw + _i * 8192), 16, 0, 0); } while (0)
#define PG8_LDA(dst, b, h) do { _Pragma("unroll") for (int m = 0; m < 4; ++m) _Pragma("unroll") for (int k = 0; k < 2; ++k) dst[m][k] = *(const PG8_LAS bf16x8*)(lds + PG8_SA(b, h) + aoff + m * 2048 + k * 1024); } while (0)
#define PG8_LDB(dst, b, h) do { _Pragma("unroll") for (int n = 0; n < 2; ++n) _Pragma("unroll") for (int k = 0; k < 2; ++k) dst[n][k] = *(const PG8_LAS bf16x8*)(lds + PG8_SB(b, h) + boff + n * 2048 + k * 1024); } while (0)
#define PG8_MMA(ai, bj, At, Bt) do { __builtin_amdgcn_s_setprio(1); _Pragma("unroll") for (int m = 0; m < 4; ++m) _Pragma("unroll") for (int n = 0; n < 2; ++n) _Pragma("unroll") for (int k = 0; k < 2; ++k) \
        acc[ai][bj][m][n] = __builtin_amdgcn_mfma_f32_16x16x32_bf16(Bt[n][k], At[m][k], acc[ai][bj][m][n], 0, 0, 0); __builtin_amdgcn_s_setprio(0); } while (0)
#define PG8_WAIT_V(n) asm volatile("s_waitcnt vmcnt(" #n ")" ::: "memory")
#define PG8_WAIT_L(n) asm volatile("s_waitcnt lgkmcnt(" #n ")" ::: "memory")
#define PG8_BAR __builtin_amdgcn_s_barrier()
#define PG8_SCHED __builtin_amdgcn_sched_barrier(0)
    Unit cur, nxt; int ui = 0;
    if (!S.next(0, cur)) return;
    f32x4 acc[2][2][4][2];
#pragma unroll
    for (int a = 0; a < 2; ++a)
#pragma unroll
        for (int b = 0; b < 2; ++b)
#pragma unroll
            for (int m = 0; m < 4; ++m)
#pragma unroll
                for (int n = 0; n < 2; ++n) acc[a][b][m][n] = (f32x4){0.f, 0.f, 0.f, 0.f};
    bf16x8 At[4][2], B0[2][2], B1[2][2];
    const char* cA = (const char*)g.A + (size_t)cur.pm * tstep; const char* cB = (const char*)g.Bt + (size_t)cur.pn * tstep;
    S.a_ready(cur);
    if constexpr (SP2) {
        PG8_STAGE(PG8_SB(0, 0), cB, voffB); PG8_STAGE(PG8_SB(0, 1), cB + hstep, voffB); PG8_STAGE(PG8_SA(0, 0), cA, voffA); PG8_STAGE(PG8_SA(0, 1), cA + hstep, voffA);
        if (wr == 1) PG8_BAR;
        PG8_WAIT_V(2); PG8_BAR;
        PG8_STAGE(PG8_SB(1, 0), cB + kstep, voffB); PG8_STAGE(PG8_SA(1, 0), cA + kstep, voffA); PG8_STAGE(PG8_SB(1, 1), cB + hstep + kstep, voffB);
        PG8_WAIT_V(6); PG8_BAR;
    } else {
        PG8_STAGE(PG8_SB(0, 0), cB, voffB); PG8_STAGE(PG8_SA(0, 0), cA, voffA); PG8_STAGE(PG8_SB(0, 1), cB + hstep, voffB); PG8_STAGE(PG8_SA(0, 1), cA + hstep, voffA);
        if (wr == 1) PG8_BAR;
        PG8_WAIT_V(4); PG8_BAR;
        PG8_STAGE(PG8_SB(1, 0), cB + kstep, voffB); PG8_STAGE(PG8_SA(1, 0), cA + kstep, voffA); PG8_STAGE(PG8_SB(1, 1), cB + hstep + kstep, voffB);
        PG8_WAIT_V(6); PG8_BAR;
    }
    for (;;) {
        const bool has_next = S.next(ui + 1, nxt);
        const char* nA = has_next ? (const char*)g.A + (size_t)nxt.pm * tstep : cA; const char* nB = has_next ? (const char*)g.Bt + (size_t)nxt.pn * tstep : cB;
        for (int t = 0; t < nt; t += 2) {
            const bool last = (t == nt - 2);
            const char* a1 = cA + (size_t)(t + 1) * kstep;
            const char* a2 = last ? nA : cA + (size_t)(t + 2) * kstep; const char* b2 = last ? nB : cB + (size_t)(t + 2) * kstep;
            const char* a3 = a2 + kstep; const char* b3 = b2 + kstep;
            if (last && has_next) S.a_ready(nxt);
            if constexpr (SP2) {
            PG8_LDB(B0, 0, 0); PG8_LDB(B1, 0, 1); PG8_SCHED; PG8_LDA(At, 0, 0); PG8_STAGE(PG8_SA(1, 1), a1 + hstep, voffA);
            PG8_WAIT_V(8); PG8_WAIT_L(0); PG8_BAR; PG8_MMA(0, 0, At, B0); PG8_MMA(0, 1, At, B1); PG8_BAR; PG8_SCHED;
            PG8_LDA(At, 0, 1); PG8_STAGE(PG8_SB(0, 0), b2, voffB); PG8_STAGE(PG8_SB(0, 1), b2 + hstep, voffB); PG8_STAGE(PG8_SA(0, 0), a2, voffA);
            PG8_WAIT_V(8); PG8_WAIT_L(0); PG8_BAR; PG8_MMA(1, 0, At, B0); PG8_MMA(1, 1, At, B1); PG8_BAR; PG8_SCHED;
            PG8_LDB(B0, 1, 0); PG8_LDB(B1, 1, 1); PG8_SCHED; PG8_LDA(At, 1, 0); PG8_STAGE(PG8_SA(0, 1), a2 + hstep, voffA);
            PG8_WAIT_V(8); PG8_WAIT_L(0); PG8_BAR; PG8_MMA(0, 0, At, B0); PG8_MMA(0, 1, At, B1); PG8_BAR; PG8_SCHED;
            PG8_LDA(At, 1, 1); PG8_STAGE(PG8_SB(1, 0), b3, voffB); PG8_STAGE(PG8_SB(1, 1), b3 + hstep, voffB); PG8_STAGE(PG8_SA(1, 0), a3, voffA);
            PG8_WAIT_V(8); PG8_WAIT_L(0); PG8_BAR; PG8_MMA(1, 0, At, B0); PG8_MMA(1, 1, At, B1); PG8_BAR; PG8_SCHED;
            } else {
            PG8_LDB(B0, 0, 0); PG8_SCHED; PG8_LDA(At, 0, 0); PG8_STAGE(PG8_SA(1, 1), a1 + hstep, voffA);
            PG8_WAIT_L(8); PG8_BAR; PG8_WAIT_L(0); PG8_MMA(0, 0, At, B0); PG8_BAR; PG8_SCHED;
            PG8_LDB(B1, 0, 1); PG8_STAGE(PG8_SB(0, 0), b2, voffB);
            PG8_BAR; PG8_WAIT_L(0); PG8_MMA(0, 1, At, B1); PG8_BAR;
            PG8_LDA(At, 0, 1); PG8_STAGE(PG8_SA(0, 0), a2, voffA);
            PG8_BAR; PG8_WAIT_L(0); PG8_MMA(1, 0, At, B0); PG8_BAR; PG8_SCHED;
            PG8_STAGE(PG8_SB(0, 1), b2 + hstep, voffB);
            PG8_WAIT_V(6); PG8_BAR; PG8_MMA(1, 1, At, B1); PG8_BAR;
            PG8_LDB(B0, 1, 0); PG8_SCHED; PG8_LDA(At, 1, 0); PG8_STAGE(PG8_SA(0, 1), a2 + hstep, voffA);
            PG8_WAIT_L(8); PG8_BAR; PG8_WAIT_L(0); PG8_MMA(0, 0, At, B0); PG8_BAR; PG8_SCHED;
            PG8_LDB(B1, 1, 1); PG8_STAGE(PG8_SB(1, 0), b3, voffB);
            PG8_BAR; PG8_WAIT_L(0); PG8_MMA(0, 1, At, B1); PG8_BAR;
            PG8_LDA(At, 1, 1); PG8_STAGE(PG8_SA(1, 0), a3, voffA);
            PG8_BAR; PG8_WAIT_L(0); PG8_MMA(1, 0, At, B0); PG8_BAR; PG8_SCHED;
            PG8_STAGE(PG8_SB(1, 1), b3 + hstep, voffB);
            PG8_WAIT_V(6); PG8_BAR; PG8_MMA(1, 1, At, B1); PG8_BAR;
            }
        }
        if constexpr (ALIGN_EPI) { if (wr == 0) PG8_BAR; }
        if constexpr (!Epi::AFTER_DRAIN) { E(acc, cur, wr, wc, fr, fq); S.done(cur); }
        if (!has_next) break;
#pragma unroll
        for (int a = 0; a < 2; ++a)
#pragma unroll
            for (int b = 0; b < 2; ++b)
#pragma unroll
                for (int m = 0; m < 4; ++m)
#pragma unroll
                    for (int n = 0; n < 2; ++n) acc[a][b][m][n] = (f32x4){0.f, 0.f, 0.f, 0.f};
        cur = nxt; cA = nA; cB = nB; ++ui;
        if constexpr (ALIGN_EPI) { if (wr == 1) PG8_BAR; }
    }
    PG8_WAIT_V(0);
    if constexpr (!ALIGN_EPI) { if (wr == 0) PG8_BAR; }
    PG8_BAR;
    if constexpr (Epi::AFTER_DRAIN) { E.fused(acc, cur, wr, wc, fr, fq, lds, wid, lane); S.done(cur); }
#undef PG8_SA
#undef PG8_SB
#undef PG8_STAGE
#undef PG8_LDA
#undef PG8_LDB
#undef PG8_MMA
#undef PG8_WAIT_V
#undef PG8_WAIT_L
#undef PG8_BAR
#undef PG8_SCHED
}
}

constexpr int T = 16384, D = 1024, SEQ = 2048, NBATCH = 8, NIN = 8192;
constexpr int NHEAD = 8, NEXP = 16384;
constexpr float LN_EPS = 1e-5f;
constexpr float ALPHA = 1.189207115002721f;
constexpr float LAM_INIT = 0.2f;
constexpr int NWAVES = 8, NTHREADS = 512;
constexpr int LDS_BYTES = 147456;
constexpr int NPHASES = 9;
#ifndef MK_N_LAUNCHES
#define MK_N_LAUNCHES 9
#endif

typedef unsigned short bf16_t;
typedef short bf16x8 __attribute__((ext_vector_type(8)));
typedef short s16x4 __attribute__((ext_vector_type(4)));
typedef float f32x4 __attribute__((ext_vector_type(4)));
typedef float f32x16 __attribute__((ext_vector_type(16)));
typedef unsigned u32x4 __attribute__((ext_vector_type(4)));
typedef unsigned u32x2 __attribute__((ext_vector_type(2)));
#define LAS __attribute__((address_space(3)))
#define LDS_WAIT() asm volatile("s_waitcnt lgkmcnt(0)" ::: "memory")

constexpr size_t MiB = 1u << 20;
constexpr size_t WS_CTL = 0, WS_CS = 1 * MiB, WS_WCO = 2 * MiB, WS_WAO = 4 * MiB, WS_WO = 6 * MiB, WS_WSC = 8 * MiB;
constexpr size_t WS_WIN = 12 * MiB, WS_XB = 28 * MiB, WS_Z = 60 * MiB, WS_BG = 92 * MiB, WS_Q = 124 * MiB, WS_K = 156 * MiB, WS_V = 188 * MiB;
constexpr size_t WS_UB = 12 * MiB, WS_VB = 44 * MiB;
constexpr size_t WS_T1 = 156 * MiB, WS_MG = 188 * MiB;
constexpr size_t WS_X1B = 76 * MiB;
constexpr size_t WS_SC = 124 * MiB;
constexpr size_t WS_END = 252 * MiB;

__device__ __forceinline__ unsigned f2bf(float f) { unsigned u = __builtin_bit_cast(unsigned, f); return (u + 0x7fffu + ((u >> 16) & 1u)) >> 16; }
__device__ __forceinline__ unsigned pk2(float lo, float hi) { return f2bf(lo) | (f2bf(hi) << 16); }
__device__ __forceinline__ float bflo(unsigned w) { return __uint_as_float(w << 16); }
__device__ __forceinline__ float bfhi(unsigned w) { return __uint_as_float(w & 0xffff0000u); }
__device__ __forceinline__ float wave_sum(float v) {
#pragma unroll
    for (int o = 1; o < 64; o <<= 1) v += __shfl_xor(v, o);
    return v;
}
__device__ __forceinline__ float wave_max(float v) {
#pragma unroll
    for (int o = 1; o < 64; o <<= 1) v = fmaxf(v, __shfl_xor(v, o));
    return v;
}
__device__ __forceinline__ float wave_min(float v) {
#pragma unroll
    for (int o = 1; o < 64; o <<= 1) v = fminf(v, __shfl_xor(v, o));
    return v;
}

__device__ __forceinline__ int win_src(int n) {
    if (n < 2048) { const int i = n >> 8, r = n & 255; return r < 128 ? 128 * i + r : 2048 + 128 * i + (r - 128); }
    if (n < 3072) return 1024 + (n - 2048);
    if (n < 5120) { const int base = n - 3072, which = base >> 10, within = base & 1023, map = within >> 6, p = within & 63; const int d = p < 16 ? (p >> 1) + 8 * (p & 1) : p; return 3072 + which * 1024 + map * 64 + d; }
    return n;
}
template <bool PERMUTE>
__device__ __forceinline__ void transpose_item(const float* W, int K, int N, bf16_t* WT, LAS float* scr, int item, int lane) {
    const int nblk = N / 32, kb = item / nblk, nb = item % nblk, k0 = 64 * kb, n0 = 32 * nb;
    const int nsrc = PERMUTE ? win_src(n0 + (lane & 31)) : n0 + (lane & 31);
#pragma unroll 8
    for (int i = 0; i < 32; ++i) { const int kk = 2 * i + (lane >> 5); scr[kk * 33 + (lane & 31)] = W[(size_t)(k0 + kk) * N + nsrc]; }
    LDS_WAIT();
    const int c = lane & 7;
#pragma unroll
    for (int j = 0; j < 4; ++j) { const int n = (lane >> 3) + 8 * j; const LAS float* s = scr + (8 * c) * 33 + n;
        u32x4 o; o.x = pk2(s[0 * 33], s[1 * 33]); o.y = pk2(s[2 * 33], s[3 * 33]); o.z = pk2(s[4 * 33], s[5 * 33]); o.w = pk2(s[6 * 33], s[7 * 33]);
        *(u32x4*)(WT + (size_t)(n0 + n) * K + k0 + 8 * c) = o; }
    LDS_WAIT();
}
__device__ __forceinline__ void cvt_bf16(const float* src, bf16_t* dst, size_t n, int gtid, int gthreads) {
    const size_t n8 = n / 8;
    for (size_t i = gtid; i < n8; i += gthreads) {
        const f32x4 a = *(const f32x4*)(src + i * 8), b = *(const f32x4*)(src + i * 8 + 4);
        u32x4 o; o.x = pk2(a[0], a[1]); o.y = pk2(a[2], a[3]); o.z = pk2(b[0], b[1]); o.w = pk2(b[2], b[3]);
        *(u32x4*)(dst + i * 8) = o;
    }
}
__device__ __forceinline__ void wsc_item(const float* w_pq, const float* sub_keys, bf16_t* Wsc, LAS unsigned char* lds, int item, int tid) {
    const int hc = item >> 4, d0 = (item & 15) * 64;
    LAS float* kl = (LAS float*)lds; LAS float* wl = (LAS float*)(lds + 67584);
    for (int i = tid; i < 128 * 32; i += NTHREADS) { const int n = i >> 5, j4 = (i & 31) * 4; *(LAS f32x4*)(kl + n * 132 + j4) = *(const f32x4*)(sub_keys + ((size_t)hc * 128 + n) * 128 + j4); }
    for (int i = tid; i < 64 * 32; i += NTHREADS) { const int dd = i >> 5, j4 = (i & 31) * 4; *(LAS f32x4*)(wl + dd * 128 + j4) = *(const f32x4*)(w_pq + (size_t)(d0 + dd) * 2048 + hc * 128 + j4); }
    __syncthreads();
    const int n = tid & 127, dq = tid >> 7;
    float acc[16];
#pragma unroll
    for (int i = 0; i < 16; ++i) acc[i] = 0.f;
    for (int j4 = 0; j4 < 128; j4 += 4) {
        const f32x4 kv = *(const LAS f32x4*)(kl + n * 132 + j4);
#pragma unroll
        for (int i = 0; i < 16; ++i) { const f32x4 wv = *(const LAS f32x4*)(wl + (dq * 16 + i) * 128 + j4); acc[i] += kv[0] * wv[0] + kv[1] * wv[1] + kv[2] * wv[2] + kv[3] * wv[3]; }
    }
    u32x4 o0, o1;
    o0.x = pk2(acc[0], acc[1]); o0.y = pk2(acc[2], acc[3]); o0.z = pk2(acc[4], acc[5]); o0.w = pk2(acc[6], acc[7]);
    o1.x = pk2(acc[8], acc[9]); o1.y = pk2(acc[10], acc[11]); o1.z = pk2(acc[12], acc[13]); o1.w = pk2(acc[14], acc[15]);
    bf16_t* dst = Wsc + (size_t)(hc * 128 + n) * 1024 + d0 + dq * 16;
    *(u32x4*)dst = o0; *(u32x4*)(dst + 8) = o1;
    __syncthreads();
}

__device__ __forceinline__ void conv_phase(const bf16_t* Z, bf16_t* BG, const float* conv_w, const float* conv_b, int gtid, int gthreads) {
    for (int it = gtid; it < (T / 16) * 128; it += gthreads) {
        const int rb = it >> 7, cc = it & 127, t0 = rb * 16, c0 = cc * 8;
        float w0[8], w1[8], w2[8], cb[8];
#pragma unroll
        for (int i = 0; i < 8; ++i) { w0[i] = conv_w[c0 + i]; w1[i] = conv_w[1024 + c0 + i]; w2[i] = conv_w[2048 + c0 + i]; cb[i] = conv_b[c0 + i]; }
        float zm2[8], zm1[8];
        if ((t0 & (SEQ - 1)) != 0) {
            const u32x4 a = *(const u32x4*)(Z + (size_t)(t0 - 2) * 1024 + c0), b = *(const u32x4*)(Z + (size_t)(t0 - 1) * 1024 + c0);
            zm2[0] = bflo(a.x); zm2[1] = bfhi(a.x); zm2[2] = bflo(a.y); zm2[3] = bfhi(a.y); zm2[4] = bflo(a.z); zm2[5] = bfhi(a.z); zm2[6] = bflo(a.w); zm2[7] = bfhi(a.w);
            zm1[0] = bflo(b.x); zm1[1] = bfhi(b.x); zm1[2] = bflo(b.y); zm1[3] = bfhi(b.y); zm1[4] = bflo(b.z); zm1[5] = bfhi(b.z); zm1[6] = bflo(b.w); zm1[7] = bfhi(b.w);
        } else {
#pragma unroll
            for (int i = 0; i < 8; ++i) { zm2[i] = 0.f; zm1[i] = 0.f; }
        }
#pragma unroll 4
        for (int r = 0; r < 16; ++r) {
            const size_t o = (size_t)(t0 + r) * 1024 + c0;
            const u32x4 a = *(const u32x4*)(Z + o), g = *(const u32x4*)(BG + o);
            float z[8], bgv[8], y[8];
            z[0] = bflo(a.x); z[1] = bfhi(a.x); z[2] = bflo(a.y); z[3] = bfhi(a.y); z[4] = bflo(a.z); z[5] = bfhi(a.z); z[6] = bflo(a.w); z[7] = bfhi(a.w);
            bgv[0] = bflo(g.x); bgv[1] = bfhi(g.x); bgv[2] = bflo(g.y); bgv[3] = bfhi(g.y); bgv[4] = bflo(g.z); bgv[5] = bfhi(g.z); bgv[6] = bflo(g.w); bgv[7] = bfhi(g.w);
#pragma unroll
            for (int i = 0; i < 8; ++i) { y[i] = bgv[i] * (cb[i] + w0[i] * zm2[i] + w1[i] * zm1[i] + w2[i] * z[i]); zm2[i] = zm1[i]; zm1[i] = z[i]; }
            u32x4 ov; ov.x = pk2(y[0], y[1]); ov.y = pk2(y[2], y[3]); ov.z = pk2(y[4], y[5]); ov.w = pk2(y[6], y[7]);
            *(u32x4*)(BG + o) = ov;
        }
    }
}

namespace att {
constexpr int STAGE = 32768;
constexpr int XCH_OFF = 65536;
__device__ __forceinline__ int crow(int r, int hi) { return (r & 3) + 8 * (r >> 2) + 4 * hi; }
__device__ __forceinline__ s16x4 vtr(const LAS unsigned char* p) { return __builtin_bit_cast(s16x4, __builtin_amdgcn_ds_read_tr16_b64_v4i16((LAS s16x4*)p)); }

__device__ __forceinline__ void attn_unit(int b, int h, int qblk, const bf16_t* Q, const bf16_t* Kg, const bf16_t* Vg, bf16_t* O, const float* subln_g, float lam,
                                          LAS unsigned char* lds, int tid) {
    const int lane = tid & 63, wid = __builtin_amdgcn_readfirstlane(tid >> 6), rg = wid >> 1, c = wid & 1, r = lane & 31, hh = lane >> 5;
    const size_t seq0 = (size_t)b * SEQ;
    const int qs = qblk * 128 + rg * 32;
    bf16x8 qf[4];
    { const bf16_t* qp = Q + (seq0 + qs + r) * 1024 + h * 128 + c * 64 + 8 * hh;
#pragma unroll
      for (int ks = 0; ks < 4; ++ks) qf[ks] = *(const bf16x8*)(qp + 16 * ks); }
    const int kkey = tid >> 3, kch = tid & 7;
    const unsigned kdst = (unsigned)(kkey * 128 + ((kch ^ ((kkey >> 1) & 7)) * 16));
    const int v0key = tid >> 4, vch = tid & 15;
    const unsigned vdst0 = (unsigned)(v0key * 256 + (((vch >> 2) ^ (v0key & 3)) * 64) + (vch & 3) * 16);
    const unsigned vdst1 = vdst0 + 32 * 256;
    const bf16_t* kbase = Kg + seq0 * 1024 + h * 128 + kch * 8;
    const bf16_t* vbase = Vg + seq0 * 1024 + h * 128 + vch * 8;
    const int kswz = (r >> 1) & 7;
    unsigned koff[4];
#pragma unroll
    for (int ks = 0; ks < 4; ++ks) koff[ks] = (unsigned)(c * 8192 + r * 128 + (((ks * 2 + hh) ^ kswz) * 16));
    const int i16 = lane & 15, vq = i16 >> 2, vp = i16 & 3, g16 = (lane >> 4) & 1;
    unsigned voff[4];
#pragma unroll
    for (int dt = 0; dt < 4; ++dt) voff[dt] = (unsigned)(16384 + (4 * hh + vq) * 256 + ((dt ^ vq) * 64) + (16 * g16 + 4 * vp) * 2);

    f32x16 o[4];
#pragma unroll
    for (int dt = 0; dt < 4; ++dt)
#pragma unroll
        for (int i = 0; i < 16; ++i) o[dt][i] = 0.f;
    float mrun = -1e30f, lrun = 0.f;
    const int nt = 2 * qblk + 2;
    const int jmax = (qs + 31) >> 6;

    u32x4 pk0, pk1, pv0, pv1;
    { const size_t ro = (size_t)kkey * 1024; pk0 = *(const u32x4*)(kbase + ro); pk1 = *(const u32x4*)(kbase + ro + 64);
      pv0 = *(const u32x4*)(vbase + (size_t)v0key * 1024); pv1 = *(const u32x4*)(vbase + (size_t)(v0key + 32) * 1024); }
    *(LAS u32x4*)(lds + kdst) = pk0; *(LAS u32x4*)(lds + 8192 + kdst) = pk1; *(LAS u32x4*)(lds + 16384 + vdst0) = pv0; *(LAS u32x4*)(lds + 16384 + vdst1) = pv1;
    __syncthreads();
    for (int j = 0; j < nt; ++j) {
        const LAS unsigned char* st = lds + (j & 1) * STAGE;
        if (j + 1 < nt) { const size_t ro = (size_t)((j + 1) * 64 + kkey) * 1024; pk0 = *(const u32x4*)(kbase + ro); pk1 = *(const u32x4*)(kbase + ro + 64);
            pv0 = *(const u32x4*)(vbase + (size_t)((j + 1) * 64 + v0key) * 1024); pv1 = *(const u32x4*)(vbase + (size_t)((j + 1) * 64 + v0key + 32) * 1024); }
        if (j <= jmax) {
            f32x16 s0, s1;
#pragma unroll
            for (int i = 0; i < 16; ++i) { s0[i] = 0.f; s1[i] = 0.f; }
#pragma unroll
            for (int ks = 0; ks < 4; ++ks) {
                const bf16x8 ka = *(const LAS bf16x8*)(st + koff[ks]), kb = *(const LAS bf16x8*)(st + koff[ks] + 4096);
                s0 = __builtin_amdgcn_mfma_f32_32x32x16_bf16(ka, qf[ks], s0, 0, 0, 0);
                s1 = __builtin_amdgcn_mfma_f32_32x32x16_bf16(kb, qf[ks], s1, 0, 0, 0);
            }
            if (j * 64 + 63 > qs) {
                const int qrel = qs + r - j * 64;
#pragma unroll
                for (int i = 0; i < 16; ++i) { const int kv = crow(i, hh); if (kv > qrel) s0[i] = -INFINITY; if (kv + 32 > qrel) s1[i] = -INFINITY; }
            }
            float mx = fmaxf(s0[0], s1[0]);
#pragma unroll
            for (int i = 1; i < 16; ++i) mx = fmaxf(mx, fmaxf(s0[i], s1[i]));
            mx = fmaxf(mx, __shfl_xor(mx, 32));
            const float mnew = fmaxf(mrun, mx), al = exp2f(mrun - mnew);
            mrun = mnew;
            float ps = 0.f;
#pragma unroll
            for (int i = 0; i < 16; ++i) { s0[i] = exp2f(s0[i] - mnew); s1[i] = exp2f(s1[i] - mnew); ps += s0[i] + s1[i]; }
            lrun = lrun * al + ps;
#pragma unroll
            for (int dt = 0; dt < 4; ++dt)
#pragma unroll
                for (int i = 0; i < 16; ++i) o[dt][i] *= al;
            bf16x8 pf[4];
#pragma unroll
            for (int s = 0; s < 2; ++s) {
                u32x4 w0, w1;
                w0.x = pg8::cvt_pk_bf16(s0[8 * s + 0], s0[8 * s + 1]); w0.y = pg8::cvt_pk_bf16(s0[8 * s + 2], s0[8 * s + 3]); w0.z = pg8::cvt_pk_bf16(s0[8 * s + 4], s0[8 * s + 5]); w0.w = pg8::cvt_pk_bf16(s0[8 * s + 6], s0[8 * s + 7]);
                w1.x = pg8::cvt_pk_bf16(s1[8 * s + 0], s1[8 * s + 1]); w1.y = pg8::cvt_pk_bf16(s1[8 * s + 2], s1[8 * s + 3]); w1.z = pg8::cvt_pk_bf16(s1[8 * s + 4], s1[8 * s + 5]); w1.w = pg8::cvt_pk_bf16(s1[8 * s + 6], s1[8 * s + 7]);
                pf[s] = __builtin_bit_cast(bf16x8, w0); pf[2 + s] = __builtin_bit_cast(bf16x8, w1);
            }
#pragma unroll
            for (int dt = 0; dt < 4; ++dt) {
#pragma unroll
                for (int ks = 0; ks < 4; ++ks) {
                    const s16x4 lo = vtr(st + voff[dt] + ks * 16 * 256), hi = vtr(st + voff[dt] + ks * 16 * 256 + 8 * 256);
                    const bf16x8 va = (bf16x8){lo[0], lo[1], lo[2], lo[3], hi[0], hi[1], hi[2], hi[3]};
                    o[dt] = __builtin_amdgcn_mfma_f32_32x32x16_bf16(va, pf[ks], o[dt], 0, 0, 0);
                }
            }
        }
        if (j + 1 < nt) { LAS unsigned char* sn = lds + ((j + 1) & 1) * STAGE;
            *(LAS u32x4*)(sn + kdst) = pk0; *(LAS u32x4*)(sn + 8192 + kdst) = pk1; *(LAS u32x4*)(sn + 16384 + vdst0) = pv0; *(LAS u32x4*)(sn + 16384 + vdst1) = pv1; }
        __syncthreads();
    }
    const float ltot = lrun + __shfl_xor(lrun, 32);
    const float inv = (c == 0 ? 1.0f : lam) / ltot;
    LAS float* xch = (LAS float*)(lds + XCH_OFF) + rg * 4096 + lane;
    if (c == 1) {
#pragma unroll
        for (int dt = 0; dt < 4; ++dt)
#pragma unroll
            for (int i = 0; i < 16; ++i) xch[(dt * 16 + i) * 64] = o[dt][i] * inv;
    }
    __syncthreads();
    if (c == 0) {
        float ss = 0.f;
#pragma unroll
        for (int dt = 0; dt < 4; ++dt)
#pragma unroll
            for (int i = 0; i < 16; ++i) { const float v = o[dt][i] * inv - xch[(dt * 16 + i) * 64]; o[dt][i] = v; ss += v * v; }
        ss += __shfl_xor(ss, 32);
        const float rs = (1.0f - LAM_INIT) / sqrtf(ss * (1.0f / 128.0f) + LN_EPS);
        bf16_t* op = O + (seq0 + qs + r) * 1024 + h * 128 + 4 * hh;
#pragma unroll
        for (int dt = 0; dt < 4; ++dt)
#pragma unroll
            for (int g = 0; g < 4; ++g) { const int e = dt * 32 + 8 * g;
                const f32x4 gv = *(const f32x4*)(subln_g + e + 4 * hh);
                u32x2 w; w.x = pg8::cvt_pk_bf16(o[dt][4 * g] * rs * gv[0], o[dt][4 * g + 1] * rs * gv[1]); w.y = pg8::cvt_pk_bf16(o[dt][4 * g + 2] * rs * gv[2], o[dt][4 * g + 3] * rs * gv[3]);
                *(u32x2*)(op + e) = w; }
    }
    __syncthreads();
}
}

__device__ __forceinline__ void ln1_phase(float* X, bf16_t* XB, const float* g, const float* bta, int gw, int ngw, int lane) {
    f32x4 gv[4], bv[4];
#pragma unroll
    for (int j = 0; j < 4; ++j) { gv[j] = *(const f32x4*)(g + 4 * lane + 256 * j); bv[j] = *(const f32x4*)(bta + 4 * lane + 256 * j); }
    for (int m = gw; m < T; m += ngw) {
        f32x4* xr = (f32x4*)(X + (size_t)m * D) + lane;
        f32x4 v[4]; float s = 0.f;
#pragma unroll
        for (int j = 0; j < 4; ++j) { v[j] = xr[64 * j]; s += (v[j][0] + v[j][1]) + (v[j][2] + v[j][3]); }
        const float mean = wave_sum(s) * (1.f / D); float s2 = 0.f;
#pragma unroll
        for (int j = 0; j < 4; ++j) { v[j] = v[j] - mean; s2 += (v[j][0] * v[j][0] + v[j][1] * v[j][1]) + (v[j][2] * v[j][2] + v[j][3] * v[j][3]); }
        const float rstd = 1.f / sqrtf(wave_sum(s2) * (1.f / D) + LN_EPS);
        u32x2* o8 = (u32x2*)(XB + (size_t)m * D) + lane;
#pragma unroll
        for (int j = 0; j < 4; ++j) { const f32x4 y = v[j] * rstd * gv[j] + bv[j]; xr[64 * j] = y; u32x2 w; w.x = pk2(y[0], y[1]); w.y = pk2(y[2], y[3]); o8[64 * j] = w; }
    }
}

namespace peer {
constexpr int WAVE_LDS = 4096;
template <int NV>
__device__ __forceinline__ void top16(const float (&v)[NV], LAS float* oval, LAS int* oidx, int lane) {
    float lmx = v[0], lmn = v[0];
#pragma unroll
    for (int q = 1; q < NV; ++q) { lmx = fmaxf(lmx, v[q]); lmn = fminf(lmn, v[q]); }
    float hi = wave_max(lmx), lo = wave_min(lmn);
    lo = lo - fabsf(lo) * 1e-6f - 1e-30f;
    float thr = hi; int need_ties = 1;
    for (int it = 0; it < 64; ++it) {
        const float mid = 0.5f * (lo + hi);
        if (!(mid > lo && mid < hi)) break;
        int cnt = 0;
#pragma unroll
        for (int q = 0; q < NV; ++q) cnt += __popcll(__ballot(v[q] > mid));
        if (cnt == 16) { thr = mid; need_ties = 0; break; }
        if (cnt > 16) lo = mid; else hi = mid;
    }
    const float tie_hi = hi;
    int base = 0;
    if (!need_ties) {
#pragma unroll
        for (int q = 0; q < NV; ++q) { const bool sel = v[q] > thr; const unsigned long long bm = __ballot(sel);
            const int pos = base + (int)__builtin_amdgcn_mbcnt_hi((unsigned)(bm >> 32), __builtin_amdgcn_mbcnt_lo((unsigned)bm, 0u));
            if (sel) { oval[pos] = v[q]; oidx[pos] = lane + 64 * q; }
            base += __popcll(bm); }
    } else {
#pragma unroll
        for (int q = 0; q < NV; ++q) { const bool sel = v[q] > tie_hi; const unsigned long long bm = __ballot(sel);
            const int pos = base + (int)__builtin_amdgcn_mbcnt_hi((unsigned)(bm >> 32), __builtin_amdgcn_mbcnt_lo((unsigned)bm, 0u));
            if (sel && pos < 16) { oval[pos] = v[q]; oidx[pos] = lane + 64 * q; }
            base += __popcll(bm); }
#pragma unroll
        for (int q = 0; q < NV; ++q) { const bool sel = (v[q] <= tie_hi) && (v[q] > lo); const unsigned long long bm = __ballot(sel);
            const int pos = base + (int)__builtin_amdgcn_mbcnt_hi((unsigned)(bm >> 32), __builtin_amdgcn_mbcnt_lo((unsigned)bm, 0u));
            if (sel && pos < 16) { oval[pos] = v[q]; oidx[pos] = lane + 64 * q; }
            base += __popcll(bm); }
    }
    LDS_WAIT();
}

__device__ __forceinline__ void unpack8(const u32x4 a, float (&f)[8]) {
    f[0] = bflo(a.x); f[1] = bfhi(a.x); f[2] = bflo(a.y); f[3] = bfhi(a.y); f[4] = bflo(a.z); f[5] = bfhi(a.z); f[6] = bflo(a.w); f[7] = bfhi(a.w);
}

__device__ __forceinline__ void token(int t, const float* SC, float* X1  , const bf16_t* UB, const bf16_t* VB, const float* ln_g, const float* ln_b,
                                      LAS unsigned char* wl, int lane) {
    LAS float* s1v = (LAS float*)wl; LAS int* s1i = (LAS int*)(wl + 64); LAS float* s2v = (LAS float*)(wl + 128); LAS int* s2i = (LAS int*)(wl + 192);
    LAS float* cv = (LAS float*)(wl + 256); LAS int* ci = (LAS int*)(wl + 320);
    LAS int* eidx = (LAS int*)(wl + 512); LAS float* gsel = (LAS float*)(wl + 1024); LAS float* wsel = (LAS float*)(wl + 1536);
    const float* sc = SC + (size_t)t * 2048;
    for (int h = 0; h < NHEAD; ++h) {
        float a[2], bq[2];
        a[0] = sc[h * 256 + lane]; a[1] = sc[h * 256 + 64 + lane]; bq[0] = sc[h * 256 + 128 + lane]; bq[1] = sc[h * 256 + 192 + lane];
        top16<2>(a, s1v, s1i, lane);
        top16<2>(bq, s2v, s2i, lane);
        float cand[4];
#pragma unroll
        for (int q = 0; q < 4; ++q) { const int idx = lane + 64 * q; cand[q] = s1v[idx >> 4] + s2v[idx & 15]; }
        top16<4>(cand, cv, ci, lane);
        {
            const float v = cv[lane & 15]; const int code = ci[lane & 15];
            float mx = v;
#pragma unroll
            for (int o = 1; o < 16; o <<= 1) mx = fmaxf(mx, __shfl_xor(mx, o));
            const float e = __expf(v - mx); float sm = e;
#pragma unroll
            for (int o = 1; o < 16; o <<= 1) sm += __shfl_xor(sm, o);
            if (lane < 16) { gsel[h * 16 + lane] = e / sm; eidx[h * 16 + lane] = s1i[code >> 4] * 128 + s2i[code & 15]; }
        }
        LDS_WAIT();
    }
    float xr[16];
    { const f32x4* xp = (const f32x4*)(X1 + (size_t)t * D);
      const f32x4 a0 = xp[2 * lane], a1 = xp[2 * lane + 1], b0 = xp[128 + 2 * lane], b1 = xp[128 + 2 * lane + 1];
#pragma unroll
      for (int i = 0; i < 4; ++i) { xr[i] = a0[i]; xr[4 + i] = a1[i]; xr[8 + i] = b0[i]; xr[12 + i] = b1[i]; } }
    const int hb5 = (lane >> 5) & 1, hb4 = (lane >> 4) & 1, hb3 = (lane >> 3) & 1;
    for (int k0 = 0; k0 < 128; k0 += 8) {
        u32x4 ra[8], rb[8];
#pragma unroll
        for (int e = 0; e < 8; ++e) { const int ei = __builtin_amdgcn_readfirstlane(eidx[k0 + e]); const bf16_t* row = UB + (size_t)ei * D;
            ra[e] = *(const u32x4*)(row + 8 * lane); rb[e] = *(const u32x4*)(row + 512 + 8 * lane); }
        float s[8];
#pragma unroll
        for (int e = 0; e < 8; ++e) { float fa[8], fb[8]; unpack8(ra[e], fa); unpack8(rb[e], fb); float d = 0.f;
#pragma unroll
            for (int i = 0; i < 8; ++i) d += xr[i] * fa[i] + xr[8 + i] * fb[i];
            s[e] = d; }
        float r4[4], r2[2], r1;
#pragma unroll
        for (int i = 0; i < 4; ++i) { const float mine = hb5 ? s[4 + i] : s[i], oth = hb5 ? s[i] : s[4 + i]; r4[i] = mine + __shfl_xor(oth, 32); }
#pragma unroll
        for (int i = 0; i < 2; ++i) { const float mine = hb4 ? r4[2 + i] : r4[i], oth = hb4 ? r4[i] : r4[2 + i]; r2[i] = mine + __shfl_xor(oth, 16); }
        { const float mine = hb3 ? r2[1] : r2[0], oth = hb3 ? r2[0] : r2[1]; r1 = mine + __shfl_xor(oth, 8); }
        r1 += __shfl_xor(r1, 4); r1 += __shfl_xor(r1, 2); r1 += __shfl_xor(r1, 1);
        const int ke = k0 + hb5 * 4 + hb4 * 2 + hb3;
        const float act = 0.5f * r1 * (1.0f + erff(r1 * 0.70710678118654752f));
        if ((lane & 7) == 0) wsel[ke] = gsel[ke] * act;
    }
    LDS_WAIT();
    float acc[16];
#pragma unroll
    for (int i = 0; i < 16; ++i) acc[i] = 0.f;
    for (int k0 = 0; k0 < 128; k0 += 8) {
        u32x4 ra[8], rb[8];
#pragma unroll
        for (int e = 0; e < 8; ++e) { const int ei = __builtin_amdgcn_readfirstlane(eidx[k0 + e]); const bf16_t* row = VB + (size_t)ei * D;
            ra[e] = *(const u32x4*)(row + 8 * lane); rb[e] = *(const u32x4*)(row + 512 + 8 * lane); }
#pragma unroll
        for (int e = 0; e < 8; ++e) { float fa[8], fb[8]; unpack8(ra[e], fa); unpack8(rb[e], fb); const float wk = wsel[k0 + e];
#pragma unroll
            for (int i = 0; i < 8; ++i) { acc[i] += wk * fa[i]; acc[8 + i] += wk * fb[i]; } }
    }
    float s = 0.f;
#pragma unroll
    for (int i = 0; i < 16; ++i) { acc[i] = ALPHA * xr[i] + acc[i]; s += acc[i]; }
    const float mean = wave_sum(s) * (1.f / D); float s2 = 0.f;
#pragma unroll
    for (int i = 0; i < 16; ++i) { acc[i] -= mean; s2 += acc[i] * acc[i]; }
    const float rstd = 1.f / sqrtf(wave_sum(s2) * (1.f / D) + LN_EPS);
    { const f32x4* gp = (const f32x4*)ln_g; const f32x4* bp = (const f32x4*)ln_b; f32x4* op = (f32x4*)(X1 + (size_t)t * D);
      const f32x4 g0 = gp[2 * lane], g1 = gp[2 * lane + 1], g2 = gp[128 + 2 * lane], g3 = gp[128 + 2 * lane + 1];
      const f32x4 b0 = bp[2 * lane], b1 = bp[2 * lane + 1], b2 = bp[128 + 2 * lane], b3 = bp[128 + 2 * lane + 1];
      f32x4 y0, y1, y2, y3;
#pragma unroll
      for (int i = 0; i < 4; ++i) { y0[i] = acc[i] * rstd * g0[i] + b0[i]; y1[i] = acc[4 + i] * rstd * g1[i] + b1[i]; y2[i] = acc[8 + i] * rstd * g2[i] + b2[i]; y3[i] = acc[12 + i] * rstd * g3[i] + b3[i]; }
      op[2 * lane] = y0; op[2 * lane + 1] = y1; op[128 + 2 * lane] = y2; op[128 + 2 * lane + 1] = y3; }
}
}

struct Args {
    const float *x; const int* positions; const float *w_in, *conv_w, *conv_b, *gate_b, *lq1, *lk1, *lq2, *lk2, *subln_g, *w_conv_out, *w_attn_out, *w_o, *ln1_g, *ln1_b, *w_pq, *sub_keys, *u_tab, *v_tab, *ln2_g, *ln2_b;
    float* out; unsigned char* ws; int ph_lo, ph_hi;
};

__global__ void __launch_bounds__(NTHREADS, 2) fwd_kernel(Args a) {
    extern __shared__ __attribute__((aligned(16))) unsigned char lds_raw[];
    LAS unsigned char* lds = (LAS unsigned char*)lds_raw;
    const int tid = threadIdx.x, lane = tid & 63, wave = __builtin_amdgcn_readfirstlane(tid >> 6);
    const int G = gridDim.x, bx = blockIdx.x;
    const int gw = bx * NWAVES + wave, ngw = G * NWAVES, gtid = bx * NTHREADS + tid, gthreads = G * NTHREADS;
    unsigned char* ws = a.ws;
    bf16_t* Wt_in = (bf16_t*)(ws + WS_WIN); bf16_t* Wt_co = (bf16_t*)(ws + WS_WCO); bf16_t* Wt_ao = (bf16_t*)(ws + WS_WAO); bf16_t* Wt_o = (bf16_t*)(ws + WS_WO); bf16_t* Wt_sc = (bf16_t*)(ws + WS_WSC);
    float* CS = (float*)(ws + WS_CS);
    bf16_t* XB = (bf16_t*)(ws + WS_XB); bf16_t* Zb = (bf16_t*)(ws + WS_Z); bf16_t* BG = (bf16_t*)(ws + WS_BG); bf16_t* Qb = (bf16_t*)(ws + WS_Q); bf16_t* Kb = (bf16_t*)(ws + WS_K); bf16_t* Vb = (bf16_t*)(ws + WS_V);
    bf16_t* Gb = (bf16_t*)a.out;
    bf16_t* UB = (bf16_t*)(ws + WS_UB); bf16_t* VB = (bf16_t*)(ws + WS_VB); bf16_t* T1 = (bf16_t*)(ws + WS_T1); bf16_t* MG = (bf16_t*)(ws + WS_MG);
    bf16_t* X1B = (bf16_t*)(ws + WS_X1B); float* SC = (float*)(ws + WS_SC);
    const int lo = a.ph_lo, hi = a.ph_hi;
    cg::grid_group grid = cg::this_grid();
#define IN(k) (lo <= (k) && (k) < hi)
#define SEAM(k) do { if (IN(k) && IN((k) + 1)) grid.sync(); } while (0)

    if (IN(0)) {
        for (int it = bx; it < 256; it += G) wsc_item(a.w_pq, a.sub_keys, Wt_sc, lds, it, tid);
        LAS float* scr = (LAS float*)(lds + wave * 16384);
        constexpr int I_IN = (D / 64) * (NIN / 32), I_SQ = (D / 64) * (D / 32);
        for (int it = gw; it < I_IN + 3 * I_SQ; it += ngw) {
            int r = it;
            if (r < I_IN) { transpose_item<true>(a.w_in, D, NIN, Wt_in, scr, r, lane); continue; } r -= I_IN;
            if (r < I_SQ) { transpose_item<false>(a.w_conv_out, D, D, Wt_co, scr, r, lane); continue; } r -= I_SQ;
            if (r < I_SQ) { transpose_item<false>(a.w_attn_out, D, D, Wt_ao, scr, r, lane); continue; } r -= I_SQ;
            transpose_item<false>(a.w_o, D, D, Wt_o, scr, r, lane);
        }
        cvt_bf16(a.x, XB, (size_t)T * D, gtid, gthreads);
        for (int i = gtid; i < T * 8; i += gthreads) { const int t = i >> 3, f = i & 7;
            const float inv_freq = powf(500000.0f, -(float)f * 0.125f); const float ang = (float)a.positions[t] * inv_freq;
            CS[t * 16 + f] = cosf(ang); CS[t * 16 + 8 + f] = sinf(ang); }
    }
    SEAM(0);
    if (IN(1)) {
        pg8::Gemm g{XB, Wt_in, T, NIN, D}; pg8::StaticOrder S; S.init(T, NIN, G, bx);
        pg8::EpiProj E{Zb, BG, Qb, Kb, Vb, Gb, a.gate_b, CS};
        pg8::gemm_phase<pg8::EpiProj, pg8::StaticOrder, true, true>(lds, g, S, E);
    }
    SEAM(1);
    if (IN(2)) {
        conv_phase(Zb, BG, a.conv_w, a.conv_b, gtid, gthreads);
        float lam;
        { const float p1 = wave_sum(a.lq1[lane] * a.lk1[lane]), p2 = wave_sum(a.lq2[lane] * a.lk2[lane]); lam = __expf(p1) - __expf(p2) + LAM_INIT; }
        for (int it = bx; it < 512; it += G) {
            const int bh = it >> 3, pq = it & 7, b = bh >> 3, h = bh & 7;
            att::attn_unit(b, h, 15 - pq, Qb, Kb, Vb, Qb, a.subln_g, lam, lds, tid);
            att::attn_unit(b, h, pq, Qb, Kb, Vb, Qb, a.subln_g, lam, lds, tid);
        }
    }
    SEAM(2);
    if (IN(3)) {
        cvt_bf16(a.u_tab, UB, (size_t)NEXP * D, gtid, gthreads);
        cvt_bf16(a.v_tab, VB, (size_t)NEXP * D, gtid, gthreads);
        pg8::Gemm g{BG, Wt_co, T, D, D}; pg8::StaticOrder S; S.init(T, D, G, bx);
        pg8::EpiGate1 E{Gb, T1};
        pg8::gemm_phase<pg8::EpiGate1, pg8::StaticOrder, true, true>(lds, g, S, E);
    }
    SEAM(3);
    if (IN(4)) {
        pg8::Gemm g{Qb, Wt_ao, T, D, D}; pg8::StaticOrder S; S.init(T, D, G, bx);
        pg8::EpiGate2 E{Gb, T1, MG};
        pg8::gemm_phase<pg8::EpiGate2, pg8::StaticOrder, true, true>(lds, g, S, E);
    }
    SEAM(4);
    if (IN(5)) {
        pg8::Gemm g{MG, Wt_o, T, D, D}; pg8::StaticOrder S; S.init(T, D, G, bx);
        pg8::EpiF32<true, 1024> E{a.x, a.out};
        pg8::gemm_phase<pg8::EpiF32<true, 1024>, pg8::StaticOrder, true, true>(lds, g, S, E);
    }
    SEAM(5);
    if (IN(6)) ln1_phase(a.out, X1B, a.ln1_g, a.ln1_b, gw, ngw, lane);
    SEAM(6);
    if (IN(7)) {
        pg8::Gemm g{X1B, Wt_sc, T, 2048, D}; pg8::StaticOrder S; S.init(T, 2048, G, bx);
        pg8::EpiF32<false, 2048> E{nullptr, SC};
        pg8::gemm_phase<pg8::EpiF32<false, 2048>, pg8::StaticOrder, true, true>(lds, g, S, E);
    }
    SEAM(7);
    if (IN(8)) {
        LAS unsigned char* wl = lds + wave * peer::WAVE_LDS;
        for (int t = gw; t < T; t += ngw) peer::token(t, SC, a.out, UB, VB, a.ln2_g, a.ln2_b, wl, lane);
    }
#undef IN
#undef SEAM
}

extern "C" void kernel_launch(void* const* d_in, const int* in_sizes, int n_in, void* d_out, int out_size, void* d_ws, size_t ws_size, hipStream_t stream) {
    static int grid = 0;
    if (grid == 0) {
        if (n_in != 22 || out_size != T * D || ws_size < WS_END) { fprintf(stderr, "kernel_launch: unexpected shapes (n_in %d, out %d, ws %zu); nothing launched\n", n_in, out_size, ws_size); grid = -1; return; }
        int dev = 0, cus = 0, per_cu = 0;
        if (hipGetDevice(&dev) != hipSuccess || hipDeviceGetAttribute(&cus, hipDeviceAttributeMultiprocessorCount, dev) != hipSuccess) { grid = -1; return; }
        if (hipFuncSetAttribute((const void*)fwd_kernel, hipFuncAttributeMaxDynamicSharedMemorySize, LDS_BYTES) != hipSuccess) { fprintf(stderr, "kernel_launch: hipFuncSetAttribute failed\n"); grid = -1; return; }
        if (hipOccupancyMaxActiveBlocksPerMultiprocessor(&per_cu, (const void*)fwd_kernel, NTHREADS, LDS_BYTES) != hipSuccess || per_cu < 1) { fprintf(stderr, "kernel_launch: occupancy query failed (%d)\n", per_cu); (void)hipGetLastError(); per_cu = 1; }
        grid = cus * per_cu;
    }
    if (grid < 0) return;
    Args a{};
    a.x = (const float*)d_in[0]; a.positions = (const int*)d_in[1]; a.w_in = (const float*)d_in[2]; a.conv_w = (const float*)d_in[3]; a.conv_b = (const float*)d_in[4]; a.gate_b = (const float*)d_in[5];
    a.lq1 = (const float*)d_in[6]; a.lk1 = (const float*)d_in[7]; a.lq2 = (const float*)d_in[8]; a.lk2 = (const float*)d_in[9]; a.subln_g = (const float*)d_in[10];
    a.w_conv_out = (const float*)d_in[11]; a.w_attn_out = (const float*)d_in[12]; a.w_o = (const float*)d_in[13]; a.ln1_g = (const float*)d_in[14]; a.ln1_b = (const float*)d_in[15];
    a.w_pq = (const float*)d_in[16]; a.sub_keys = (const float*)d_in[17]; a.u_tab = (const float*)d_in[18]; a.v_tab = (const float*)d_in[19]; a.ln2_g = (const float*)d_in[20]; a.ln2_b = (const float*)d_in[21];
    a.out = (float*)d_out; a.ws = (unsigned char*)d_ws;
#if MK_N_LAUNCHES == 1
    a.ph_lo = 0; a.ph_hi = NPHASES;
    void* args[] = {&a};
    hipError_t e = hipLaunchCooperativeKernel((const void*)fwd_kernel, dim3(grid), dim3(NTHREADS), args, LDS_BYTES, stream);
    if (e != hipSuccess) fprintf(stderr, "kernel_launch: cooperative launch failed: %s (grid %d)\n", hipGetErrorString(e), grid);
#else
    for (int p = 0; p < NPHASES; ++p) { a.ph_lo = p; a.ph_hi = p + 1; hipLaunchKernelGGL(fwd_kernel, dim3(grid), dim3(NTHREADS), LDS_BYTES, stream, a); }
#endif
}
```

```cpp
#include <hip/hip_runtime.h>
#include <hip/hip_cooperative_groups.h>
#include <cstdio>
#include <cstdint>
namespace cg = cooperative_groups;
namespace pg8 {
#define PG8_LAS __attribute__((address_space(3)))
typedef unsigned short bf16_t;
typedef short bf16x8 __attribute__((ext_vector_type(8)));
typedef float f32x4 __attribute__((ext_vector_type(4)));
typedef unsigned u32x4 __attribute__((ext_vector_type(4)));
constexpr int BM = 256, BK = 64, HALF = 128, HTB = HALF * BK * 2  , STAGE_BYTES = 8 * HTB, NXCD = 8, WGM = 8;

__host__ __device__ __forceinline__ int lds_byte(int r, int c) { const int st = (r >> 4) * 2 + (c >> 5), rr = r & 15, cc = c & 31, ob = rr * 64 + cc * 2; return st * 1024 + (ob ^ (((ob >> 9) & 1) << 5)); }
__host__ __device__ __forceinline__ void stage_rc(int b, int& R, int& C) { const int st = b / 1024, sb = b % 1024, swz = sb ^ (((sb >> 9) & 1) << 5); R = (st >> 1) * 16 + swz / 64; C = (st & 1) * 32 + (swz % 64) / 2; }
__host__ __device__ __forceinline__ int perm32(int rho) { const int n = rho >> 4, i = rho & 15; return 8 * (i >> 2) + 4 * n + (i & 3); }

struct Unit { int pm, pn; };
struct Gemm { const bf16_t* A; const bf16_t* Bt; int M, N, K; };

struct StaticOrder {
    int nM, nN, nwg, G, c;
    __host__ __device__ void init(int M, int N, int G_, int c_) { nM = M / BM; nN = N / BM; nwg = nM * nN; G = G_; c = c_; }
    __host__ __device__ bool next(int i, Unit& u) const {
        const long L = (long)i * G + c; if (L >= nwg) return false;
        int wgid = (int)L; { const int q = nwg / NXCD, r = nwg % NXCD, xcd = wgid % NXCD, off = wgid / NXCD; wgid = (xcd < r ? xcd * (q + 1) : r * (q + 1) + (xcd - r) * q) + off; }
        const int nig = WGM * nN, gid = wgid / nig, fm = gid * WGM, gsz = (nM - fm) < WGM ? (nM - fm) : WGM;
        u.pm = fm + ((wgid % nig) % gsz); u.pn = (wgid % nig) / gsz; return true;
    }
    __device__ __forceinline__ void a_ready(const Unit&) const {}
    __device__ __forceinline__ void done(const Unit&) const {}
};


__device__ __forceinline__ unsigned cvt_pk_bf16(float lo, float hi) { unsigned r; asm volatile("v_cvt_pk_bf16_f32 %0, %1, %2" : "=v"(r) : "v"(lo), "v"(hi)); return r; }
__device__ __forceinline__ void store8(bf16_t* p, f32x4 v0, f32x4 v1) {
    u32x4 w; w.x = cvt_pk_bf16(v0[0], v0[1]); w.y = cvt_pk_bf16(v0[2], v0[3]); w.z = cvt_pk_bf16(v1[0], v1[1]); w.w = cvt_pk_bf16(v1[2], v1[3]);
    *(u32x4*)p = w;
}
__device__ __forceinline__ void load8(const bf16_t* p, f32x4& v0, f32x4& v1) {
    const u32x4 w = *(const u32x4*)p;
    v0[0] = __uint_as_float(w.x << 16); v0[1] = __uint_as_float(w.x & 0xffff0000u); v0[2] = __uint_as_float(w.y << 16); v0[3] = __uint_as_float(w.y & 0xffff0000u);
    v1[0] = __uint_as_float(w.z << 16); v1[1] = __uint_as_float(w.z & 0xffff0000u); v1[2] = __uint_as_float(w.w << 16); v1[3] = __uint_as_float(w.w & 0xffff0000u);
}
constexpr float QSCALE = 0.125f * 1.4426950408889634f;

struct EpiProj {
    static constexpr bool PERM = true, AFTER_DRAIN = false;
    bf16_t *Z, *BG, *Q, *Kk, *V, *G; const float* gate_b; const float* CS;
    __device__ __forceinline__ void operator()(const f32x4 (&acc)[2][2][4][2], const Unit& u, int wr, int wc, int fr, int fq) const {
        const int row0 = u.pm * BM + wr * 64 + fr, pn = u.pn, cw = wc * 32 + 8 * fq;
        if (pn < 8) {
#pragma unroll
            for (int ai = 0; ai < 2; ++ai)
#pragma unroll
                for (int m = 0; m < 4; ++m) { const size_t row = row0 + ai * HALF + m * 16;
                    store8(Z + row * 1024 + pn * 128 + cw, acc[ai][0][m][0] * acc[ai][1][m][0], acc[ai][0][m][1] * acc[ai][1][m][1]); }
        } else if (pn < 12) {
#pragma unroll
            for (int ai = 0; ai < 2; ++ai)
#pragma unroll
                for (int m = 0; m < 4; ++m) { const size_t row = row0 + ai * HALF + m * 16;
#pragma unroll
                    for (int bj = 0; bj < 2; ++bj) store8(BG + row * 1024 + (pn - 8) * 256 + bj * HALF + cw, acc[ai][bj][m][0], acc[ai][bj][m][1]); }
        } else if (pn < 20) {
            const bool isq = pn < 16; bf16_t* dst = isq ? Q : Kk; const int cb = ((pn - 12) & 3) * 256; const float sc = isq ? QSCALE : 1.0f;
            const bool rot = ((wc & 1) == 0) && (fq < 2);
#pragma unroll
            for (int ai = 0; ai < 2; ++ai)
#pragma unroll
                for (int m = 0; m < 4; ++m) { const size_t row = row0 + ai * HALF + m * 16;
                    f32x4 c4 = *(const f32x4*)(CS + row * 16 + 4 * (fq & 1)), s4 = *(const f32x4*)(CS + row * 16 + 8 + 4 * (fq & 1));
                    if (!rot) { c4 = (f32x4){1.f, 1.f, 1.f, 1.f}; s4 = (f32x4){0.f, 0.f, 0.f, 0.f}; }
#pragma unroll
                    for (int bj = 0; bj < 2; ++bj) { const f32x4 v0 = acc[ai][bj][m][0], v1 = acc[ai][bj][m][1]; f32x4 o0, o1;
                        o0[0] = v0[0] * c4[0] - v0[1] * s4[0]; o0[1] = v0[1] * c4[0] + v0[0] * s4[0];
                        o0[2] = v0[2] * c4[1] - v0[3] * s4[1]; o0[3] = v0[3] * c4[1] + v0[2] * s4[1];
                        o1[0] = v1[0] * c4[2] - v1[1] * s4[2]; o1[1] = v1[1] * c4[2] + v1[0] * s4[2];
                        o1[2] = v1[2] * c4[3] - v1[3] * s4[3]; o1[3] = v1[3] * c4[3] + v1[2] * s4[3];
                        store8(dst + row * 1024 + cb + bj * HALF + cw, o0 * sc, o1 * sc); } }
        } else if (pn < 24) {
#pragma unroll
            for (int ai = 0; ai < 2; ++ai)
#pragma unroll
                for (int m = 0; m < 4; ++m) { const size_t row = row0 + ai * HALF + m * 16;
#pragma unroll
                    for (int bj = 0; bj < 2; ++bj) store8(V + row * 1024 + (pn - 20) * 256 + bj * HALF + cw, acc[ai][bj][m][0], acc[ai][bj][m][1]); }
        } else {
            f32x4 bv[2][2];
#pragma unroll
            for (int bj = 0; bj < 2; ++bj)
#pragma unroll
                for (int n = 0; n < 2; ++n) bv[bj][n] = *(const f32x4*)(gate_b + (pn - 24) * 256 + bj * HALF + cw + 4 * n);
#pragma unroll
            for (int ai = 0; ai < 2; ++ai)
#pragma unroll
                for (int m = 0; m < 4; ++m) { const size_t row = row0 + ai * HALF + m * 16;
#pragma unroll
                    for (int bj = 0; bj < 2; ++bj) { f32x4 g0 = acc[ai][bj][m][0] + bv[bj][0], g1 = acc[ai][bj][m][1] + bv[bj][1];
#pragma unroll
                        for (int i = 0; i < 4; ++i) { g0[i] = 1.0f / (1.0f + __expf(-g0[i])); g1[i] = 1.0f / (1.0f + __expf(-g1[i])); }
                        store8(G + row * 2048 + (pn - 24) * 256 + bj * HALF + cw, g0, g1); } }
        }
    }
};
struct EpiGate1 {
    static constexpr bool PERM = true, AFTER_DRAIN = false;
    const bf16_t* G; bf16_t* T1;
    __device__ __forceinline__ void operator()(const f32x4 (&acc)[2][2][4][2], const Unit& u, int wr, int wc, int fr, int fq) const {
        const int row0 = u.pm * BM + wr * 64 + fr, col0 = u.pn * BM + wc * 32 + 8 * fq;
#pragma unroll
        for (int ai = 0; ai < 2; ++ai)
#pragma unroll
            for (int m = 0; m < 4; ++m) { const size_t row = row0 + ai * HALF + m * 16;
#pragma unroll
                for (int bj = 0; bj < 2; ++bj) { f32x4 g0, g1; load8(G + row * 2048 + col0 + bj * HALF, g0, g1);
                    store8(T1 + row * 1024 + col0 + bj * HALF, acc[ai][bj][m][0] * g0, acc[ai][bj][m][1] * g1); } }
    }
};
struct EpiGate2 {
    static constexpr bool PERM = true, AFTER_DRAIN = false;
    const bf16_t* G; const bf16_t* T1; bf16_t* MG;
    __device__ __forceinline__ void operator()(const f32x4 (&acc)[2][2][4][2], const Unit& u, int wr, int wc, int fr, int fq) const {
        const int row0 = u.pm * BM + wr * 64 + fr, col0 = u.pn * BM + wc * 32 + 8 * fq;
#pragma unroll
        for (int ai = 0; ai < 2; ++ai)
#pragma unroll
            for (int m = 0; m < 4; ++m) { const size_t row = row0 + ai * HALF + m * 16;
#pragma unroll
                for (int bj = 0; bj < 2; ++bj) { f32x4 g0, g1, t0, t1; load8(G + row * 2048 + 1024 + col0 + bj * HALF, g0, g1); load8(T1 + row * 1024 + col0 + bj * HALF, t0, t1);
                    store8(MG + row * 1024 + col0 + bj * HALF, t0 + acc[ai][bj][m][0] * g0, t1 + acc[ai][bj][m][1] * g1); } }
    }
};
template <bool HAS_BASE, int ldc> struct EpiF32 {
    static constexpr bool PERM = false, AFTER_DRAIN = false;
    static constexpr float alpha = 1.189207115002721f;
    const float* base; float* O;
    __device__ __forceinline__ void operator()(const f32x4 (&acc)[2][2][4][2], const Unit& u, int wr, int wc, int fr, int fq) const {
        const int row0 = u.pm * BM + wr * 64 + fr, col0 = u.pn * BM + wc * 32 + 4 * fq;
#pragma unroll
        for (int ai = 0; ai < 2; ++ai)
#pragma unroll
            for (int m = 0; m < 4; ++m) { const size_t row = row0 + ai * HALF + m * 16;
#pragma unroll
                for (int bj = 0; bj < 2; ++bj)
#pragma unroll
                    for (int n = 0; n < 2; ++n) { const size_t o = row * ldc + col0 + bj * HALF + n * 16; f32x4 v = acc[ai][bj][m][n];
                        if constexpr (HAS_BASE) v = v + alpha * *(const f32x4*)(base + o);
                        *(f32x4*)(O + o) = v; } }
    }
};

template <class Epi, class Sched, bool ALIGN_EPI = false, bool SP2 = false>
__device__ __forceinline__ void gemm_phase(PG8_LAS unsigned char* lds, const Gemm g, const Sched& S, const Epi& E) {
    const int tid = threadIdx.x, wid = __builtin_amdgcn_readfirstlane(tid >> 6), lane = tid & 63, wr = wid >> 2, wc = wid & 3, fr = lane & 15, fq = lane >> 4;
    const int K = g.K, nt = K / BK;
    unsigned voffA[2], voffB[2];
#pragma unroll
    for (int i = 0; i < 2; ++i) { int R, C; stage_rc(tid * 16 + i * 8192, R, C); const int Rb = Epi::PERM ? ((R & ~31) + perm32(R & 31)) : R;
        voffA[i] = (unsigned)(R * K + C) * 2u; voffB[i] = (unsigned)(Rb * K + C) * 2u; }
    const size_t kstep = (size_t)(BK * 2);
    const size_t hstep = (size_t)HALF * K * 2;
    const size_t tstep = 2 * hstep;
    const unsigned ldsw = (unsigned)wid * 1024u;
    const int aoff = lds_byte(wr * 64 + fr, fq * 8), boff = lds_byte(wc * 32 + fr, fq * 8);
#define PG8_SA(b, h) (((b) * 2 + (h)) * HTB)
#define PG8_SB(b, h) ((4 + (b) * 2 + (h)) * HTB)
#define PG8_STAGE(bufoff, gbase, voff) do { _Pragma("unroll") for (int _i = 0; _i < 2; ++_i) \
        __builtin_amdgcn_global_load_lds((const unsigned*)((const char*)(gbase) + (voff)[_i]), (PG8_LAS unsigned*)(lds + (bufoff) + ldsw + _i * 8192), 16, 0, 0); } while (0)
#define PG8_LDA(dst, b, h) do { _Pragma("unroll") for (int m = 0; m < 4; ++m) _Pragma("unroll") for (int k = 0; k < 2; ++k) dst[m][k] = *(const PG8_LAS bf16x8*)(lds + PG8_SA(b, h) + aoff + m * 2048 + k * 1024); } while (0)
#define PG8_LDB(dst, b, h) do { _Pragma("unroll") for (int n = 0; n < 2; ++n) _Pragma("unroll") for (int k = 0; k < 2; ++k) dst[n][k] = *(const PG8_LAS bf16x8*)(lds + PG8_SB(b, h) + boff + n * 2048 + k * 1024); } while (0)
#define PG8_MMA(ai, bj, At, Bt) do { __builtin_amdgcn_s_setprio(1); _Pragma("unroll") for (int m = 0; m < 4; ++m) _Pragma("unroll") for (int n = 0; n < 2; ++n) _Pragma("unroll") for (int k = 0; k < 2; ++k) \
        acc[ai][bj][m][n] = __builtin_amdgcn_mfma_f32_16x16x32_bf16(Bt[n][k], At[m][k], acc[ai][bj][m][n], 0, 0, 0); __builtin_amdgcn_s_setprio(0); } while (0)
#define PG8_WAIT_V(n) asm volatile("s_waitcnt vmcnt(" #n ")" ::: "memory")
#define PG8_WAIT_L(n) asm volatile("s_waitcnt lgkmcnt(" #n ")" ::: "memory")
#define PG8_BAR __builtin_amdgcn_s_barrier()
#define PG8_SCHED __builtin_amdgcn_sched_barrier(0)
    Unit cur, nxt; int ui = 0;
    if (!S.next(0, cur)) return;
    f32x4 acc[2][2][4][2];
#pragma unroll
    for (int a = 0; a < 2; ++a)
#pragma unroll
        for (int b = 0; b < 2; ++b)
#pragma unroll
            for (int m = 0; m < 4; ++m)
#pragma unroll
                for (int n = 0; n < 2; ++n) acc[a][b][m][n] = (f32x4){0.f, 0.f, 0.f, 0.f};
    bf16x8 At[4][2], B0[2][2], B1[2][2];
    const char* cA = (const char*)g.A + (size_t)cur.pm * tstep; const char* cB = (const char*)g.Bt + (size_t)cur.pn * tstep;
    S.a_ready(cur);
    if constexpr (SP2) {
        PG8_STAGE(PG8_SB(0, 0), cB, voffB); PG8_STAGE(PG8_SB(0, 1), cB + hstep, voffB); PG8_STAGE(PG8_SA(0, 0), cA, voffA); PG8_STAGE(PG8_SA(0, 1), cA + hstep, voffA);
        if (wr == 1) PG8_BAR;
        PG8_WAIT_V(2); PG8_BAR;
        PG8_STAGE(PG8_SB(1, 0), cB + kstep, voffB); PG8_STAGE(PG8_SA(1, 0), cA + kstep, voffA); PG8_STAGE(PG8_SB(1, 1), cB + hstep + kstep, voffB);
        PG8_WAIT_V(6); PG8_BAR;
    } else {
        PG8_STAGE(PG8_SB(0, 0), cB, voffB); PG8_STAGE(PG8_SA(0, 0), cA, voffA); PG8_STAGE(PG8_SB(0, 1), cB + hstep, voffB); PG8_STAGE(PG8_SA(0, 1), cA + hstep, voffA);
        if (wr == 1) PG8_BAR;
        PG8_WAIT_V(4); PG8_BAR;
        PG8_STAGE(PG8_SB(1, 0), cB + kstep, voffB); PG8_STAGE(PG8_SA(1, 0), cA + kstep, voffA); PG8_STAGE(PG8_SB(1, 1), cB + hstep + kstep, voffB);
        PG8_WAIT_V(6); PG8_BAR;
    }
    for (;;) {
        const bool has_next = S.next(ui + 1, nxt);
        const char* nA = has_next ? (const char*)g.A + (size_t)nxt.pm * tstep : cA; const char* nB = has_next ? (const char*)g.Bt + (size_t)nxt.pn * tstep : cB;
        for (int t = 0; t < nt; t += 2) {
            const bool last = (t == nt - 2);
            const char* a1 = cA + (size_t)(t + 1) * kstep;
            const char* a2 = last ? nA : cA + (size_t)(t + 2) * kstep; const char* b2 = last ? nB : cB + (size_t)(t + 2) * kstep;
            const char* a3 = a2 + kstep; const char* b3 = b2 + kstep;
            if (last && has_next) S.a_ready(nxt);
            if constexpr (SP2) {
            PG8_LDB(B0, 0, 0); PG8_LDB(B1, 0, 1); PG8_SCHED; PG8_LDA(At, 0, 0); PG8_STAGE(PG8_SA(1, 1), a1 + hstep, voffA);
            PG8_WAIT_V(8); PG8_WAIT_L(0); PG8_BAR; PG8_MMA(0, 0, At, B0); PG8_MMA(0, 1, At, B1); PG8_BAR; PG8_SCHED;
            PG8_LDA(At, 0, 1); PG8_STAGE(PG8_SB(0, 0), b2, voffB); PG8_STAGE(PG8_SB(0, 1), b2 + hstep, voffB); PG8_STAGE(PG8_SA(0, 0), a2, voffA);
            PG8_WAIT_V(8); PG8_WAIT_L(0); PG8_BAR; PG8_MMA(1, 0, At, B0); PG8_MMA(1, 1, At, B1); PG8_BAR; PG8_SCHED;
            PG8_LDB(B0, 1, 0); PG8_LDB(B1, 1, 1); PG8_SCHED; PG8_LDA(At, 1, 0); PG8_STAGE(PG8_SA(0, 1), a2 + hstep, voffA);
            PG8_WAIT_V(8); PG8_WAIT_L(0); PG8_BAR; PG8_MMA(0, 0, At, B0); PG8_MMA(0, 1, At, B1); PG8_BAR; PG8_SCHED;
            PG8_LDA(At, 1, 1); PG8_STAGE(PG8_SB(1, 0), b3, voffB); PG8_STAGE(PG8_SB(1, 1), b3 + hstep, voffB); PG8_STAGE(PG8_SA(1, 0), a3, voffA);
            PG8_WAIT_V(8); PG8_WAIT_L(0); PG8_BAR; PG8_MMA(1, 0, At, B0); PG8_MMA(1, 1, At, B1); PG8_BAR; PG8_SCHED;
            } else {
            PG8_LDB(B0, 0, 0); PG8_SCHED; PG8_LDA(At, 0, 0); PG8_STAGE(PG8_SA(1, 1), a1 + hstep, voffA);
            PG8_WAIT_L(8); PG8_BAR; PG8_WAIT_L(0); PG8_MMA(0, 0, At, B0); PG8_BAR; PG8_SCHED;
            PG8_LDB(B1, 0, 1); PG8_STAGE(PG8_SB(0, 0), b2, voffB);
            PG8_BAR; PG8_WAIT_L(0); PG8_MMA(0, 1, At, B1); PG8_BAR;
            PG8_LDA(At, 0, 1); PG8_STAGE(PG8_SA(0, 0), a2, voffA);
            PG8_BAR; PG8_WAIT_L(0); PG8_MMA(1, 0, At, B0); PG8_BAR; PG8_SCHED;
            PG8_STAGE(PG8_SB(0, 1), b2 + hstep, voffB);
            PG8_WAIT_V(6); PG8_BAR; PG8_MMA(1, 1, At, B1); PG8_BAR;
            PG8_LDB(B0, 1, 0); PG8_SCHED; PG8_LDA(At, 1, 0); PG8_STAGE(PG8_SA(0, 1), a2 + hstep, voffA);
            PG8_WAIT_L(8); PG8_BAR; PG8_WAIT_L(0); PG8_MMA(0, 0, At, B0); PG8_BAR; PG8_SCHED;
            PG8_LDB(B1, 1, 1); PG8_STAGE(PG8_SB(1, 0), b3, voffB);
            PG8_BAR; PG8_WAIT_L(0); PG8_MMA(0, 1, At, B1); PG8_BAR;
            PG8_LDA(At, 1, 1); PG8_STAGE(PG8_SA(1, 0), a3, voffA);
            PG8_BAR; PG8_WAIT_L(0); PG8_MMA(1, 0, At, B0); PG8_BAR; PG8_SCHED;
            PG8_STAGE(PG8_SB(1, 1), b3 + hstep, voffB);
            PG8_WAIT_V(6); PG8_BAR; PG8_MMA(1, 1, At, B1); PG8_BAR;
            }
        }
        if constexpr (ALIGN_EPI) { if (wr == 0) PG8_BAR; }
        if constexpr (!Epi::AFTER_DRAIN) { E(acc, cur, wr, wc, fr, fq); S.done(cur); }
        if (!has_next) break;
#pragma unroll
        for (int a = 0; a < 2; ++a)
#pragma unroll
            for (int b = 0; b < 2; ++b)
#pragma unroll
                for (int m = 0; m < 4; ++m)
#pragma unroll
                    for (int n = 0; n < 2; ++n) acc[a][b][m][n] = (f32x4){0.f, 0.f, 0.f, 0.f};
        cur = nxt; cA = nA; cB = nB; ++ui;
        if constexpr (ALIGN_EPI) { if (wr == 1) PG8_BAR; }
    }
    PG8_WAIT_V(0);
    if constexpr (!ALIGN_EPI) { if (wr == 0) PG8_BAR; }
    PG8_BAR;
    if constexpr (Epi::AFTER_DRAIN) { E.fused(acc, cur, wr, wc, fr, fq, lds, wid, lane); S.done(cur); }
#undef PG8_SA
#undef PG8_SB
#undef PG8_STAGE
#undef PG8_LDA
#undef PG8_LDB
#undef PG8_MMA
#undef PG8_WAIT_V
#undef PG8_WAIT_L
#undef PG8_BAR
#undef PG8_SCHED
}
}

constexpr int T = 16384, D = 1024, SEQ = 2048, NBATCH = 8, NIN = 8192;
constexpr int NHEAD = 8, NEXP = 16384;
constexpr float LN_EPS = 1e-5f;
constexpr float ALPHA = 1.189207115002721f;
constexpr float LAM_INIT = 0.2f;
constexpr int NWAVES = 8, NTHREADS = 512;
constexpr int LDS_BYTES = 147456;
constexpr int NPHASES = 9;
#ifndef MK_N_LAUNCHES
#define MK_N_LAUNCHES 1
#endif

typedef unsigned short bf16_t;
typedef short bf16x8 __attribute__((ext_vector_type(8)));
typedef short s16x4 __attribute__((ext_vector_type(4)));
typedef float f32x4 __attribute__((ext_vector_type(4)));
typedef float f32x16 __attribute__((ext_vector_type(16)));
typedef unsigned u32x4 __attribute__((ext_vector_type(4)));
typedef unsigned u32x2 __attribute__((ext_vector_type(2)));
#define LAS __attribute__((address_space(3)))
#define LDS_WAIT() asm volatile("s_waitcnt lgkmcnt(0)" ::: "memory")

constexpr size_t MiB = 1u << 20;
constexpr size_t WS_CTL = 0, WS_CS = 1 * MiB, WS_WCO = 2 * MiB, WS_WAO = 4 * MiB, WS_WO = 6 * MiB, WS_WSC = 8 * MiB;
constexpr size_t WS_WIN = 12 * MiB, WS_XB = 28 * MiB, WS_Z = 60 * MiB, WS_BG = 92 * MiB, WS_Q = 124 * MiB, WS_K = 156 * MiB, WS_V = 188 * MiB;
constexpr size_t WS_UB = 12 * MiB, WS_VB = 44 * MiB;
constexpr size_t WS_T1 = 156 * MiB, WS_MG = 188 * MiB;
constexpr size_t WS_X1B = 76 * MiB;
constexpr size_t WS_SC = 124 * MiB;
constexpr size_t WS_END = 252 * MiB;

__device__ __forceinline__ unsigned f2bf(float f) { unsigned u = __builtin_bit_cast(unsigned, f); return (u + 0x7fffu + ((u >> 16) & 1u)) >> 16; }
__device__ __forceinline__ unsigned pk2(float lo, float hi) { return f2bf(lo) | (f2bf(hi) << 16); }
__device__ __forceinline__ float bflo(unsigned w) { return __uint_as_float(w << 16); }
__device__ __forceinline__ float bfhi(unsigned w) { return __uint_as_float(w & 0xffff0000u); }
__device__ __forceinline__ float wave_sum(float v) {
#pragma unroll
    for (int o = 1; o < 64; o <<= 1) v += __shfl_xor(v, o);
    return v;
}
__device__ __forceinline__ float wave_max(float v) {
#pragma unroll
    for (int o = 1; o < 64; o <<= 1) v = fmaxf(v, __shfl_xor(v, o));
    return v;
}
__device__ __forceinline__ float wave_min(float v) {
#pragma unroll
    for (int o = 1; o < 64; o <<= 1) v = fminf(v, __shfl_xor(v, o));
    return v;
}

__device__ __forceinline__ int win_src(int n) {
    if (n < 2048) { const int i = n >> 8, r = n & 255; return r < 128 ? 128 * i + r : 2048 + 128 * i + (r - 128); }
    if (n < 3072) return 1024 + (n - 2048);
    if (n < 5120) { const int base = n - 3072, which = base >> 10, within = base & 1023, map = within >> 6, p = within & 63; const int d = p < 16 ? (p >> 1) + 8 * (p & 1) : p; return 3072 + which * 1024 + map * 64 + d; }
    return n;
}
template <bool PERMUTE>
__device__ __forceinline__ void transpose_item(const float* W, int K, int N, bf16_t* WT, LAS float* scr, int item, int lane) {
    const int nblk = N / 32, kb = item / nblk, nb = item % nblk, k0 = 64 * kb, n0 = 32 * nb;
    const int nsrc = PERMUTE ? win_src(n0 + (lane & 31)) : n0 + (lane & 31);
#pragma unroll 8
    for (int i = 0; i < 32; ++i) { const int kk = 2 * i + (lane >> 5); scr[kk * 33 + (lane & 31)] = W[(size_t)(k0 + kk) * N + nsrc]; }
    LDS_WAIT();
    const int c = lane & 7;
#pragma unroll
    for (int j = 0; j < 4; ++j) { const int n = (lane >> 3) + 8 * j; const LAS float* s = scr + (8 * c) * 33 + n;
        u32x4 o; o.x = pk2(s[0 * 33], s[1 * 33]); o.y = pk2(s[2 * 33], s[3 * 33]); o.z = pk2(s[4 * 33], s[5 * 33]); o.w = pk2(s[6 * 33], s[7 * 33]);
        *(u32x4*)(WT + (size_t)(n0 + n) * K + k0 + 8 * c) = o; }
    LDS_WAIT();
}
__device__ __forceinline__ void cvt_bf16(const float* src, bf16_t* dst, size_t n, int gtid, int gthreads) {
    const size_t n8 = n / 8;
    for (size_t i = gtid; i < n8; i += gthreads) {
        const f32x4 a = *(const f32x4*)(src + i * 8), b = *(const f32x4*)(src + i * 8 + 4);
        u32x4 o; o.x = pk2(a[0], a[1]); o.y = pk2(a[2], a[3]); o.z = pk2(b[0], b[1]); o.w = pk2(b[2], b[3]);
        *(u32x4*)(dst + i * 8) = o;
    }
}
__device__ __forceinline__ void wsc_item(const float* w_pq, const float* sub_keys, bf16_t* Wsc, LAS unsigned char* lds, int item, int tid) {
    const int hc = item >> 4, d0 = (item & 15) * 64;
    LAS float* kl = (LAS float*)lds; LAS float* wl = (LAS float*)(lds + 67584);
    for (int i = tid; i < 128 * 32; i += NTHREADS) { const int n = i >> 5, j4 = (i & 31) * 4; *(LAS f32x4*)(kl + n * 132 + j4) = *(const f32x4*)(sub_keys + ((size_t)hc * 128 + n) * 128 + j4); }
    for (int i = tid; i < 64 * 32; i += NTHREADS) { const int dd = i >> 5, j4 = (i & 31) * 4; *(LAS f32x4*)(wl + dd * 128 + j4) = *(const f32x4*)(w_pq + (size_t)(d0 + dd) * 2048 + hc * 128 + j4); }
    __syncthreads();
    const int n = tid & 127, dq = tid >> 7;
    float acc[16];
#pragma unroll
    for (int i = 0; i < 16; ++i) acc[i] = 0.f;
    for (int j4 = 0; j4 < 128; j4 += 4) {
        const f32x4 kv = *(const LAS f32x4*)(kl + n * 132 + j4);
#pragma unroll
        for (int i = 0; i < 16; ++i) { const f32x4 wv = *(const LAS f32x4*)(wl + (dq * 16 + i) * 128 + j4); acc[i] += kv[0] * wv[0] + kv[1] * wv[1] + kv[2] * wv[2] + kv[3] * wv[3]; }
    }
    u32x4 o0, o1;
    o0.x = pk2(acc[0], acc[1]); o0.y = pk2(acc[2], acc[3]); o0.z = pk2(acc[4], acc[5]); o0.w = pk2(acc[6], acc[7]);
    o1.x = pk2(acc[8], acc[9]); o1.y = pk2(acc[10], acc[11]); o1.z = pk2(acc[12], acc[13]); o1.w = pk2(acc[14], acc[15]);
    bf16_t* dst = Wsc + (size_t)(hc * 128 + n) * 1024 + d0 + dq * 16;
    *(u32x4*)dst = o0; *(u32x4*)(dst + 8) = o1;
    __syncthreads();
}

__device__ __forceinline__ void conv_phase(const bf16_t* Z, bf16_t* BG, const float* conv_w, const float* conv_b, int gtid, int gthreads) {
    for (int it = gtid; it < (T / 16) * 128; it += gthreads) {
        const int rb = it >> 7, cc = it & 127, t0 = rb * 16, c0 = cc * 8;
        float w0[8], w1[8], w2[8], cb[8];
#pragma unroll
        for (int i = 0; i < 8; ++i) { w0[i] = conv_w[c0 + i]; w1[i] = conv_w[1024 + c0 + i]; w2[i] = conv_w[2048 + c0 + i]; cb[i] = conv_b[c0 + i]; }
        float zm2[8], zm1[8];
        if ((t0 & (SEQ - 1)) != 0) {
            const u32x4 a = *(const u32x4*)(Z + (size_t)(t0 - 2) * 1024 + c0), b = *(const u32x4*)(Z + (size_t)(t0 - 1) * 1024 + c0);
            zm2[0] = bflo(a.x); zm2[1] = bfhi(a.x); zm2[2] = bflo(a.y); zm2[3] = bfhi(a.y); zm2[4] = bflo(a.z); zm2[5] = bfhi(a.z); zm2[6] = bflo(a.w); zm2[7] = bfhi(a.w);
            zm1[0] = bflo(b.x); zm1[1] = bfhi(b.x); zm1[2] = bflo(b.y); zm1[3] = bfhi(b.y); zm1[4] = bflo(b.z); zm1[5] = bfhi(b.z); zm1[6] = bflo(b.w); zm1[7] = bfhi(b.w);
        } else {
#pragma unroll
            for (int i = 0; i < 8; ++i) { zm2[i] = 0.f; zm1[i] = 0.f; }
        }
#pragma unroll 4
        for (int r = 0; r < 16; ++r) {
            const size_t o = (size_t)(t0 + r) * 1024 + c0;
            const u32x4 a = *(const u32x4*)(Z + o), g = *(const u32x4*)(BG + o);
            float z[8], bgv[8], y[8];
            z[0] = bflo(a.x); z[1] = bfhi(a.x); z[2] = bflo(a.y); z[3] = bfhi(a.y); z[4] = bflo(a.z); z[5] = bfhi(a.z); z[6] = bflo(a.w); z[7] = bfhi(a.w);
            bgv[0] = bflo(g.x); bgv[1] = bfhi(g.x); bgv[2] = bflo(g.y); bgv[3] = bfhi(g.y); bgv[4] = bflo(g.z); bgv[5] = bfhi(g.z); bgv[6] = bflo(g.w); bgv[7] = bfhi(g.w);
#pragma unroll
            for (int i = 0; i < 8; ++i) { y[i] = bgv[i] * (cb[i] + w0[i] * zm2[i] + w1[i] * zm1[i] + w2[i] * z[i]); zm2[i] = zm1[i]; zm1[i] = z[i]; }
            u32x4 ov; ov.x = pk2(y[0], y[1]); ov.y = pk2(y[2], y[3]); ov.z = pk2(y[4], y[5]); ov.w = pk2(y[6], y[7]);
            *(u32x4*)(BG + o) = ov;
        }
    }
}

namespace att {
constexpr int STAGE = 32768;
constexpr int XCH_OFF = 65536;
__device__ __forceinline__ int crow(int r, int hi) { return (r & 3) + 8 * (r >> 2) + 4 * hi; }
__device__ __forceinline__ s16x4 vtr(const LAS unsigned char* p) { return __builtin_bit_cast(s16x4, __builtin_amdgcn_ds_read_tr16_b64_v4i16((LAS s16x4*)p)); }

__device__ __forceinline__ void attn_unit(int b, int h, int qblk, const bf16_t* Q, const bf16_t* Kg, const bf16_t* Vg, bf16_t* O, const float* subln_g, float lam,
                                          LAS unsigned char* lds, int tid) {
    const int lane = tid & 63, wid = __builtin_amdgcn_readfirstlane(tid >> 6), rg = wid >> 1, c = wid & 1, r = lane & 31, hh = lane >> 5;
    const size_t seq0 = (size_t)b * SEQ;
    const int qs = qblk * 128 + rg * 32;
    bf16x8 qf[4];
    { const bf16_t* qp = Q + (seq0 + qs + r) * 1024 + h * 128 + c * 64 + 8 * hh;
#pragma unroll
      for (int ks = 0; ks < 4; ++ks) qf[ks] = *(const bf16x8*)(qp + 16 * ks); }
    const int kkey = tid >> 3, kch = tid & 7;
    const unsigned kdst = (unsigned)(kkey * 128 + ((kch ^ ((kkey >> 1) & 7)) * 16));
    const int v0key = tid >> 4, vch = tid & 15;
    const unsigned vdst0 = (unsigned)(v0key * 256 + (((vch >> 2) ^ (v0key & 3)) * 64) + (vch & 3) * 16);
    const unsigned vdst1 = vdst0 + 32 * 256;
    const bf16_t* kbase = Kg + seq0 * 1024 + h * 128 + kch * 8;
    const bf16_t* vbase = Vg + seq0 * 1024 + h * 128 + vch * 8;
    const int kswz = (r >> 1) & 7;
    unsigned koff[4];
#pragma unroll
    for (int ks = 0; ks < 4; ++ks) koff[ks] = (unsigned)(c * 8192 + r * 128 + (((ks * 2 + hh) ^ kswz) * 16));
    const int i16 = lane & 15, vq = i16 >> 2, vp = i16 & 3, g16 = (lane >> 4) & 1;
    unsigned voff[4];
#pragma unroll
    for (int dt = 0; dt < 4; ++dt) voff[dt] = (unsigned)(16384 + (4 * hh + vq) * 256 + ((dt ^ vq) * 64) + (16 * g16 + 4 * vp) * 2);

    f32x16 o[4];
#pragma unroll
    for (int dt = 0; dt < 4; ++dt)
#pragma unroll
        for (int i = 0; i < 16; ++i) o[dt][i] = 0.f;
    float mrun = -1e30f, lrun = 0.f;
    const int nt = 2 * qblk + 2;
    const int jmax = (qs + 31) >> 6;

    u32x4 pk0, pk1, pv0, pv1;
    { const size_t ro = (size_t)kkey * 1024; pk0 = *(const u32x4*)(kbase + ro); pk1 = *(const u32x4*)(kbase + ro + 64);
      pv0 = *(const u32x4*)(vbase + (size_t)v0key * 1024); pv1 = *(const u32x4*)(vbase + (size_t)(v0key + 32) * 1024); }
    *(LAS u32x4*)(lds + kdst) = pk0; *(LAS u32x4*)(lds + 8192 + kdst) = pk1; *(LAS u32x4*)(lds + 16384 + vdst0) = pv0; *(LAS u32x4*)(lds + 16384 + vdst1) = pv1;
    __syncthreads();
    for (int j = 0; j < nt; ++j) {
        const LAS unsigned char* st = lds + (j & 1) * STAGE;
        if (j + 1 < nt) { const size_t ro = (size_t)((j + 1) * 64 + kkey) * 1024; pk0 = *(const u32x4*)(kbase + ro); pk1 = *(const u32x4*)(kbase + ro + 64);
            pv0 = *(const u32x4*)(vbase + (size_t)((j + 1) * 64 + v0key) * 1024); pv1 = *(const u32x4*)(vbase + (size_t)((j + 1) * 64 + v0key + 32) * 1024); }
        if (j <= jmax) {
            f32x16 s0, s1;
#pragma unroll
            for (int i = 0; i < 16; ++i) { s0[i] = 0.f; s1[i] = 0.f; }
#pragma unroll
            for (int ks = 0; ks < 4; ++ks) {
                const bf16x8 ka = *(const LAS bf16x8*)(st + koff[ks]), kb = *(const LAS bf16x8*)(st + koff[ks] + 4096);
                s0 = __builtin_amdgcn_mfma_f32_32x32x16_bf16(ka, qf[ks], s0, 0, 0, 0);
                s1 = __builtin_amdgcn_mfma_f32_32x32x16_bf16(kb, qf[ks], s1, 0, 0, 0);
            }
            if (j * 64 + 63 > qs) {
                const int qrel = qs + r - j * 64;
#pragma unroll
                for (int i = 0; i < 16; ++i) { const int kv = crow(i, hh); if (kv > qrel) s0[i] = -INFINITY; if (kv + 32 > qrel) s1[i] = -INFINITY; }
            }
            float mx = fmaxf(s0[0], s1[0]);
#pragma unroll
            for (int i = 1; i < 16; ++i) mx = fmaxf(mx, fmaxf(s0[i], s1[i]));
            mx = fmaxf(mx, __shfl_xor(mx, 32));
            const float mnew = fmaxf(mrun, mx), al = exp2f(mrun - mnew);
            mrun = mnew;
            float ps = 0.f;
#pragma unroll
            for (int i = 0; i < 16; ++i) { s0[i] = exp2f(s0[i] - mnew); s1[i] = exp2f(s1[i] - mnew); ps += s0[i] + s1[i]; }
            lrun = lrun * al + ps;
#pragma unroll
            for (int dt = 0; dt < 4; ++dt)
#pragma unroll
                for (int i = 0; i < 16; ++i) o[dt][i] *= al;
            bf16x8 pf[4];
#pragma unroll
            for (int s = 0; s < 2; ++s) {
                u32x4 w0, w1;
                w0.x = pg8::cvt_pk_bf16(s0[8 * s + 0], s0[8 * s + 1]); w0.y = pg8::cvt_pk_bf16(s0[8 * s + 2], s0[8 * s + 3]); w0.z = pg8::cvt_pk_bf16(s0[8 * s + 4], s0[8 * s + 5]); w0.w = pg8::cvt_pk_bf16(s0[8 * s + 6], s0[8 * s + 7]);
                w1.x = pg8::cvt_pk_bf16(s1[8 * s + 0], s1[8 * s + 1]); w1.y = pg8::cvt_pk_bf16(s1[8 * s + 2], s1[8 * s + 3]); w1.z = pg8::cvt_pk_bf16(s1[8 * s + 4], s1[8 * s + 5]); w1.w = pg8::cvt_pk_bf16(s1[8 * s + 6], s1[8 * s + 7]);
                pf[s] = __builtin_bit_cast(bf16x8, w0); pf[2 + s] = __builtin_bit_cast(bf16x8, w1);
            }
#pragma unroll
            for (int dt = 0; dt < 4; ++dt) {
#pragma unroll
                for (int ks = 0; ks < 4; ++ks) {
                    const s16x4 lo = vtr(st + voff[dt] + ks * 16 * 256), hi = vtr(st + voff[dt] + ks * 16 * 256 + 8 * 256);
                    const bf16x8 va = (bf16x8){lo[0], lo[1], lo[2], lo[3], hi[0], hi[1], hi[2], hi[3]};
                    o[dt] = __builtin_amdgcn_mfma_f32_32x32x16_bf16(va, pf[ks], o[dt], 0, 0, 0);
                }
            }
        }
        if (j + 1 < nt) { LAS unsigned char* sn = lds + ((j + 1) & 1) * STAGE;
            *(LAS u32x4*)(sn + kdst) = pk0; *(LAS u32x4*)(sn + 8192 + kdst) = pk1; *(LAS u32x4*)(sn + 16384 + vdst0) = pv0; *(LAS u32x4*)(sn + 16384 + vdst1) = pv1; }
        __syncthreads();
    }
    const float ltot = lrun + __shfl_xor(lrun, 32);
    const float inv = (c == 0 ? 1.0f : lam) / ltot;
    LAS float* xch = (LAS float*)(lds + XCH_OFF) + rg * 4096 + lane;
    if (c == 1) {
#pragma unroll
        for (int dt = 0; dt < 4; ++dt)
#pragma unroll
            for (int i = 0; i < 16; ++i) xch[(dt * 16 + i) * 64] = o[dt][i] * inv;
    }
    __syncthreads();
    if (c == 0) {
        float ss = 0.f;
#pragma unroll
        for (int dt = 0; dt < 4; ++dt)
#pragma unroll
            for (int i = 0; i < 16; ++i) { const float v = o[dt][i] * inv - xch[(dt * 16 + i) * 64]; o[dt][i] = v; ss += v * v; }
        ss += __shfl_xor(ss, 32);
        const float rs = (1.0f - LAM_INIT) / sqrtf(ss * (1.0f / 128.0f) + LN_EPS);
        bf16_t* op = O + (seq0 + qs + r) * 1024 + h * 128 + 4 * hh;
#pragma unroll
        for (int dt = 0; dt < 4; ++dt)
#pragma unroll
            for (int g = 0; g < 4; ++g) { const int e = dt * 32 + 8 * g;
                const f32x4 gv = *(const f32x4*)(subln_g + e + 4 * hh);
                u32x2 w; w.x = pg8::cvt_pk_bf16(o[dt][4 * g] * rs * gv[0], o[dt][4 * g + 1] * rs * gv[1]); w.y = pg8::cvt_pk_bf16(o[dt][4 * g + 2] * rs * gv[2], o[dt][4 * g + 3] * rs * gv[3]);
                *(u32x2*)(op + e) = w; }
    }
    __syncthreads();
}
}

__device__ __forceinline__ void ln1_phase(float* X, bf16_t* XB, const float* g, const float* bta, int gw, int ngw, int lane) {
    f32x4 gv[4], bv[4];
#pragma unroll
    for (int j = 0; j < 4; ++j) { gv[j] = *(const f32x4*)(g + 4 * lane + 256 * j); bv[j] = *(const f32x4*)(bta + 4 * lane + 256 * j); }
    for (int m = gw; m < T; m += ngw) {
        f32x4* xr = (f32x4*)(X + (size_t)m * D) + lane;
        f32x4 v[4]; float s = 0.f;
#pragma unroll
        for (int j = 0; j < 4; ++j) { v[j] = xr[64 * j]; s += (v[j][0] + v[j][1]) + (v[j][2] + v[j][3]); }
        const float mean = wave_sum(s) * (1.f / D); float s2 = 0.f;
#pragma unroll
        for (int j = 0; j < 4; ++j) { v[j] = v[j] - mean; s2 += (v[j][0] * v[j][0] + v[j][1] * v[j][1]) + (v[j][2] * v[j][2] + v[j][3] * v[j][3]); }
        const float rstd = 1.f / sqrtf(wave_sum(s2) * (1.f / D) + LN_EPS);
        u32x2* o8 = (u32x2*)(XB + (size_t)m * D) + lane;
#pragma unroll
        for (int j = 0; j < 4; ++j) { const f32x4 y = v[j] * rstd * gv[j] + bv[j]; xr[64 * j] = y; u32x2 w; w.x = pk2(y[0], y[1]); w.y = pk2(y[2], y[3]); o8[64 * j] = w; }
    }
}

namespace peer {
constexpr int WAVE_LDS = 4096;
template <int NV>
__device__ __forceinline__ void top16(const float (&v)[NV], LAS float* oval, LAS int* oidx, int lane) {
    float lmx = v[0], lmn = v[0];
#pragma unroll
    for (int q = 1; q < NV; ++q) { lmx = fmaxf(lmx, v[q]); lmn = fminf(lmn, v[q]); }
    float hi = wave_max(lmx), lo = wave_min(lmn);
    lo = lo - fabsf(lo) * 1e-6f - 1e-30f;
    float thr = hi; int need_ties = 1;
    for (int it = 0; it < 64; ++it) {
        const float mid = 0.5f * (lo + hi);
        if (!(mid > lo && mid < hi)) break;
        int cnt = 0;
#pragma unroll
        for (int q = 0; q < NV; ++q) cnt += __popcll(__ballot(v[q] > mid));
        if (cnt == 16) { thr = mid; need_ties = 0; break; }
        if (cnt > 16) lo = mid; else hi = mid;
    }
    const float tie_hi = hi;
    int base = 0;
    if (!need_ties) {
#pragma unroll
        for (int q = 0; q < NV; ++q) { const bool sel = v[q] > thr; const unsigned long long bm = __ballot(sel);
            const int pos = base + (int)__builtin_amdgcn_mbcnt_hi((unsigned)(bm >> 32), __builtin_amdgcn_mbcnt_lo((unsigned)bm, 0u));
            if (sel) { oval[pos] = v[q]; oidx[pos] = lane + 64 * q; }
            base += __popcll(bm); }
    } else {
#pragma unroll
        for (int q = 0; q < NV; ++q) { const bool sel = v[q] > tie_hi; const unsigned long long bm = __ballot(sel);
            const int pos = base + (int)__builtin_amdgcn_mbcnt_hi((unsigned)(bm >> 32), __builtin_amdgcn_mbcnt_lo((unsigned)bm, 0u));
            if (sel && pos < 16) { oval[pos] = v[q]; oidx[pos] = lane + 64 * q; }
            base += __popcll(bm); }
#pragma unroll
        for (int q = 0; q < NV; ++q) { const bool sel = (v[q] <= tie_hi) && (v[q] > lo); const unsigned long long bm = __ballot(sel);
            const int pos = base + (int)__builtin_amdgcn_mbcnt_hi((unsigned)(bm >> 32), __builtin_amdgcn_mbcnt_lo((unsigned)bm, 0u));
            if (sel && pos < 16) { oval[pos] = v[q]; oidx[pos] = lane + 64 * q; }
            base += __popcll(bm); }
    }
    LDS_WAIT();
}

__device__ __forceinline__ void unpack8(const u32x4 a, float (&f)[8]) {
    f[0] = bflo(a.x); f[1] = bfhi(a.x); f[2] = bflo(a.y); f[3] = bfhi(a.y); f[4] = bflo(a.z); f[5] = bfhi(a.z); f[6] = bflo(a.w); f[7] = bfhi(a.w);
}

__device__ __forceinline__ void token(int t, const float* SC, float* X1  , const bf16_t* UB, const bf16_t* VB, const float* ln_g, const float* ln_b,
                                      LAS unsigned char* wl, int lane) {
    LAS float* s1v = (LAS float*)wl; LAS int* s1i = (LAS int*)(wl + 64); LAS float* s2v = (LAS float*)(wl + 128); LAS int* s2i = (LAS int*)(wl + 192);
    LAS float* cv = (LAS float*)(wl + 256); LAS int* ci = (LAS int*)(wl + 320);
    LAS int* eidx = (LAS int*)(wl + 512); LAS float* gsel = (LAS float*)(wl + 1024); LAS float* wsel = (LAS float*)(wl + 1536);
    const float* sc = SC + (size_t)t * 2048;
    for (int h = 0; h < NHEAD; ++h) {
        float a[2], bq[2];
        a[0] = sc[h * 256 + lane]; a[1] = sc[h * 256 + 64 + lane]; bq[0] = sc[h * 256 + 128 + lane]; bq[1] = sc[h * 256 + 192 + lane];
        top16<2>(a, s1v, s1i, lane);
        top16<2>(bq, s2v, s2i, lane);
        float cand[4];
#pragma unroll
        for (int q = 0; q < 4; ++q) { const int idx = lane + 64 * q; cand[q] = s1v[idx >> 4] + s2v[idx & 15]; }
        top16<4>(cand, cv, ci, lane);
        {
            const float v = cv[lane & 15]; const int code = ci[lane & 15];
            float mx = v;
#pragma unroll
            for (int o = 1; o < 16; o <<= 1) mx = fmaxf(mx, __shfl_xor(mx, o));
            const float e = __expf(v - mx); float sm = e;
#pragma unroll
            for (int o = 1; o < 16; o <<= 1) sm += __shfl_xor(sm, o);
            if (lane < 16) { gsel[h * 16 + lane] = e / sm; eidx[h * 16 + lane] = s1i[code >> 4] * 128 + s2i[code & 15]; }
        }
        LDS_WAIT();
    }
    float xr[16];
    { const f32x4* xp = (const f32x4*)(X1 + (size_t)t * D);
      const f32x4 a0 = xp[2 * lane], a1 = xp[2 * lane + 1], b0 = xp[128 + 2 * lane], b1 = xp[128 + 2 * lane + 1];
#pragma unroll
      for (int i = 0; i < 4; ++i) { xr[i] = a0[i]; xr[4 + i] = a1[i]; xr[8 + i] = b0[i]; xr[12 + i] = b1[i]; } }
    const int hb5 = (lane >> 5) & 1, hb4 = (lane >> 4) & 1, hb3 = (lane >> 3) & 1;
    for (int k0 = 0; k0 < 128; k0 += 8) {
        u32x4 ra[8], rb[8];
#pragma unroll
        for (int e = 0; e < 8; ++e) { const int ei = __builtin_amdgcn_readfirstlane(eidx[k0 + e]); const bf16_t* row = UB + (size_t)ei * D;
            ra[e] = *(const u32x4*)(row + 8 * lane); rb[e] = *(const u32x4*)(row + 512 + 8 * lane); }
        float s[8];
#pragma unroll
        for (int e = 0; e < 8; ++e) { float fa[8], fb[8]; unpack8(ra[e], fa); unpack8(rb[e], fb); float d = 0.f;
#pragma unroll
            for (int i = 0; i < 8; ++i) d += xr[i] * fa[i] + xr[8 + i] * fb[i];
            s[e] = d; }
        float r4[4], r2[2], r1;
#pragma unroll
        for (int i = 0; i < 4; ++i) { const float mine = hb5 ? s[4 + i] : s[i], oth = hb5 ? s[i] : s[4 + i]; r4[i] = mine + __shfl_xor(oth, 32); }
#pragma unroll
        for (int i = 0; i < 2; ++i) { const float mine = hb4 ? r4[2 + i] : r4[i], oth = hb4 ? r4[i] : r4[2 + i]; r2[i] = mine + __shfl_xor(oth, 16); }
        { const float mine = hb3 ? r2[1] : r2[0], oth = hb3 ? r2[0] : r2[1]; r1 = mine + __shfl_xor(oth, 8); }
        r1 += __shfl_xor(r1, 4); r1 += __shfl_xor(r1, 2); r1 += __shfl_xor(r1, 1);
        const int ke = k0 + hb5 * 4 + hb4 * 2 + hb3;
        const float act = 0.5f * r1 * (1.0f + erff(r1 * 0.70710678118654752f));
        if ((lane & 7) == 0) wsel[ke] = gsel[ke] * act;
    }
    LDS_WAIT();
    float acc[16];
#pragma unroll
    for (int i = 0; i < 16; ++i) acc[i] = 0.f;
    for (int k0 = 0; k0 < 128; k0 += 8) {
        u32x4 ra[8], rb[8];
#pragma unroll
        for (int e = 0; e < 8; ++e) { const int ei = __builtin_amdgcn_readfirstlane(eidx[k0 + e]); const bf16_t* row = VB + (size_t)ei * D;
            ra[e] = *(const u32x4*)(row + 8 * lane); rb[e] = *(const u32x4*)(row + 512 + 8 * lane); }
#pragma unroll
        for (int e = 0; e < 8; ++e) { float fa[8], fb[8]; unpack8(ra[e], fa); unpack8(rb[e], fb); const float wk = wsel[k0 + e];
#pragma unroll
            for (int i = 0; i < 8; ++i) { acc[i] += wk * fa[i]; acc[8 + i] += wk * fb[i]; } }
    }
    float s = 0.f;
#pragma unroll
    for (int i = 0; i < 16; ++i) { acc[i] = ALPHA * xr[i] + acc[i]; s += acc[i]; }
    const float mean = wave_sum(s) * (1.f / D); float s2 = 0.f;
#pragma unroll
    for (int i = 0; i < 16; ++i) { acc[i] -= mean; s2 += acc[i] * acc[i]; }
    const float rstd = 1.f / sqrtf(wave_sum(s2) * (1.f / D) + LN_EPS);
    { const f32x4* gp = (const f32x4*)ln_g; const f32x4* bp = (const f32x4*)ln_b; f32x4* op = (f32x4*)(X1 + (size_t)t * D);
      const f32x4 g0 = gp[2 * lane], g1 = gp[2 * lane + 1], g2 = gp[128 + 2 * lane], g3 = gp[128 + 2 * lane + 1];
      const f32x4 b0 = bp[2 * lane], b1 = bp[2 * lane + 1], b2 = bp[128 + 2 * lane], b3 = bp[128 + 2 * lane + 1];
      f32x4 y0, y1, y2, y3;
#pragma unroll
      for (int i = 0; i < 4; ++i) { y0[i] = acc[i] * rstd * g0[i] + b0[i]; y1[i] = acc[4 + i] * rstd * g1[i] + b1[i]; y2[i] = acc[8 + i] * rstd * g2[i] + b2[i]; y3[i] = acc[12 + i] * rstd * g3[i] + b3[i]; }
      op[2 * lane] = y0; op[2 * lane + 1] = y1; op[128 + 2 * lane] = y2; op[128 + 2 * lane + 1] = y3; }
}
}

struct Args {
    const float *x; const int* positions; const float *w_in, *conv_w, *conv_b, *gate_b, *lq1, *lk1, *lq2, *lk2, *subln_g, *w_conv_out, *w_attn_out, *w_o, *ln1_g, *ln1_b, *w_pq, *sub_keys, *u_tab, *v_tab, *ln2_g, *ln2_b;
    float* out; unsigned char* ws; int ph_lo, ph_hi;
};

__global__ void __launch_bounds__(NTHREADS, 2) fwd_kernel(Args a) {
    extern __shared__ __attribute__((aligned(16))) unsigned char lds_raw[];
    LAS unsigned char* lds = (LAS unsigned char*)lds_raw;
    const int tid = threadIdx.x, lane = tid & 63, wave = __builtin_amdgcn_readfirstlane(tid >> 6);
    const int G = gridDim.x, bx = blockIdx.x;
    const int gw = bx * NWAVES + wave, ngw = G * NWAVES, gtid = bx * NTHREADS + tid, gthreads = G * NTHREADS;
    unsigned char* ws = a.ws;
    bf16_t* Wt_in = (bf16_t*)(ws + WS_WIN); bf16_t* Wt_co = (bf16_t*)(ws + WS_WCO); bf16_t* Wt_ao = (bf16_t*)(ws + WS_WAO); bf16_t* Wt_o = (bf16_t*)(ws + WS_WO); bf16_t* Wt_sc = (bf16_t*)(ws + WS_WSC);
    float* CS = (float*)(ws + WS_CS);
    bf16_t* XB = (bf16_t*)(ws + WS_XB); bf16_t* Zb = (bf16_t*)(ws + WS_Z); bf16_t* BG = (bf16_t*)(ws + WS_BG); bf16_t* Qb = (bf16_t*)(ws + WS_Q); bf16_t* Kb = (bf16_t*)(ws + WS_K); bf16_t* Vb = (bf16_t*)(ws + WS_V);
    bf16_t* Gb = (bf16_t*)a.out;
    bf16_t* UB = (bf16_t*)(ws + WS_UB); bf16_t* VB = (bf16_t*)(ws + WS_VB); bf16_t* T1 = (bf16_t*)(ws + WS_T1); bf16_t* MG = (bf16_t*)(ws + WS_MG);
    bf16_t* X1B = (bf16_t*)(ws + WS_X1B); float* SC = (float*)(ws + WS_SC);
    const int lo = a.ph_lo, hi = a.ph_hi;
    cg::grid_group grid = cg::this_grid();
#define IN(k) (lo <= (k) && (k) < hi)
#define SEAM(k) do { if (IN(k) && IN((k) + 1)) grid.sync(); } while (0)

    if (IN(0)) {
        for (int it = bx; it < 256; it += G) wsc_item(a.w_pq, a.sub_keys, Wt_sc, lds, it, tid);
        LAS float* scr = (LAS float*)(lds + wave * 16384);
        constexpr int I_IN = (D / 64) * (NIN / 32), I_SQ = (D / 64) * (D / 32);
        for (int it = gw; it < I_IN + 3 * I_SQ; it += ngw) {
            int r = it;
            if (r < I_IN) { transpose_item<true>(a.w_in, D, NIN, Wt_in, scr, r, lane); continue; } r -= I_IN;
            if (r < I_SQ) { transpose_item<false>(a.w_conv_out, D, D, Wt_co, scr, r, lane); continue; } r -= I_SQ;
            if (r < I_SQ) { transpose_item<false>(a.w_attn_out, D, D, Wt_ao, scr, r, lane); continue; } r -= I_SQ;
            transpose_item<false>(a.w_o, D, D, Wt_o, scr, r, lane);
        }
        cvt_bf16(a.x, XB, (size_t)T * D, gtid, gthreads);
        for (int i = gtid; i < T * 8; i += gthreads) { const int t = i >> 3, f = i & 7;
            const float inv_freq = powf(500000.0f, -(float)f * 0.125f); const float ang = (float)a.positions[t] * inv_freq;
            CS[t * 16 + f] = cosf(ang); CS[t * 16 + 8 + f] = sinf(ang); }
    }
    SEAM(0);
    if (IN(1)) {
        pg8::Gemm g{XB, Wt_in, T, NIN, D}; pg8::StaticOrder S; S.init(T, NIN, G, bx);
        pg8::EpiProj E{Zb, BG, Qb, Kb, Vb, Gb, a.gate_b, CS};
        pg8::gemm_phase<pg8::EpiProj, pg8::StaticOrder, true, true>(lds, g, S, E);
    }
    SEAM(1);
    if (IN(2)) {
        conv_phase(Zb, BG, a.conv_w, a.conv_b, gtid, gthreads);
        float lam;
        { const float p1 = wave_sum(a.lq1[lane] * a.lk1[lane]), p2 = wave_sum(a.lq2[lane] * a.lk2[lane]); lam = __expf(p1) - __expf(p2) + LAM_INIT; }
        for (int it = bx; it < 512; it += G) {
            const int bh = it >> 3, pq = it & 7, b = bh >> 3, h = bh & 7;
            att::attn_unit(b, h, 15 - pq, Qb, Kb, Vb, Qb, a.subln_g, lam, lds, tid);
            att::attn_unit(b, h, pq, Qb, Kb, Vb, Qb, a.subln_g, lam, lds, tid);
        }
    }
    SEAM(2);
    if (IN(3)) {
        cvt_bf16(a.u_tab, UB, (size_t)NEXP * D, gtid, gthreads);
        cvt_bf16(a.v_tab, VB, (size_t)NEXP * D, gtid, gthreads);
        pg8::Gemm g{BG, Wt_co, T, D, D}; pg8::StaticOrder S; S.init(T, D, G, bx);
        pg8::EpiGate1 E{Gb, T1};
        pg8::gemm_phase<pg8::EpiGate1, pg8::StaticOrder, true, true>(lds, g, S, E);
    }
    SEAM(3);
    if (IN(4)) {
        pg8::Gemm g{Qb, Wt_ao, T, D, D}; pg8::StaticOrder S; S.init(T, D, G, bx);
        pg8::EpiGate2 E{Gb, T1, MG};
        pg8::gemm_phase<pg8::EpiGate2, pg8::StaticOrder, true, true>(lds, g, S, E);
    }
    SEAM(4);
    if (IN(5)) {
        pg8::Gemm g{MG, Wt_o, T, D, D}; pg8::StaticOrder S; S.init(T, D, G, bx);
        pg8::EpiF32<true, 1024> E{a.x, a.out};
        pg8::gemm_phase<pg8::EpiF32<true, 1024>, pg8::StaticOrder, true, true>(lds, g, S, E);
    }
    SEAM(5);
    if (IN(6)) ln1_phase(a.out, X1B, a.ln1_g, a.ln1_b, gw, ngw, lane);
    SEAM(6);
    if (IN(7)) {
        pg8::Gemm g{X1B, Wt_sc, T, 2048, D}; pg8::StaticOrder S; S.init(T, 2048, G, bx);
        pg8::EpiF32<false, 2048> E{nullptr, SC};
        pg8::gemm_phase<pg8::EpiF32<false, 2048>, pg8::StaticOrder, true, true>(lds, g, S, E);
    }
    SEAM(7);
    if (IN(8)) {
        LAS unsigned char* wl = lds + wave * peer::WAVE_LDS;
        for (int t = gw; t < T; t += ngw) peer::token(t, SC, a.out, UB, VB, a.ln2_g, a.ln2_b, wl, lane);
    }
#undef IN
#undef SEAM
}

extern "C" void kernel_launch(void* const* d_in, const int* in_sizes, int n_in, void* d_out, int out_size, void* d_ws, size_t ws_size, hipStream_t stream) {
    static int grid = 0;
    if (grid == 0) {
        if (n_in != 22 || out_size != T * D || ws_size < WS_END) { fprintf(stderr, "kernel_launch: unexpected shapes (n_in %d, out %d, ws %zu); nothing launched\n", n_in, out_size, ws_size); grid = -1; return; }
        int dev = 0, cus = 0, per_cu = 0;
        if (hipGetDevice(&dev) != hipSuccess || hipDeviceGetAttribute(&cus, hipDeviceAttributeMultiprocessorCount, dev) != hipSuccess) { grid = -1; return; }
        if (hipFuncSetAttribute((const void*)fwd_kernel, hipFuncAttributeMaxDynamicSharedMemorySize, LDS_BYTES) != hipSuccess) { fprintf(stderr, "kernel_launch: hipFuncSetAttribute failed\n"); grid = -1; return; }
        if (hipOccupancyMaxActiveBlocksPerMultiprocessor(&per_cu, (const void*)fwd_kernel, NTHREADS, LDS_BYTES) != hipSuccess || per_cu < 1) { fprintf(stderr, "kernel_launch: occupancy query failed (%d)\n", per_cu); (void)hipGetLastError(); per_cu = 1; }
        grid = cus * per_cu;
    }
    if (grid < 0) return;
    Args a{};
    a.x = (const float*)d_in[0]; a.positions = (const int*)d_in[1]; a.w_in = (const float*)d_in[2]; a.conv_w = (const float*)d_in[3]; a.conv_b = (const float*)d_in[4]; a.gate_b = (const float*)d_in[5];
    a.lq1 = (const float*)d_in[6]; a.lk1 = (const float*)d_in[7]; a.lq2 = (const float*)d_in[8]; a.lk2 = (const float*)d_in[9]; a.subln_g = (const float*)d_in[10];
    a.w_conv_out = (const float*)d_in[11]; a.w_attn_out = (const float*)d_in[12]; a.w_o = (const float*)d_in[13]; a.ln1_g = (const float*)d_in[14]; a.ln1_b = (const float*)d_in[15];
    a.w_pq = (const float*)d_in[16]; a.sub_keys = (const float*)d_in[17]; a.u_tab = (const float*)d_in[18]; a.v_tab = (const float*)d_in[19]; a.ln2_g = (const float*)d_in[20]; a.ln2_b = (const float*)d_in[21];
    a.out = (float*)d_out; a.ws = (unsigned char*)d_ws;
#if MK_N_LAUNCHES == 1
    a.ph_lo = 0; a.ph_hi = NPHASES;
    void* args[] = {&a};
    hipError_t e = hipLaunchCooperativeKernel((const void*)fwd_kernel, dim3(grid), dim3(NTHREADS), args, LDS_BYTES, stream);
    if (e != hipSuccess) fprintf(stderr, "kernel_launch: cooperative launch failed: %s (grid %d)\n", hipGetErrorString(e), grid);
#else
    for (int p = 0; p < NPHASES; ++p) { a.ph_lo = p; a.ph_hi = p + 1; hipLaunchKernelGGL(fwd_kernel, dim3(grid), dim3(NTHREADS), LDS_BYTES, stream, a); }
#endif
}
```

```cpp
#include <hip/hip_runtime.h>
#include <hip/hip_cooperative_groups.h>
#include <cstdio>
#include <cstdint>
namespace cg = cooperative_groups;
namespace pg8 {
#define PG8_LAS __attribute__((address_space(3)))
typedef unsigned short bf16_t;
typedef short bf16x8 __attribute__((ext_vector_type(8)));
typedef float f32x4 __attribute__((ext_vector_type(4)));
typedef unsigned u32x4 __attribute__((ext_vector_type(4)));
constexpr int BM = 256, BK = 64, HALF = 128, HTB = HALF * BK * 2  , STAGE_BYTES = 8 * HTB, NXCD = 8, WGM = 8;

__host__ __device__ __forceinline__ int lds_byte(int r, int c) { const int st = (r >> 4) * 2 + (c >> 5), rr = r & 15, cc = c & 31, ob = rr * 64 + cc * 2; return st * 1024 + (ob ^ (((ob >> 9) & 1) << 5)); }
__host__ __device__ __forceinline__ void stage_rc(int b, int& R, int& C) { const int st = b / 1024, sb = b % 1024, swz = sb ^ (((sb >> 9) & 1) << 5); R = (st >> 1) * 16 + swz / 64; C = (st & 1) * 32 + (swz % 64) / 2; }
__host__ __device__ __forceinline__ int perm32(int rho) { const int n = rho >> 4, i = rho & 15; return 8 * (i >> 2) + 4 * n + (i & 3); }

struct Unit { int pm, pn; };
struct Gemm { const bf16_t* A; const bf16_t* Bt; int M, N, K; };

struct StaticOrder {
    int nM, nN, nwg, G, c;
    __host__ __device__ void init(int M, int N, int G_, int c_) { nM = M / BM; nN = N / BM; nwg = nM * nN; G = G_; c = c_; }
    __host__ __device__ bool next(int i, Unit& u) const {
        const long L = (long)i * G + c; if (L >= nwg) return false;
        int wgid = (int)L; { const int q = nwg / NXCD, r = nwg % NXCD, xcd = wgid % NXCD, off = wgid / NXCD; wgid = (xcd < r ? xcd * (q + 1) : r * (q + 1) + (xcd - r) * q) + off; }
        const int nig = WGM * nN, gid = wgid / nig, fm = gid * WGM, gsz = (nM - fm) < WGM ? (nM - fm) : WGM;
        u.pm = fm + ((wgid % nig) % gsz); u.pn = (wgid % nig) / gsz; return true;
    }
    __device__ __forceinline__ void a_ready(const Unit&) const {}
    __device__ __forceinline__ void done(const Unit&) const {}
};


__device__ __forceinline__ unsigned cvt_pk_bf16(float lo, float hi) { unsigned r; asm volatile("v_cvt_pk_bf16_f32 %0, %1, %2" : "=v"(r) : "v"(lo), "v"(hi)); return r; }
__device__ __forceinline__ void store8(bf16_t* p, f32x4 v0, f32x4 v1) {
    u32x4 w; w.x = cvt_pk_bf16(v0[0], v0[1]); w.y = cvt_pk_bf16(v0[2], v0[3]); w.z = cvt_pk_bf16(v1[0], v1[1]); w.w = cvt_pk_bf16(v1[2], v1[3]);
    *(u32x4*)p = w;
}
__device__ __forceinline__ void load8(const bf16_t* p, f32x4& v0, f32x4& v1) {
    const u32x4 w = *(const u32x4*)p;
    v0[0] = __uint_as_float(w.x << 16); v0[1] = __uint_as_float(w.x & 0xffff0000u); v0[2] = __uint_as_float(w.y << 16); v0[3] = __uint_as_float(w.y & 0xffff0000u);
    v1[0] = __uint_as_float(w.z << 16); v1[1] = __uint_as_float(w.z & 0xffff0000u); v1[2] = __uint_as_float(w.w << 16); v1[3] = __uint_as_float(w.w & 0xffff0000u);
}
constexpr float QSCALE = 0.125f * 1.4426950408889634f;

struct EpiProj {
    static constexpr bool PERM = true, AFTER_DRAIN = false;
    bf16_t *Z, *BG, *Q, *Kk, *V, *G; const float* gate_b; const float* CS;
    __device__ __forceinline__ void operator()(const f32x4 (&acc)[2][2][4][2], const Unit& u, int wr, int wc, int fr, int fq) const {
        const int row0 = u.pm * BM + wr * 64 + fr, pn = u.pn, cw = wc * 32 + 8 * fq;
        if (pn < 8) {
#pragma unroll
            for (int ai = 0; ai < 2; ++ai)
#pragma unroll
                for (int m = 0; m < 4; ++m) { const size_t row = row0 + ai * HALF + m * 16;
                    store8(Z + row * 1024 + pn * 128 + cw, acc[ai][0][m][0] * acc[ai][1][m][0], acc[ai][0][m][1] * acc[ai][1][m][1]); }
        } else if (pn < 12) {
#pragma unroll
            for (int ai = 0; ai < 2; ++ai)
#pragma unroll
                for (int m = 0; m < 4; ++m) { const size_t row = row0 + ai * HALF + m * 16;
#pragma unroll
                    for (int bj = 0; bj < 2; ++bj) store8(BG + row * 1024 + (pn - 8) * 256 + bj * HALF + cw, acc[ai][bj][m][0], acc[ai][bj][m][1]); }
        } else if (pn < 20) {
            const bool isq = pn < 16; bf16_t* dst = isq ? Q : Kk; const int cb = ((pn - 12) & 3) * 256; const float sc = isq ? QSCALE : 1.0f;
            const bool rot = ((wc & 1) == 0) && (fq < 2);
#pragma unroll
            for (int ai = 0; ai < 2; ++ai)
#pragma unroll
                for (int m = 0; m < 4; ++m) { const size_t row = row0 + ai * HALF + m * 16;
                    f32x4 c4 = *(const f32x4*)(CS + row * 16 + 4 * (fq & 1)), s4 = *(const f32x4*)(CS + row * 16 + 8 + 4 * (fq & 1));
                    if (!rot) { c4 = (f32x4){1.f, 1.f, 1.f, 1.f}; s4 = (f32x4){0.f, 0.f, 0.f, 0.f}; }
#pragma unroll
                    for (int bj = 0; bj < 2; ++bj) { const f32x4 v0 = acc[ai][bj][m][0], v1 = acc[ai][bj][m][1]; f32x4 o0, o1;
                        o0[0] = v0[0] * c4[0] - v0[1] * s4[0]; o0[1] = v0[1] * c4[0] + v0[0] * s4[0];
                        o0[2] = v0[2] * c4[1] - v0[3] * s4[1]; o0[3] = v0[3] * c4[1] + v0[2] * s4[1];
                        o1[0] = v1[0] * c4[2] - v1[1] * s4[2]; o1[1] = v1[1] * c4[2] + v1[0] * s4[2];
                        o1[2] = v1[2] * c4[3] - v1[3] * s4[3]; o1[3] = v1[3] * c4[3] + v1[2] * s4[3];
                        store8(dst + row * 1024 + cb + bj * HALF + cw, o0 * sc, o1 * sc); } }
        } else if (pn < 24) {
#pragma unroll
            for (int ai = 0; ai < 2; ++ai)
#pragma unroll
                for (int m = 0; m < 4; ++m) { const size_t row = row0 + ai * HALF + m * 16;
#pragma unroll
                    for (int bj = 0; bj < 2; ++bj) store8(V + row * 1024 + (pn - 20) * 256 + bj * HALF + cw, acc[ai][bj][m][0], acc[ai][bj][m][1]); }
        } else {
            f32x4 bv[2][2];
#pragma unroll
            for (int bj = 0; bj < 2; ++bj)
#pragma unroll
                for (int n = 0; n < 2; ++n) bv[bj][n] = *(const f32x4*)(gate_b + (pn - 24) * 256 + bj * HALF + cw + 4 * n);
#pragma unroll
            for (int ai = 0; ai < 2; ++ai)
#pragma unroll
                for (int m = 0; m < 4; ++m) { const size_t row = row0 + ai * HALF + m * 16;
#pragma unroll
                    for (int bj = 0; bj < 2; ++bj) { f32x4 g0 = acc[ai][bj][m][0] + bv[bj][0], g1 = acc[ai][bj][m][1] + bv[bj][1];
#pragma unroll
                        for (int i = 0; i < 4; ++i) { g0[i] = 1.0f / (1.0f + __expf(-g0[i])); g1[i] = 1.0f / (1.0f + __expf(-g1[i])); }
                        store8(G + row * 2048 + (pn - 24) * 256 + bj * HALF + cw, g0, g1); } }
        }
    }
};
struct EpiGate1 {
    static constexpr bool PERM = true, AFTER_DRAIN = false;
    const bf16_t* G; bf16_t* T1;
    __device__ __forceinline__ void operator()(const f32x4 (&acc)[2][2][4][2], const Unit& u, int wr, int wc, int fr, int fq) const {
        const int row0 = u.pm * BM + wr * 64 + fr, col0 = u.pn * BM + wc * 32 + 8 * fq;
#pragma unroll
        for (int ai = 0; ai < 2; ++ai)
#pragma unroll
            for (int m = 0; m < 4; ++m) { const size_t row = row0 + ai * HALF + m * 16;
#pragma unroll
                for (int bj = 0; bj < 2; ++bj) { f32x4 g0, g1; load8(G + row * 2048 + col0 + bj * HALF, g0, g1);
                    store8(T1 + row * 1024 + col0 + bj * HALF, acc[ai][bj][m][0] * g0, acc[ai][bj][m][1] * g1); } }
    }
};
struct EpiGate2 {
    static constexpr bool PERM = true, AFTER_DRAIN = false;
    const bf16_t* G; const bf16_t* T1; bf16_t* MG;
    __device__ __forceinline__ void operator()(const f32x4 (&acc)[2][2][4][2], const Unit& u, int wr, int wc, int fr, int fq) const {
        const int row0 = u.pm * BM + wr * 64 + fr, col0 = u.pn * BM + wc * 32 + 8 * fq;
#pragma unroll
        for (int ai = 0; ai < 2; ++ai)
#pragma unroll
            for (int m = 0; m < 4; ++m) { const size_t row = row0 + ai * HALF + m * 16;
#pragma unroll
                for (int bj = 0; bj < 2; ++bj) { f32x4 g0, g1, t0, t1; load8(G + row * 2048 + 1024 + col0 + bj * HALF, g0, g1); load8(T1 + row * 1024 + col0 + bj * HALF, t0, t1);
                    store8(MG + row * 1024 + col0 + bj * HALF, t0 + acc[ai][bj][m][0] * g0, t1 + acc[ai][bj][m][1] * g1); } }
    }
};
template <bool HAS_BASE, int ldc> struct EpiF32 {
    static constexpr bool PERM = false, AFTER_DRAIN = false;
    static constexpr float alpha = 1.189207115002721f;
    const float* base; float* O;
    __device__ __forceinline__ void operator()(const f32x4 (&acc)[2][2][4][2], const Unit& u, int wr, int wc, int fr, int fq) const {
        const int row0 = u.pm * BM + wr * 64 + fr, col0 = u.pn * BM + wc * 32 + 4 * fq;
#pragma unroll
        for (int ai = 0; ai < 2; ++ai)
#pragma unroll
            for (int m = 0; m < 4; ++m) { const size_t row = row0 + ai * HALF + m * 16;
#pragma unroll
                for (int bj = 0; bj < 2; ++bj)
#pragma unroll
                    for (int n = 0; n < 2; ++n) { const size_t o = row * ldc + col0 + bj * HALF + n * 16; f32x4 v = acc[ai][bj][m][n];
                        if constexpr (HAS_BASE) v = v + alpha * *(const f32x4*)(base + o);
                        *(f32x4*)(O + o) = v; } }
    }
};

template <class Epi, class Sched, bool ALIGN_EPI = false, bool SP2 = false>
__device__ __forceinline__ void gemm_phase(PG8_LAS unsigned char* lds, const Gemm g, const Sched& S, const Epi& E) {
    const int tid = threadIdx.x, wid = __builtin_amdgcn_readfirstlane(tid >> 6), lane = tid & 63, wr = wid >> 2, wc = wid & 3, fr = lane & 15, fq = lane >> 4;
    const int K = g.K, nt = K / BK;
    unsigned voffA[2], voffB[2];
#pragma unroll
    for (int i = 0; i < 2; ++i) { int R, C; stage_rc(tid * 16 + i * 8192, R, C); const int Rb = Epi::PERM ? ((R & ~31) + perm32(R & 31)) : R;
        voffA[i] = (unsigned)(R * K + C) * 2u; voffB[i] = (unsigned)(Rb * K + C) * 2u; }
    const size_t kstep = (size_t)(BK * 2);
    const size_t hstep = (size_t)HALF * K * 2;
    const size_t tstep = 2 * hstep;
    const unsigned ldsw = (unsigned)wid * 1024u;
    const int aoff = lds_byte(wr * 64 + fr, fq * 8), boff = lds_byte(wc * 32 + fr, fq * 8);
#define PG8_SA(b, h) (((b) * 2 + (h)) * HTB)
#define PG8_SB(b, h) ((4 + (b) * 2 + (h)) * HTB)
#define PG8_STAGE(bufoff, gbase, voff) do { _Pragma("unroll") for (int _i = 0; _i < 2; ++_i) \
        __builtin_amdgcn_global_load_lds((const unsigned*)((const char*)(gbase) + (voff)[_i]), (PG8_LAS unsigned*)(lds + (bufoff) + ldsw + _i * 8192), 16, 0, 0); } while (0)
#define PG8_LDA(dst, b, h) do { _Pragma("unroll") for (int m = 0; m < 4; ++m) _Pragma("unroll") for (int k = 0; k < 2; ++k) dst[m][k] = *(const PG8_LAS bf16x8*)(lds + PG8_SA(b, h) + aoff + m * 2048 + k * 1024); } while (0)
#define PG8_LDB(dst, b, h) do { _Pragma("unroll") for (int n = 0; n < 2; ++n) _Pragma("unroll") for (int k = 0; k < 2; ++k) dst[n][k] = *(const PG8_LAS bf16x8*)(lds + PG8_SB(b, h) + boff + n * 2048 + k * 1024); } while (0)
#define PG8_MMA(ai, bj, At, Bt) do { __builtin_amdgcn_s_setprio(1); _Pragma("unroll") for (int m = 0; m < 4; ++m) _Pragma("unroll") for (int n = 0; n < 2; ++n) _Pragma("unroll") for (int k = 0; k < 2; ++k) \
        acc[ai][bj][m][n] = __builtin_amdgcn_mfma_f32_16x16x32_bf16(Bt[n][k], At[m][k], acc[ai][bj][m][n], 0, 0, 0); __builtin_amdgcn_s_setprio(0); } while (0)
#define PG8_WAIT_V(n) asm volatile("s_waitcnt vmcnt(" #n ")" ::: "memory")
#define PG8_WAIT_L(n) asm volatile("s_waitcnt lgkmcnt(" #n ")" ::: "memory")
#define PG8_BAR __builtin_amdgcn_s_barrier()
#define PG8_SCHED __builtin_amdgcn_sched_barrier(0)
    Unit cur, nxt; int ui = 0;
    if (!S.next(0, cur)) return;
    f32x4 acc[2][2][4][2];
#pragma unroll
    for (int a = 0; a < 2; ++a)
#pragma unroll
        for (int b = 0; b < 2; ++b)
#pragma unroll
            for (int m = 0; m < 4; ++m)
#pragma unroll
                for (int n = 0; n < 2; ++n) acc[a][b][m][n] = (f32x4){0.f, 0.f, 0.f, 0.f};
    bf16x8 At[4][2], B0[2][2], B1[2][2];
    const char* cA = (const char*)g.A + (size_t)cur.pm * tstep; const char* cB = (const char*)g.Bt + (size_t)cur.pn * tstep;
    S.a_ready(cur);
    if constexpr (SP2) {
        PG8_STAGE(PG8_SB(0, 0), cB, voffB); PG8_STAGE(PG8_SB(0, 1), cB + hstep, voffB); PG8_STAGE(PG8_SA(0, 0), cA, voffA); PG8_STAGE(PG8_SA(0, 1), cA + hstep, voffA);
        if (wr == 1) PG8_BAR;
        PG8_WAIT_V(2); PG8_BAR;
        PG8_STAGE(PG8_SB(1, 0), cB + kstep, voffB); PG8_STAGE(PG8_SA(1, 0), cA + kstep, voffA); PG8_STAGE(PG8_SB(1, 1), cB + hstep + kstep, voffB);
        PG8_WAIT_V(6); PG8_BAR;
    } else {
        PG8_STAGE(PG8_SB(0, 0), cB, voffB); PG8_STAGE(PG8_SA(0, 0), cA, voffA); PG8_STAGE(PG8_SB(0, 1), cB + hstep, voffB); PG8_STAGE(PG8_SA(0, 1), cA + hstep, voffA);
        if (wr == 1) PG8_BAR;
        PG8_WAIT_V(4); PG8_BAR;
        PG8_STAGE(PG8_SB(1, 0), cB + kstep, voffB); PG8_STAGE(PG8_SA(1, 0), cA + kstep, voffA); PG8_STAGE(PG8_SB(1, 1), cB + hstep + kstep, voffB);
        PG8_WAIT_V(6); PG8_BAR;
    }
    for (;;) {
        const bool has_next = S.next(ui + 1, nxt);
        const char* nA = has_next ? (const char*)g.A + (size_t)nxt.pm * tstep : cA; const char* nB = has_next ? (const char*)g.Bt + (size_t)nxt.pn * tstep : cB;
        for (int t = 0; t < nt; t += 2) {
            const bool last = (t == nt - 2);
            const char* a1 = cA + (size_t)(t + 1) * kstep;
            const char* a2 = last ? nA : cA + (size_t)(t + 2) * kstep; const char* b2 = last ? nB : cB + (size_t)(t + 2) * kstep;
            const char* a3 = a2 + kstep; const char* b3 = b2 + kstep;
            if (last && has_next) S.a_ready(nxt);
            if constexpr (SP2) {
            PG8_LDB(B0, 0, 0); PG8_LDB(B1, 0, 1); PG8_SCHED; PG8_LDA(At, 0, 0); PG8_STAGE(PG8_SA(1, 1), a1 + hstep, voffA);
            PG8_WAIT_V(8); PG8_WAIT_L(0); PG8_BAR; PG8_MMA(0, 0, At, B0); PG8_MMA(0, 1, At, B1); PG8_BAR; PG8_SCHED;
            PG8_LDA(At, 0, 1); PG8_STAGE(PG8_SB(0, 0), b2, voffB); PG8_STAGE(PG8_SB(0, 1), b2 + hstep, voffB); PG8_STAGE(PG8_SA(0, 0), a2, voffA);
            PG8_WAIT_V(8); PG8_WAIT_L(0); PG8_BAR; PG8_MMA(1, 0, At, B0); PG8_MMA(1, 1, At, B1); PG8_BAR; PG8_SCHED;
            PG8_LDB(B0, 1, 0); PG8_LDB(B1, 1, 1); PG8_SCHED; PG8_LDA(At, 1, 0); PG8_STAGE(PG8_SA(0, 1), a2 + hstep, voffA);
            PG8_WAIT_V(8); PG8_WAIT_L(0); PG8_BAR; PG8_MMA(0, 0, At, B0); PG8_MMA(0, 1, At, B1); PG8_BAR; PG8_SCHED;
            PG8_LDA(At, 1, 1); PG8_STAGE(PG8_SB(1, 0), b3, voffB); PG8_STAGE(PG8_SB(1, 1), b3 + hstep, voffB); PG8_STAGE(PG8_SA(1, 0), a3, voffA);
            PG8_WAIT_V(8); PG8_WAIT_L(0); PG8_BAR; PG8_MMA(1, 0, At, B0); PG8_MMA(1, 1, At, B1); PG8_BAR; PG8_SCHED;
            } else {
            PG8_LDB(B0, 0, 0); PG8_SCHED; PG8_LDA(At, 0, 0); PG8_STAGE(PG8_SA(1, 1), a1 + hstep, voffA);
            PG8_WAIT_L(8); PG8_BAR; PG8_WAIT_L(0); PG8_MMA(0, 0, At, B0); PG8_BAR; PG8_SCHED;
            PG8_LDB(B1, 0, 1); PG8_STAGE(PG8_SB(0, 0), b2, voffB);
            PG8_BAR; PG8_WAIT_L(0); PG8_MMA(0, 1, At, B1); PG8_BAR;
            PG8_LDA(At, 0, 1); PG8_STAGE(PG8_SA(0, 0), a2, voffA);
            PG8_BAR; PG8_WAIT_L(0); PG8_MMA(1, 0, At, B0); PG8_BAR; PG8_SCHED;
            PG8_STAGE(PG8_SB(0, 1), b2 + hstep, voffB);
            PG8_WAIT_V(6); PG8_BAR; PG8_MMA(1, 1, At, B1); PG8_BAR;
            PG8_LDB(B0, 1, 0); PG8_SCHED; PG8_LDA(At, 1, 0); PG8_STAGE(PG8_SA(0, 1), a2 + hstep, voffA);
            PG8_WAIT_L(8); PG8_BAR; PG8_WAIT_L(0); PG8_MMA(0, 0, At, B0); PG8_BAR; PG8_SCHED;
            PG8_LDB(B1, 1, 1); PG8_STAGE(PG8_SB(1, 0), b3, voffB);
            PG8_BAR; PG8_WAIT_L(0); PG8_MMA(0, 1, At, B1); PG8_BAR;
            PG8_LDA(At, 1, 1); PG8_STAGE(PG8_SA(1, 0), a3, voffA);
            PG8_BAR; PG8_WAIT_L(0); PG8_MMA(1, 0, At, B0); PG8_BAR; PG8_SCHED;
            PG8_STAGE(PG8_SB(1, 1), b3 + hstep, voffB);
            PG8_WAIT_V(6); PG8_BAR; PG8_MMA(1, 1, At, B1); PG8_BAR;
            }
        }
        if constexpr (ALIGN_EPI) { if (wr == 0) PG8_BAR; }
        if constexpr (!Epi::AFTER_DRAIN) { E(acc, cur, wr, wc, fr, fq); S.done(cur); }
        if (!has_next) break;
#pragma unroll
        for (int a = 0; a < 2; ++a)
#pragma unroll
            for (int b = 0; b < 2; ++b)
#pragma unroll
                for (int m = 0; m < 4; ++m)
#pragma unroll
                    for (int n = 0; n < 2; ++n) acc[a][b][m][n] = (f32x4){0.f, 0.f, 0.f, 0.f};
        cur = nxt; cA = nA; cB = nB; ++ui;
        if constexpr (ALIGN_EPI) { if (wr == 1) PG8_BAR; }
    }
    PG8_WAIT_V(0);
    if constexpr (!ALIGN_EPI) { if (wr == 0) PG8_BAR; }
    PG8_BAR;
    if constexpr (Epi::AFTER_DRAIN) { E.fused(acc, cur, wr, wc, fr, fq, lds, wid, lane); S.done(cur); }
#undef PG8_SA
#undef PG8_SB
#undef PG8_STAGE
#undef PG8_LDA
#undef PG8_LDB
#undef PG8_MMA
#undef PG8_WAIT_V
#undef PG8_WAIT_L
#undef PG8_BAR
#undef PG8_SCHED
}
}

constexpr int T = 16384, D = 1024, SEQ = 2048, NBATCH = 8, NIN = 8192;
constexpr int NHEAD = 8, NEXP = 16384;
constexpr float LN_EPS = 1e-5f;
constexpr float ALPHA = 1.189207115002721f;
constexpr float LAM_INIT = 0.2f;
constexpr int NWAVES = 8, NTHREADS = 512;
constexpr int LDS_BYTES = 147456;
constexpr int NPHASES = 9;
constexpr int RING_BYTES = 131072, LDSCTL_OFF = RING_BYTES, MISC_OFF = LDSCTL_OFF + 320;
constexpr int CW_BAR = 4096;
constexpr size_t CTL_ZERO_BYTES = 65536;
#ifndef MK_N_LAUNCHES
#define MK_N_LAUNCHES 1
#endif

typedef unsigned short bf16_t;
typedef short bf16x8 __attribute__((ext_vector_type(8)));
typedef short s16x4 __attribute__((ext_vector_type(4)));
typedef float f32x4 __attribute__((ext_vector_type(4)));
typedef float f32x16 __attribute__((ext_vector_type(16)));
typedef unsigned u32x4 __attribute__((ext_vector_type(4)));
typedef unsigned u32x2 __attribute__((ext_vector_type(2)));
#define LAS __attribute__((address_space(3)))
#define LDS_WAIT() asm volatile("s_waitcnt lgkmcnt(0)" ::: "memory")

constexpr size_t MiB = 1u << 20;
constexpr size_t WS_CTL = 0, WS_CS = 1 * MiB, WS_WCO = 2 * MiB, WS_WAO = 4 * MiB, WS_WO = 6 * MiB, WS_WSC = 8 * MiB;
constexpr size_t WS_WIN = 12 * MiB, WS_XB = 28 * MiB, WS_Z = 60 * MiB, WS_BG = 92 * MiB, WS_Q = 124 * MiB, WS_K = 156 * MiB, WS_V = 188 * MiB;
constexpr size_t WS_UB = 12 * MiB, WS_VB = 44 * MiB;
constexpr size_t WS_T1 = 156 * MiB, WS_MG = 188 * MiB;
constexpr size_t WS_X1B = 76 * MiB;
constexpr size_t WS_SC = 124 * MiB;
constexpr size_t WS_END = 252 * MiB;

__device__ __forceinline__ unsigned f2bf(float f) { unsigned u = __builtin_bit_cast(unsigned, f); return (u + 0x7fffu + ((u >> 16) & 1u)) >> 16; }
__device__ __forceinline__ unsigned pk2(float lo, float hi) { return f2bf(lo) | (f2bf(hi) << 16); }
__device__ __forceinline__ float bflo(unsigned w) { return __uint_as_float(w << 16); }
__device__ __forceinline__ float bfhi(unsigned w) { return __uint_as_float(w & 0xffff0000u); }
__device__ __forceinline__ float wave_sum(float v) {
#pragma unroll
    for (int o = 1; o < 64; o <<= 1) v += __shfl_xor(v, o);
    return v;
}
__device__ __forceinline__ float wave_max(float v) {
#pragma unroll
    for (int o = 1; o < 64; o <<= 1) v = fmaxf(v, __shfl_xor(v, o));
    return v;
}
__device__ __forceinline__ float wave_min(float v) {
#pragma unroll
    for (int o = 1; o < 64; o <<= 1) v = fminf(v, __shfl_xor(v, o));
    return v;
}

__device__ __forceinline__ int win_src(int n) {
    if (n < 2048) { const int i = n >> 8, r = n & 255; return r < 128 ? 128 * i + r : 2048 + 128 * i + (r - 128); }
    if (n < 3072) return 1024 + (n - 2048);
    if (n < 5120) { const int base = n - 3072, which = base >> 10, within = base & 1023, map = within >> 6, p = within & 63; const int d = p < 16 ? (p >> 1) + 8 * (p & 1) : p; return 3072 + which * 1024 + map * 64 + d; }
    return n;
}
template <bool PERMUTE>
__device__ __forceinline__ void transpose_item(const float* W, int K, int N, bf16_t* WT, LAS float* scr, int item, int lane) {
    const int nblk = N / 32, kb = item / nblk, nb = item % nblk, k0 = 64 * kb, n0 = 32 * nb;
    const int nsrc = PERMUTE ? win_src(n0 + (lane & 31)) : n0 + (lane & 31);
#pragma unroll 8
    for (int i = 0; i < 32; ++i) { const int kk = 2 * i + (lane >> 5); scr[kk * 33 + (lane & 31)] = W[(size_t)(k0 + kk) * N + nsrc]; }
    LDS_WAIT();
    const int c = lane & 7;
#pragma unroll
    for (int j = 0; j < 4; ++j) { const int n = (lane >> 3) + 8 * j; const LAS float* s = scr + (8 * c) * 33 + n;
        u32x4 o; o.x = pk2(s[0 * 33], s[1 * 33]); o.y = pk2(s[2 * 33], s[3 * 33]); o.z = pk2(s[4 * 33], s[5 * 33]); o.w = pk2(s[6 * 33], s[7 * 33]);
        *(u32x4*)(WT + (size_t)(n0 + n) * K + k0 + 8 * c) = o; }
    LDS_WAIT();
}
__device__ __forceinline__ void cvt_bf16(const float* src, bf16_t* dst, size_t n, int gtid, int gthreads) {
    const size_t n8 = n / 8;
    for (size_t i = gtid; i < n8; i += gthreads) {
        const f32x4 a = *(const f32x4*)(src + i * 8), b = *(const f32x4*)(src + i * 8 + 4);
        u32x4 o; o.x = pk2(a[0], a[1]); o.y = pk2(a[2], a[3]); o.z = pk2(b[0], b[1]); o.w = pk2(b[2], b[3]);
        *(u32x4*)(dst + i * 8) = o;
    }
}
__device__ __forceinline__ void wsc_item(const float* w_pq, const float* sub_keys, bf16_t* Wsc, LAS unsigned char* lds, int item, int tid) {
    const int hc = item >> 4, d0 = (item & 15) * 64;
    LAS float* kl = (LAS float*)lds; LAS float* wl = (LAS float*)(lds + 67584);
    for (int i = tid; i < 128 * 32; i += NTHREADS) { const int n = i >> 5, j4 = (i & 31) * 4; *(LAS f32x4*)(kl + n * 132 + j4) = *(const f32x4*)(sub_keys + ((size_t)hc * 128 + n) * 128 + j4); }
    for (int i = tid; i < 64 * 32; i += NTHREADS) { const int dd = i >> 5, j4 = (i & 31) * 4; *(LAS f32x4*)(wl + dd * 128 + j4) = *(const f32x4*)(w_pq + (size_t)(d0 + dd) * 2048 + hc * 128 + j4); }
    __syncthreads();
    const int n = tid & 127, dq = tid >> 7;
    float acc[16];
#pragma unroll
    for (int i = 0; i < 16; ++i) acc[i] = 0.f;
    for (int j4 = 0; j4 < 128; j4 += 4) {
        const f32x4 kv = *(const LAS f32x4*)(kl + n * 132 + j4);
#pragma unroll
        for (int i = 0; i < 16; ++i) { const f32x4 wv = *(const LAS f32x4*)(wl + (dq * 16 + i) * 128 + j4); acc[i] += kv[0] * wv[0] + kv[1] * wv[1] + kv[2] * wv[2] + kv[3] * wv[3]; }
    }
    u32x4 o0, o1;
    o0.x = pk2(acc[0], acc[1]); o0.y = pk2(acc[2], acc[3]); o0.z = pk2(acc[4], acc[5]); o0.w = pk2(acc[6], acc[7]);
    o1.x = pk2(acc[8], acc[9]); o1.y = pk2(acc[10], acc[11]); o1.z = pk2(acc[12], acc[13]); o1.w = pk2(acc[14], acc[15]);
    bf16_t* dst = Wsc + (size_t)(hc * 128 + n) * 1024 + d0 + dq * 16;
    *(u32x4*)dst = o0; *(u32x4*)(dst + 8) = o1;
    __syncthreads();
}

__device__ __forceinline__ void conv_phase(const bf16_t* Z, bf16_t* BG, const float* conv_w, const float* conv_b, int gtid, int gthreads) {
    for (int it = gtid; it < (T / 16) * 128; it += gthreads) {
        const int rb = it >> 7, cc = it & 127, t0 = rb * 16, c0 = cc * 8;
        float w0[8], w1[8], w2[8], cb[8];
#pragma unroll
        for (int i = 0; i < 8; ++i) { w0[i] = conv_w[c0 + i]; w1[i] = conv_w[1024 + c0 + i]; w2[i] = conv_w[2048 + c0 + i]; cb[i] = conv_b[c0 + i]; }
        float zm2[8], zm1[8];
        if ((t0 & (SEQ - 1)) != 0) {
            const u32x4 a = *(const u32x4*)(Z + (size_t)(t0 - 2) * 1024 + c0), b = *(const u32x4*)(Z + (size_t)(t0 - 1) * 1024 + c0);
            zm2[0] = bflo(a.x); zm2[1] = bfhi(a.x); zm2[2] = bflo(a.y); zm2[3] = bfhi(a.y); zm2[4] = bflo(a.z); zm2[5] = bfhi(a.z); zm2[6] = bflo(a.w); zm2[7] = bfhi(a.w);
            zm1[0] = bflo(b.x); zm1[1] = bfhi(b.x); zm1[2] = bflo(b.y); zm1[3] = bfhi(b.y); zm1[4] = bflo(b.z); zm1[5] = bfhi(b.z); zm1[6] = bflo(b.w); zm1[7] = bfhi(b.w);
        } else {
#pragma unroll
            for (int i = 0; i < 8; ++i) { zm2[i] = 0.f; zm1[i] = 0.f; }
        }
#pragma unroll 4
        for (int r = 0; r < 16; ++r) {
            const size_t o = (size_t)(t0 + r) * 1024 + c0;
            const u32x4 a = *(const u32x4*)(Z + o), g = *(const u32x4*)(BG + o);
            float z[8], bgv[8], y[8];
            z[0] = bflo(a.x); z[1] = bfhi(a.x); z[2] = bflo(a.y); z[3] = bfhi(a.y); z[4] = bflo(a.z); z[5] = bfhi(a.z); z[6] = bflo(a.w); z[7] = bfhi(a.w);
            bgv[0] = bflo(g.x); bgv[1] = bfhi(g.x); bgv[2] = bflo(g.y); bgv[3] = bfhi(g.y); bgv[4] = bflo(g.z); bgv[5] = bfhi(g.z); bgv[6] = bflo(g.w); bgv[7] = bfhi(g.w);
#pragma unroll
            for (int i = 0; i < 8; ++i) { y[i] = bgv[i] * (cb[i] + w0[i] * zm2[i] + w1[i] * zm1[i] + w2[i] * z[i]); zm2[i] = zm1[i]; zm1[i] = z[i]; }
            u32x4 ov; ov.x = pk2(y[0], y[1]); ov.y = pk2(y[2], y[3]); ov.z = pk2(y[4], y[5]); ov.w = pk2(y[6], y[7]);
            *(u32x4*)(BG + o) = ov;
        }
    }
}

namespace att {
constexpr int STAGE = 32768;
constexpr int XCH_OFF = 65536;
__device__ __forceinline__ int crow(int r, int hi) { return (r & 3) + 8 * (r >> 2) + 4 * hi; }
__device__ __forceinline__ s16x4 vtr(const LAS unsigned char* p) { return __builtin_bit_cast(s16x4, __builtin_amdgcn_ds_read_tr16_b64_v4i16((LAS s16x4*)p)); }

__device__ __forceinline__ void attn_unit(int b, int h, int qblk, const bf16_t* Q, const bf16_t* Kg, const bf16_t* Vg, bf16_t* O, const float* subln_g, float lam,
                                          LAS unsigned char* lds, int tid) {
    const int lane = tid & 63, wid = __builtin_amdgcn_readfirstlane(tid >> 6), rg = wid >> 1, c = wid & 1, r = lane & 31, hh = lane >> 5;
    const size_t seq0 = (size_t)b * SEQ;
    const int qs = qblk * 128 + rg * 32;
    bf16x8 qf[4];
    { const bf16_t* qp = Q + (seq0 + qs + r) * 1024 + h * 128 + c * 64 + 8 * hh;
#pragma unroll
      for (int ks = 0; ks < 4; ++ks) qf[ks] = *(const bf16x8*)(qp + 16 * ks); }
    const int kkey = tid >> 3, kch = tid & 7;
    const unsigned kdst = (unsigned)(kkey * 128 + ((kch ^ ((kkey >> 1) & 7)) * 16));
    const int v0key = tid >> 4, vch = tid & 15;
    const unsigned vdst0 = (unsigned)(v0key * 256 + (((vch >> 2) ^ (v0key & 3)) * 64) + (vch & 3) * 16);
    const unsigned vdst1 = vdst0 + 32 * 256;
    const bf16_t* kbase = Kg + seq0 * 1024 + h * 128 + kch * 8;
    const bf16_t* vbase = Vg + seq0 * 1024 + h * 128 + vch * 8;
    const int kswz = (r >> 1) & 7;
    unsigned koff[4];
#pragma unroll
    for (int ks = 0; ks < 4; ++ks) koff[ks] = (unsigned)(c * 8192 + r * 128 + (((ks * 2 + hh) ^ kswz) * 16));
    const int i16 = lane & 15, vq = i16 >> 2, vp = i16 & 3, g16 = (lane >> 4) & 1;
    unsigned voff[4];
#pragma unroll
    for (int dt = 0; dt < 4; ++dt) voff[dt] = (unsigned)(16384 + (4 * hh + vq) * 256 + ((dt ^ vq) * 64) + (16 * g16 + 4 * vp) * 2);

    f32x16 o[4];
#pragma unroll
    for (int dt = 0; dt < 4; ++dt)
#pragma unroll
        for (int i = 0; i < 16; ++i) o[dt][i] = 0.f;
    float mrun = -1e30f, lrun = 0.f;
    const int nt = 2 * qblk + 2;
    const int jmax = (qs + 31) >> 6;

    u32x4 pk0, pk1, pv0, pv1;
    { const size_t ro = (size_t)kkey * 1024; pk0 = *(const u32x4*)(kbase + ro); pk1 = *(const u32x4*)(kbase + ro + 64);
      pv0 = *(const u32x4*)(vbase + (size_t)v0key * 1024); pv1 = *(const u32x4*)(vbase + (size_t)(v0key + 32) * 1024); }
    *(LAS u32x4*)(lds + kdst) = pk0; *(LAS u32x4*)(lds + 8192 + kdst) = pk1; *(LAS u32x4*)(lds + 16384 + vdst0) = pv0; *(LAS u32x4*)(lds + 16384 + vdst1) = pv1;
    __syncthreads();
    for (int j = 0; j < nt; ++j) {
        const LAS unsigned char* st = lds + (j & 1) * STAGE;
        if (j + 1 < nt) { const size_t ro = (size_t)((j + 1) * 64 + kkey) * 1024; pk0 = *(const u32x4*)(kbase + ro); pk1 = *(const u32x4*)(kbase + ro + 64);
            pv0 = *(const u32x4*)(vbase + (size_t)((j + 1) * 64 + v0key) * 1024); pv1 = *(const u32x4*)(vbase + (size_t)((j + 1) * 64 + v0key + 32) * 1024); }
        if (j <= jmax) {
            f32x16 s0, s1;
#pragma unroll
            for (int i = 0; i < 16; ++i) { s0[i] = 0.f; s1[i] = 0.f; }
#pragma unroll
            for (int ks = 0; ks < 4; ++ks) {
                const bf16x8 ka = *(const LAS bf16x8*)(st + koff[ks]), kb = *(const LAS bf16x8*)(st + koff[ks] + 4096);
                s0 = __builtin_amdgcn_mfma_f32_32x32x16_bf16(ka, qf[ks], s0, 0, 0, 0);
                s1 = __builtin_amdgcn_mfma_f32_32x32x16_bf16(kb, qf[ks], s1, 0, 0, 0);
            }
            if (j * 64 + 63 > qs) {
                const int qrel = qs + r - j * 64;
#pragma unroll
                for (int i = 0; i < 16; ++i) { const int kv = crow(i, hh); if (kv > qrel) s0[i] = -INFINITY; if (kv + 32 > qrel) s1[i] = -INFINITY; }
            }
            float mx = fmaxf(s0[0], s1[0]);
#pragma unroll
            for (int i = 1; i < 16; ++i) mx = fmaxf(mx, fmaxf(s0[i], s1[i]));
            mx = fmaxf(mx, __shfl_xor(mx, 32));
            const float mnew = fmaxf(mrun, mx), al = exp2f(mrun - mnew);
            mrun = mnew;
            float ps = 0.f;
#pragma unroll
            for (int i = 0; i < 16; ++i) { s0[i] = exp2f(s0[i] - mnew); s1[i] = exp2f(s1[i] - mnew); ps += s0[i] + s1[i]; }
            lrun = lrun * al + ps;
#pragma unroll
            for (int dt = 0; dt < 4; ++dt)
#pragma unroll
                for (int i = 0; i < 16; ++i) o[dt][i] *= al;
            bf16x8 pf[4];
#pragma unroll
            for (int s = 0; s < 2; ++s) {
                u32x4 w0, w1;
                w0.x = pg8::cvt_pk_bf16(s0[8 * s + 0], s0[8 * s + 1]); w0.y = pg8::cvt_pk_bf16(s0[8 * s + 2], s0[8 * s + 3]); w0.z = pg8::cvt_pk_bf16(s0[8 * s + 4], s0[8 * s + 5]); w0.w = pg8::cvt_pk_bf16(s0[8 * s + 6], s0[8 * s + 7]);
                w1.x = pg8::cvt_pk_bf16(s1[8 * s + 0], s1[8 * s + 1]); w1.y = pg8::cvt_pk_bf16(s1[8 * s + 2], s1[8 * s + 3]); w1.z = pg8::cvt_pk_bf16(s1[8 * s + 4], s1[8 * s + 5]); w1.w = pg8::cvt_pk_bf16(s1[8 * s + 6], s1[8 * s + 7]);
                pf[s] = __builtin_bit_cast(bf16x8, w0); pf[2 + s] = __builtin_bit_cast(bf16x8, w1);
            }
#pragma unroll
            for (int dt = 0; dt < 4; ++dt) {
#pragma unroll
                for (int ks = 0; ks < 4; ++ks) {
                    const s16x4 lo = vtr(st + voff[dt] + ks * 16 * 256), hi = vtr(st + voff[dt] + ks * 16 * 256 + 8 * 256);
                    const bf16x8 va = (bf16x8){lo[0], lo[1], lo[2], lo[3], hi[0], hi[1], hi[2], hi[3]};
                    o[dt] = __builtin_amdgcn_mfma_f32_32x32x16_bf16(va, pf[ks], o[dt], 0, 0, 0);
                }
            }
        }
        if (j + 1 < nt) { LAS unsigned char* sn = lds + ((j + 1) & 1) * STAGE;
            *(LAS u32x4*)(sn + kdst) = pk0; *(LAS u32x4*)(sn + 8192 + kdst) = pk1; *(LAS u32x4*)(sn + 16384 + vdst0) = pv0; *(LAS u32x4*)(sn + 16384 + vdst1) = pv1; }
        __syncthreads();
    }
    const float ltot = lrun + __shfl_xor(lrun, 32);
    const float inv = (c == 0 ? 1.0f : lam) / ltot;
    LAS float* xch = (LAS float*)(lds + XCH_OFF) + rg * 4096 + lane;
    if (c == 1) {
#pragma unroll
        for (int dt = 0; dt < 4; ++dt)
#pragma unroll
            for (int i = 0; i < 16; ++i) xch[(dt * 16 + i) * 64] = o[dt][i] * inv;
    }
    __syncthreads();
    if (c == 0) {
        float ss = 0.f;
#pragma unroll
        for (int dt = 0; dt < 4; ++dt)
#pragma unroll
            for (int i = 0; i < 16; ++i) { const float v = o[dt][i] * inv - xch[(dt * 16 + i) * 64]; o[dt][i] = v; ss += v * v; }
        ss += __shfl_xor(ss, 32);
        const float rs = (1.0f - LAM_INIT) / sqrtf(ss * (1.0f / 128.0f) + LN_EPS);
        bf16_t* op = O + (seq0 + qs + r) * 1024 + h * 128 + 4 * hh;
#pragma unroll
        for (int dt = 0; dt < 4; ++dt)
#pragma unroll
            for (int g = 0; g < 4; ++g) { const int e = dt * 32 + 8 * g;
                const f32x4 gv = *(const f32x4*)(subln_g + e + 4 * hh);
                u32x2 w; w.x = pg8::cvt_pk_bf16(o[dt][4 * g] * rs * gv[0], o[dt][4 * g + 1] * rs * gv[1]); w.y = pg8::cvt_pk_bf16(o[dt][4 * g + 2] * rs * gv[2], o[dt][4 * g + 3] * rs * gv[3]);
                *(u32x2*)(op + e) = w; }
    }
    __syncthreads();
}
}

__device__ __forceinline__ void ln1_phase(float* X, bf16_t* XB, const float* g, const float* bta, int gw, int ngw, int lane) {
    f32x4 gv[4], bv[4];
#pragma unroll
    for (int j = 0; j < 4; ++j) { gv[j] = *(const f32x4*)(g + 4 * lane + 256 * j); bv[j] = *(const f32x4*)(bta + 4 * lane + 256 * j); }
    for (int m = gw; m < T; m += ngw) {
        f32x4* xr = (f32x4*)(X + (size_t)m * D) + lane;
        f32x4 v[4]; float s = 0.f;
#pragma unroll
        for (int j = 0; j < 4; ++j) { v[j] = xr[64 * j]; s += (v[j][0] + v[j][1]) + (v[j][2] + v[j][3]); }
        const float mean = wave_sum(s) * (1.f / D); float s2 = 0.f;
#pragma unroll
        for (int j = 0; j < 4; ++j) { v[j] = v[j] - mean; s2 += (v[j][0] * v[j][0] + v[j][1] * v[j][1]) + (v[j][2] * v[j][2] + v[j][3] * v[j][3]); }
        const float rstd = 1.f / sqrtf(wave_sum(s2) * (1.f / D) + LN_EPS);
        u32x2* o8 = (u32x2*)(XB + (size_t)m * D) + lane;
#pragma unroll
        for (int j = 0; j < 4; ++j) { const f32x4 y = v[j] * rstd * gv[j] + bv[j]; xr[64 * j] = y; u32x2 w; w.x = pk2(y[0], y[1]); w.y = pk2(y[2], y[3]); o8[64 * j] = w; }
    }
}

namespace peer {
constexpr int WAVE_LDS = 4096;
template <int NV>
__device__ __forceinline__ void top16(const float (&v)[NV], LAS float* oval, LAS int* oidx, int lane) {
    float lmx = v[0], lmn = v[0];
#pragma unroll
    for (int q = 1; q < NV; ++q) { lmx = fmaxf(lmx, v[q]); lmn = fminf(lmn, v[q]); }
    float hi = wave_max(lmx), lo = wave_min(lmn);
    lo = lo - fabsf(lo) * 1e-6f - 1e-30f;
    float thr = hi; int need_ties = 1;
    for (int it = 0; it < 64; ++it) {
        const float mid = 0.5f * (lo + hi);
        if (!(mid > lo && mid < hi)) break;
        int cnt = 0;
#pragma unroll
        for (int q = 0; q < NV; ++q) cnt += __popcll(__ballot(v[q] > mid));
        if (cnt == 16) { thr = mid; need_ties = 0; break; }
        if (cnt > 16) lo = mid; else hi = mid;
    }
    const float tie_hi = hi;
    int base = 0;
    if (!need_ties) {
#pragma unroll
        for (int q = 0; q < NV; ++q) { const bool sel = v[q] > thr; const unsigned long long bm = __ballot(sel);
            const int pos = base + (int)__builtin_amdgcn_mbcnt_hi((unsigned)(bm >> 32), __builtin_amdgcn_mbcnt_lo((unsigned)bm, 0u));
            if (sel) { oval[pos] = v[q]; oidx[pos] = lane + 64 * q; }
            base += __popcll(bm); }
    } else {
#pragma unroll
        for (int q = 0; q < NV; ++q) { const bool sel = v[q] > tie_hi; const unsigned long long bm = __ballot(sel);
            const int pos = base + (int)__builtin_amdgcn_mbcnt_hi((unsigned)(bm >> 32), __builtin_amdgcn_mbcnt_lo((unsigned)bm, 0u));
            if (sel && pos < 16) { oval[pos] = v[q]; oidx[pos] = lane + 64 * q; }
            base += __popcll(bm); }
#pragma unroll
        for (int q = 0; q < NV; ++q) { const bool sel = (v[q] <= tie_hi) && (v[q] > lo); const unsigned long long bm = __ballot(sel);
            const int pos = base + (int)__builtin_amdgcn_mbcnt_hi((unsigned)(bm >> 32), __builtin_amdgcn_mbcnt_lo((unsigned)bm, 0u));
            if (sel && pos < 16) { oval[pos] = v[q]; oidx[pos] = lane + 64 * q; }
            base += __popcll(bm); }
    }
    LDS_WAIT();
}

__device__ __forceinline__ void unpack8(const u32x4 a, float (&f)[8]) {
    f[0] = bflo(a.x); f[1] = bfhi(a.x); f[2] = bflo(a.y); f[3] = bfhi(a.y); f[4] = bflo(a.z); f[5] = bfhi(a.z); f[6] = bflo(a.w); f[7] = bfhi(a.w);
}

__device__ __forceinline__ void token(int t, const float* SC, float* X1  , const bf16_t* UB, const bf16_t* VB, const float* ln_g, const float* ln_b,
                                      LAS unsigned char* wl, int lane) {
    LAS float* s1v = (LAS float*)wl; LAS int* s1i = (LAS int*)(wl + 64); LAS float* s2v = (LAS float*)(wl + 128); LAS int* s2i = (LAS int*)(wl + 192);
    LAS float* cv = (LAS float*)(wl + 256); LAS int* ci = (LAS int*)(wl + 320);
    LAS int* eidx = (LAS int*)(wl + 512); LAS float* gsel = (LAS float*)(wl + 1024); LAS float* wsel = (LAS float*)(wl + 1536);
    const float* sc = SC + (size_t)t * 2048;
    for (int h = 0; h < NHEAD; ++h) {
        float a[2], bq[2];
        a[0] = sc[h * 256 + lane]; a[1] = sc[h * 256 + 64 + lane]; bq[0] = sc[h * 256 + 128 + lane]; bq[1] = sc[h * 256 + 192 + lane];
        top16<2>(a, s1v, s1i, lane);
        top16<2>(bq, s2v, s2i, lane);
        float cand[4];
#pragma unroll
        for (int q = 0; q < 4; ++q) { const int idx = lane + 64 * q; cand[q] = s1v[idx >> 4] + s2v[idx & 15]; }
        top16<4>(cand, cv, ci, lane);
        {
            const float v = cv[lane & 15]; const int code = ci[lane & 15];
            float mx = v;
#pragma unroll
            for (int o = 1; o < 16; o <<= 1) mx = fmaxf(mx, __shfl_xor(mx, o));
            const float e = __expf(v - mx); float sm = e;
#pragma unroll
            for (int o = 1; o < 16; o <<= 1) sm += __shfl_xor(sm, o);
            if (lane < 16) { gsel[h * 16 + lane] = e / sm; eidx[h * 16 + lane] = s1i[code >> 4] * 128 + s2i[code & 15]; }
        }
        LDS_WAIT();
    }
    float xr[16];
    { const f32x4* xp = (const f32x4*)(X1 + (size_t)t * D);
      const f32x4 a0 = xp[2 * lane], a1 = xp[2 * lane + 1], b0 = xp[128 + 2 * lane], b1 = xp[128 + 2 * lane + 1];
#pragma unroll
      for (int i = 0; i < 4; ++i) { xr[i] = a0[i]; xr[4 + i] = a1[i]; xr[8 + i] = b0[i]; xr[12 + i] = b1[i]; } }
    const int hb5 = (lane >> 5) & 1, hb4 = (lane >> 4) & 1, hb3 = (lane >> 3) & 1;
    for (int k0 = 0; k0 < 128; k0 += 8) {
        u32x4 ra[8], rb[8];
#pragma unroll
        for (int e = 0; e < 8; ++e) { const int ei = __builtin_amdgcn_readfirstlane(eidx[k0 + e]); const bf16_t* row = UB + (size_t)ei * D;
            ra[e] = *(const u32x4*)(row + 8 * lane); rb[e] = *(const u32x4*)(row + 512 + 8 * lane); }
        float s[8];
#pragma unroll
        for (int e = 0; e < 8; ++e) { float fa[8], fb[8]; unpack8(ra[e], fa); unpack8(rb[e], fb); float d = 0.f;
#pragma unroll
            for (int i = 0; i < 8; ++i) d += xr[i] * fa[i] + xr[8 + i] * fb[i];
            s[e] = d; }
        float r4[4], r2[2], r1;
#pragma unroll
        for (int i = 0; i < 4; ++i) { const float mine = hb5 ? s[4 + i] : s[i], oth = hb5 ? s[i] : s[4 + i]; r4[i] = mine + __shfl_xor(oth, 32); }
#pragma unroll
        for (int i = 0; i < 2; ++i) { const float mine = hb4 ? r4[2 + i] : r4[i], oth = hb4 ? r4[i] : r4[2 + i]; r2[i] = mine + __shfl_xor(oth, 16); }
        { const float mine = hb3 ? r2[1] : r2[0], oth = hb3 ? r2[0] : r2[1]; r1 = mine + __shfl_xor(oth, 8); }
        r1 += __shfl_xor(r1, 4); r1 += __shfl_xor(r1, 2); r1 += __shfl_xor(r1, 1);
        const int ke = k0 + hb5 * 4 + hb4 * 2 + hb3;
        const float act = 0.5f * r1 * (1.0f + erff(r1 * 0.70710678118654752f));
        if ((lane & 7) == 0) wsel[ke] = gsel[ke] * act;
    }
    LDS_WAIT();
    float acc[16];
#pragma unroll
    for (int i = 0; i < 16; ++i) acc[i] = 0.f;
    for (int k0 = 0; k0 < 128; k0 += 8) {
        u32x4 ra[8], rb[8];
#pragma unroll
        for (int e = 0; e < 8; ++e) { const int ei = __builtin_amdgcn_readfirstlane(eidx[k0 + e]); const bf16_t* row = VB + (size_t)ei * D;
            ra[e] = *(const u32x4*)(row + 8 * lane); rb[e] = *(const u32x4*)(row + 512 + 8 * lane); }
#pragma unroll
        for (int e = 0; e < 8; ++e) { float fa[8], fb[8]; unpack8(ra[e], fa); unpack8(rb[e], fb); const float wk = wsel[k0 + e];
#pragma unroll
            for (int i = 0; i < 8; ++i) { acc[i] += wk * fa[i]; acc[8 + i] += wk * fb[i]; } }
    }
    float s = 0.f;
#pragma unroll
    for (int i = 0; i < 16; ++i) { acc[i] = ALPHA * xr[i] + acc[i]; s += acc[i]; }
    const float mean = wave_sum(s) * (1.f / D); float s2 = 0.f;
#pragma unroll
    for (int i = 0; i < 16; ++i) { acc[i] -= mean; s2 += acc[i] * acc[i]; }
    const float rstd = 1.f / sqrtf(wave_sum(s2) * (1.f / D) + LN_EPS);
    { const f32x4* gp = (const f32x4*)ln_g; const f32x4* bp = (const f32x4*)ln_b; f32x4* op = (f32x4*)(X1 + (size_t)t * D);
      const f32x4 g0 = gp[2 * lane], g1 = gp[2 * lane + 1], g2 = gp[128 + 2 * lane], g3 = gp[128 + 2 * lane + 1];
      const f32x4 b0 = bp[2 * lane], b1 = bp[2 * lane + 1], b2 = bp[128 + 2 * lane], b3 = bp[128 + 2 * lane + 1];
      f32x4 y0, y1, y2, y3;
#pragma unroll
      for (int i = 0; i < 4; ++i) { y0[i] = acc[i] * rstd * g0[i] + b0[i]; y1[i] = acc[4 + i] * rstd * g1[i] + b1[i]; y2[i] = acc[8 + i] * rstd * g2[i] + b2[i]; y3[i] = acc[12 + i] * rstd * g3[i] + b3[i]; }
      op[2 * lane] = y0; op[2 * lane + 1] = y1; op[128 + 2 * lane] = y2; op[128 + 2 * lane + 1] = y3; }
}
}

#define GAS __attribute__((address_space(1)))
typedef GAS unsigned gu32;
#define XB_TMO      128
#define XB_XCNT(j)  (256  + 64 * (j))
#define XB_XSUB(j)  (1280 + 64 * (j))
#define XB_XGEN(j)  (2304 + 64 * (j))
#define XB_TOP      3328
#define XB_TOPGEN   3392
#define XCD_BAR_WORDS 3456
#define XB_SPIN_CAP (1u << 18)

__device__ __forceinline__ unsigned xb_ld(unsigned* p)              { return __hip_atomic_load(p, __ATOMIC_RELAXED, __HIP_MEMORY_SCOPE_AGENT); }
__device__ __forceinline__ unsigned xb_add(unsigned* p, unsigned v) { return __hip_atomic_fetch_add(p, v, __ATOMIC_RELAXED, __HIP_MEMORY_SCOPE_AGENT); }
__device__ __forceinline__ unsigned xb_xcc_id() { return (unsigned)__builtin_amdgcn_s_getreg((3 << 11) | 20) & 0xFu; }
#define XB_SPIN(cond, bar) do { unsigned _sp = 0; while (cond) { __builtin_amdgcn_s_sleep(1); \
    if ((++_sp & 255u) == 0u) { if (xb_ld(&(bar)[XB_TMO])) break; if (_sp > XB_SPIN_CAP) { atomicAdd(&(bar)[XB_TMO], 1u); break; } } } } while (0)

struct XcdBarrier {
    unsigned* bar; unsigned x;
    volatile LAS unsigned* st;
};

__device__ __forceinline__ XcdBarrier xcd_barrier_post(unsigned* bar, volatile LAS unsigned* st) {
    XcdBarrier b; b.bar = bar; b.x = xb_xcc_id(); b.st = st;
    if (threadIdx.x == 0) (void)xb_add(&bar[XB_XCNT(b.x)], 1u);
    return b;
}
__device__ __forceinline__ void xcd_barrier_complete(unsigned* bar, unsigned x, unsigned& nloc, unsigned& nx) {
    const unsigned G = gridDim.x * gridDim.y * gridDim.z;
    unsigned sum, cnt, mine, sp = 0u;
    for (;;) {
        sum = 0u; cnt = 0u; mine = 0u;
#pragma unroll
        for (unsigned j = 0; j < 16; ++j) { const unsigned c = xb_ld(&bar[XB_XCNT(j)]); sum += c; cnt += (c > 0u) ? 1u : 0u; mine = (j == x) ? c : mine; }
        if (sum == G) break;
        __builtin_amdgcn_s_sleep(1);
        if ((++sp & 255u) == 0u) { if (xb_ld(&bar[XB_TMO])) break; if (sp > XB_SPIN_CAP) { atomicAdd(&bar[XB_TMO], 1u); break; } }
    }
    nloc = mine > 0u ? mine : 1u; nx = cnt > 0u ? cnt : 1u;
}

__device__ __forceinline__ void xcd_barrier(const XcdBarrier& b) {
    asm volatile("s_waitcnt vmcnt(0)" ::: "memory");
    __syncthreads();
    if (threadIdx.x == 0) {
        unsigned* bar = b.bar;
        __builtin_amdgcn_s_waitcnt(0);
        unsigned nloc = b.st[0], nx = b.st[1];
        if (nloc == 0u) { xcd_barrier_complete(bar, b.x, nloc, nx); b.st[0] = nloc; b.st[1] = nx; }
        const unsigned old = xb_add(&bar[XB_XSUB(b.x)], 1u);
        const unsigned gen = old / nloc;
        if (old + 1u == (gen + 1u) * nloc) {
            __builtin_amdgcn_fence(__ATOMIC_RELEASE, "agent");
            asm volatile("s_waitcnt vmcnt(0)" ::: "memory");
            const unsigned og = xb_add(&bar[XB_TOP], 1u);
            const unsigned tg = og / nx;
            if (og + 1u == (tg + 1u) * nx) xb_add(&bar[XB_TOPGEN], 1u);
            else XB_SPIN(xb_ld(&bar[XB_TOPGEN]) == tg, bar);
            __builtin_amdgcn_fence(__ATOMIC_ACQUIRE, "agent");
            xb_add(&bar[XB_XGEN(b.x)], 1u);
            asm volatile("s_waitcnt vmcnt(0)" ::: "memory");
        } else {
            XB_SPIN(xb_ld(&bar[XB_XGEN(b.x)]) == gen, bar);
            __builtin_amdgcn_fence(__ATOMIC_ACQUIRE, "agent");
            asm volatile("s_waitcnt vmcnt(0)" ::: "memory");
        }
    }
    __syncthreads();
}

struct Args {
    const float *x; const int* positions; const float *w_in, *conv_w, *conv_b, *gate_b, *lq1, *lk1, *lq2, *lk2, *subln_g, *w_conv_out, *w_attn_out, *w_o, *ln1_g, *ln1_b, *w_pq, *sub_keys, *u_tab, *v_tab, *ln2_g, *ln2_b;
    float* out; unsigned char* ws; int ph_lo, ph_hi;
};

__global__ void __launch_bounds__(NTHREADS, 2) fwd_kernel(Args a) {
    extern __shared__ __attribute__((aligned(16))) unsigned char lds_raw[];
    LAS unsigned char* lds = (LAS unsigned char*)lds_raw;
    const int tid = threadIdx.x, lane = tid & 63, wave = __builtin_amdgcn_readfirstlane(tid >> 6);
    const int G = gridDim.x, bx = blockIdx.x;
    const int gw = bx * NWAVES + wave, ngw = G * NWAVES, gtid = bx * NTHREADS + tid, gthreads = G * NTHREADS;
    unsigned char* ws = a.ws;
    bf16_t* Wt_in = (bf16_t*)(ws + WS_WIN); bf16_t* Wt_co = (bf16_t*)(ws + WS_WCO); bf16_t* Wt_ao = (bf16_t*)(ws + WS_WAO); bf16_t* Wt_o = (bf16_t*)(ws + WS_WO); bf16_t* Wt_sc = (bf16_t*)(ws + WS_WSC);
    float* CS = (float*)(ws + WS_CS);
    bf16_t* XB = (bf16_t*)(ws + WS_XB); bf16_t* Zb = (bf16_t*)(ws + WS_Z); bf16_t* BG = (bf16_t*)(ws + WS_BG); bf16_t* Qb = (bf16_t*)(ws + WS_Q); bf16_t* Kb = (bf16_t*)(ws + WS_K); bf16_t* Vb = (bf16_t*)(ws + WS_V);
    bf16_t* Gb = (bf16_t*)a.out;
    bf16_t* UB = (bf16_t*)(ws + WS_UB); bf16_t* VB = (bf16_t*)(ws + WS_VB); bf16_t* T1 = (bf16_t*)(ws + WS_T1); bf16_t* MG = (bf16_t*)(ws + WS_MG);
    bf16_t* X1B = (bf16_t*)(ws + WS_X1B); float* SC = (float*)(ws + WS_SC);
    const int lo = a.ph_lo, hi = a.ph_hi;
    for (int u = tid; u < (LDS_BYTES - LDSCTL_OFF) / 4; u += NTHREADS) ((LAS unsigned*)(lds + LDSCTL_OFF))[u] = 0u;
    __syncthreads();
    XcdBarrier bar; bar.bar = (unsigned*)(ws + WS_CTL) + CW_BAR; bar.x = 0; bar.st = nullptr;
    if (MK_N_LAUNCHES == 1) bar = xcd_barrier_post((unsigned*)(ws + WS_CTL) + CW_BAR, (volatile LAS unsigned*)(lds + MISC_OFF) + 8);
#define IN(k) (lo <= (k) && (k) < hi)
#define SEAM(k) do { if (IN(k) && IN((k) + 1)) xcd_barrier(bar); } while (0)

    if (IN(0)) {
        for (int it = bx; it < 256; it += G) wsc_item(a.w_pq, a.sub_keys, Wt_sc, lds, it, tid);
        LAS float* scr = (LAS float*)(lds + wave * 16384);
        constexpr int I_IN = (D / 64) * (NIN / 32), I_SQ = (D / 64) * (D / 32);
        for (int it = gw; it < I_IN + 3 * I_SQ; it += ngw) {
            int r = it;
            if (r < I_IN) { transpose_item<true>(a.w_in, D, NIN, Wt_in, scr, r, lane); continue; } r -= I_IN;
            if (r < I_SQ) { transpose_item<false>(a.w_conv_out, D, D, Wt_co, scr, r, lane); continue; } r -= I_SQ;
            if (r < I_SQ) { transpose_item<false>(a.w_attn_out, D, D, Wt_ao, scr, r, lane); continue; } r -= I_SQ;
            transpose_item<false>(a.w_o, D, D, Wt_o, scr, r, lane);
        }
        cvt_bf16(a.x, XB, (size_t)T * D, gtid, gthreads);
        for (int i = gtid; i < T * 8; i += gthreads) { const int t = i >> 3, f = i & 7;
            const float inv_freq = powf(500000.0f, -(float)f * 0.125f); const float ang = (float)a.positions[t] * inv_freq;
            CS[t * 16 + f] = cosf(ang); CS[t * 16 + 8 + f] = sinf(ang); }
    }
    SEAM(0);
    if (IN(1)) {
        pg8::Gemm g{XB, Wt_in, T, NIN, D}; pg8::StaticOrder S; S.init(T, NIN, G, bx);
        pg8::EpiProj E{Zb, BG, Qb, Kb, Vb, Gb, a.gate_b, CS};
        pg8::gemm_phase<pg8::EpiProj, pg8::StaticOrder, true, true>(lds, g, S, E);
    }
    SEAM(1);
    if (IN(2)) {
        conv_phase(Zb, BG, a.conv_w, a.conv_b, gtid, gthreads);
        float lam;
        { const float p1 = wave_sum(a.lq1[lane] * a.lk1[lane]), p2 = wave_sum(a.lq2[lane] * a.lk2[lane]); lam = __expf(p1) - __expf(p2) + LAM_INIT; }
        for (int it = bx; it < 512; it += G) {
            const int bh = it >> 3, pq = it & 7, b = bh >> 3, h = bh & 7;
            att::attn_unit(b, h, 15 - pq, Qb, Kb, Vb, Qb, a.subln_g, lam, lds, tid);
            att::attn_unit(b, h, pq, Qb, Kb, Vb, Qb, a.subln_g, lam, lds, tid);
        }
    }
    SEAM(2);
    if (IN(3)) {
        cvt_bf16(a.u_tab, UB, (size_t)NEXP * D, gtid, gthreads);
        cvt_bf16(a.v_tab, VB, (size_t)NEXP * D, gtid, gthreads);
        pg8::Gemm g{BG, Wt_co, T, D, D}; pg8::StaticOrder S; S.init(T, D, G, bx);
        pg8::EpiGate1 E{Gb, T1};
        pg8::gemm_phase<pg8::EpiGate1, pg8::StaticOrder, true, true>(lds, g, S, E);
    }
    SEAM(3);
    if (IN(4)) {
        pg8::Gemm g{Qb, Wt_ao, T, D, D}; pg8::StaticOrder S; S.init(T, D, G, bx);
        pg8::EpiGate2 E{Gb, T1, MG};
        pg8::gemm_phase<pg8::EpiGate2, pg8::StaticOrder, true, true>(lds, g, S, E);
    }
    SEAM(4);
    if (IN(5)) {
        pg8::Gemm g{MG, Wt_o, T, D, D}; pg8::StaticOrder S; S.init(T, D, G, bx);
        pg8::EpiF32<true, 1024> E{a.x, a.out};
        pg8::gemm_phase<pg8::EpiF32<true, 1024>, pg8::StaticOrder, true, true>(lds, g, S, E);
    }
    SEAM(5);
    if (IN(6)) ln1_phase(a.out, X1B, a.ln1_g, a.ln1_b, gw, ngw, lane);
    SEAM(6);
    if (IN(7)) {
        pg8::Gemm g{X1B, Wt_sc, T, 2048, D}; pg8::StaticOrder S; S.init(T, 2048, G, bx);
        pg8::EpiF32<false, 2048> E{nullptr, SC};
        pg8::gemm_phase<pg8::EpiF32<false, 2048>, pg8::StaticOrder, true, true>(lds, g, S, E);
    }
    SEAM(7);
    if (IN(8)) {
        LAS unsigned char* wl = lds + wave * peer::WAVE_LDS;
        for (int t = gw; t < T; t += ngw) peer::token(t, SC, a.out, UB, VB, a.ln2_g, a.ln2_b, wl, lane);
    }
#undef IN
#undef SEAM
}

extern "C" void kernel_launch(void* const* d_in, const int* in_sizes, int n_in, void* d_out, int out_size, void* d_ws, size_t ws_size, hipStream_t stream) {
    static int grid = 0;
    if (grid == 0) {
        if (n_in != 22 || out_size != T * D || ws_size < WS_END) { fprintf(stderr, "kernel_launch: unexpected shapes (n_in %d, out %d, ws %zu); nothing launched\n", n_in, out_size, ws_size); grid = -1; return; }
        int dev = 0, cus = 0, per_cu = 0;
        if (hipGetDevice(&dev) != hipSuccess || hipDeviceGetAttribute(&cus, hipDeviceAttributeMultiprocessorCount, dev) != hipSuccess) { grid = -1; return; }
        if (hipFuncSetAttribute((const void*)fwd_kernel, hipFuncAttributeMaxDynamicSharedMemorySize, LDS_BYTES) != hipSuccess) { fprintf(stderr, "kernel_launch: hipFuncSetAttribute failed\n"); grid = -1; return; }
        if (hipOccupancyMaxActiveBlocksPerMultiprocessor(&per_cu, (const void*)fwd_kernel, NTHREADS, LDS_BYTES) != hipSuccess || per_cu < 1) { fprintf(stderr, "kernel_launch: occupancy query failed (%d)\n", per_cu); (void)hipGetLastError(); per_cu = 1; }
        grid = cus * per_cu;
    }
    if (grid < 0) return;
    if (hipMemsetAsync((char*)d_ws + WS_CTL, 0, CTL_ZERO_BYTES, stream) != hipSuccess) { fprintf(stderr, "kernel_launch: hipMemsetAsync failed\n"); return; }
    Args a{};
    a.x = (const float*)d_in[0]; a.positions = (const int*)d_in[1]; a.w_in = (const float*)d_in[2]; a.conv_w = (const float*)d_in[3]; a.conv_b = (const float*)d_in[4]; a.gate_b = (const float*)d_in[5];
    a.lq1 = (const float*)d_in[6]; a.lk1 = (const float*)d_in[7]; a.lq2 = (const float*)d_in[8]; a.lk2 = (const float*)d_in[9]; a.subln_g = (const float*)d_in[10];
    a.w_conv_out = (const float*)d_in[11]; a.w_attn_out = (const float*)d_in[12]; a.w_o = (const float*)d_in[13]; a.ln1_g = (const float*)d_in[14]; a.ln1_b = (const float*)d_in[15];
    a.w_pq = (const float*)d_in[16]; a.sub_keys = (const float*)d_in[17]; a.u_tab = (const float*)d_in[18]; a.v_tab = (const float*)d_in[19]; a.ln2_g = (const float*)d_in[20]; a.ln2_b = (const float*)d_in[21];
    a.out = (float*)d_out; a.ws = (unsigned char*)d_ws;
#if MK_N_LAUNCHES == 1
    a.ph_lo = 0; a.ph_hi = NPHASES;
    void* args[] = {&a};
    hipError_t e = hipLaunchCooperativeKernel((const void*)fwd_kernel, dim3(grid), dim3(NTHREADS), args, LDS_BYTES, stream);
    if (e != hipSuccess) fprintf(stderr, "kernel_launch: cooperative launch failed: %s (grid %d)\n", hipGetErrorString(e), grid);
#else
    for (int p = 0; p < NPHASES; ++p) { a.ph_lo = p; a.ph_hi = p + 1; hipLaunchKernelGGL(fwd_kernel, dim3(grid), dim3(NTHREADS), LDS_BYTES, stream, a); }
#endif
}
```

```cpp
#include <hip/hip_runtime.h>
#include <hip/hip_cooperative_groups.h>
#include <cstdio>
#include <cstdint>
namespace cg = cooperative_groups;
namespace pg8 {
#define PG8_LAS __attribute__((address_space(3)))
typedef unsigned short bf16_t;
typedef short bf16x8 __attribute__((ext_vector_type(8)));
typedef float f32x4 __attribute__((ext_vector_type(4)));
typedef unsigned u32x4 __attribute__((ext_vector_type(4)));
constexpr int BM = 256, BK = 64, HALF = 128, HTB = HALF * BK * 2  , STAGE_BYTES = 8 * HTB, NXCD = 8, WGM = 8;

__host__ __device__ __forceinline__ int lds_byte(int r, int c) { const int st = (r >> 4) * 2 + (c >> 5), rr = r & 15, cc = c & 31, ob = rr * 64 + cc * 2; return st * 1024 + (ob ^ (((ob >> 9) & 1) << 5)); }
__host__ __device__ __forceinline__ void stage_rc(int b, int& R, int& C) { const int st = b / 1024, sb = b % 1024, swz = sb ^ (((sb >> 9) & 1) << 5); R = (st >> 1) * 16 + swz / 64; C = (st & 1) * 32 + (swz % 64) / 2; }
__host__ __device__ __forceinline__ int perm32(int rho) { const int n = rho >> 4, i = rho & 15; return 8 * (i >> 2) + 4 * n + (i & 3); }

struct Unit { int pm, pn; };
struct Gemm { const bf16_t* A; const bf16_t* Bt; int M, N, K; };

struct StaticOrder {
    int nM, nN, nwg, G, c;
    __host__ __device__ void init(int M, int N, int G_, int c_) { nM = M / BM; nN = N / BM; nwg = nM * nN; G = G_; c = c_; }
    __host__ __device__ bool next(int i, Unit& u) const {
        const long L = (long)i * G + c; if (L >= nwg) return false;
        int wgid = (int)L; { const int q = nwg / NXCD, r = nwg % NXCD, xcd = wgid % NXCD, off = wgid / NXCD; wgid = (xcd < r ? xcd * (q + 1) : r * (q + 1) + (xcd - r) * q) + off; }
        const int nig = WGM * nN, gid = wgid / nig, fm = gid * WGM, gsz = (nM - fm) < WGM ? (nM - fm) : WGM;
        u.pm = fm + ((wgid % nig) % gsz); u.pn = (wgid % nig) / gsz; return true;
    }
    __device__ __forceinline__ void a_ready(const Unit&) const {}
    __device__ __forceinline__ void done(const Unit&) const {}
};


__device__ __forceinline__ unsigned cvt_pk_bf16(float lo, float hi) { unsigned r; asm volatile("v_cvt_pk_bf16_f32 %0, %1, %2" : "=v"(r) : "v"(lo), "v"(hi)); return r; }
__device__ __forceinline__ void store8(bf16_t* p, f32x4 v0, f32x4 v1) {
    u32x4 w; w.x = cvt_pk_bf16(v0[0], v0[1]); w.y = cvt_pk_bf16(v0[2], v0[3]); w.z = cvt_pk_bf16(v1[0], v1[1]); w.w = cvt_pk_bf16(v1[2], v1[3]);
    *(u32x4*)p = w;
}
__device__ __forceinline__ void load8(const bf16_t* p, f32x4& v0, f32x4& v1) {
    const u32x4 w = *(const u32x4*)p;
    v0[0] = __uint_as_float(w.x << 16); v0[1] = __uint_as_float(w.x & 0xffff0000u); v0[2] = __uint_as_float(w.y << 16); v0[3] = __uint_as_float(w.y & 0xffff0000u);
    v1[0] = __uint_as_float(w.z << 16); v1[1] = __uint_as_float(w.z & 0xffff0000u); v1[2] = __uint_as_float(w.w << 16); v1[3] = __uint_as_float(w.w & 0xffff0000u);
}
constexpr float QSCALE = 0.125f * 1.4426950408889634f;

struct EpiProj {
    static constexpr bool PERM = true, AFTER_DRAIN = false;
    bf16_t *Z, *BG, *Q, *Kk, *V, *G; const float* gate_b; const float* CS;
    __device__ __forceinline__ void operator()(const f32x4 (&acc)[2][2][4][2], const Unit& u, int wr, int wc, int fr, int fq) const {
        const int row0 = u.pm * BM + wr * 64 + fr, pn = u.pn, cw = wc * 32 + 8 * fq;
        if (pn < 8) {
#pragma unroll
            for (int ai = 0; ai < 2; ++ai)
#pragma unroll
                for (int m = 0; m < 4; ++m) { const size_t row = row0 + ai * HALF + m * 16;
                    store8(Z + row * 1024 + pn * 128 + cw, acc[ai][0][m][0] * acc[ai][1][m][0], acc[ai][0][m][1] * acc[ai][1][m][1]); }
        } else if (pn < 12) {
#pragma unroll
            for (int ai = 0; ai < 2; ++ai)
#pragma unroll
                for (int m = 0; m < 4; ++m) { const size_t row = row0 + ai * HALF + m * 16;
#pragma unroll
                    for (int bj = 0; bj < 2; ++bj) store8(BG + row * 1024 + (pn - 8) * 256 + bj * HALF + cw, acc[ai][bj][m][0], acc[ai][bj][m][1]); }
        } else if (pn < 20) {
            const bool isq = pn < 16; bf16_t* dst = isq ? Q : Kk; const int cb = ((pn - 12) & 3) * 256; const float sc = isq ? QSCALE : 1.0f;
            const bool rot = ((wc & 1) == 0) && (fq < 2);
#pragma unroll
            for (int ai = 0; ai < 2; ++ai)
#pragma unroll
                for (int m = 0; m < 4; ++m) { const size_t row = row0 + ai * HALF + m * 16;
                    f32x4 c4 = *(const f32x4*)(CS + row * 16 + 4 * (fq & 1)), s4 = *(const f32x4*)(CS + row * 16 + 8 + 4 * (fq & 1));
                    if (!rot) { c4 = (f32x4){1.f, 1.f, 1.f, 1.f}; s4 = (f32x4){0.f, 0.f, 0.f, 0.f}; }
#pragma unroll
                    for (int bj = 0; bj < 2; ++bj) { const f32x4 v0 = acc[ai][bj][m][0], v1 = acc[ai][bj][m][1]; f32x4 o0, o1;
                        o0[0] = v0[0] * c4[0] - v0[1] * s4[0]; o0[1] = v0[1] * c4[0] + v0[0] * s4[0];
                        o0[2] = v0[2] * c4[1] - v0[3] * s4[1]; o0[3] = v0[3] * c4[1] + v0[2] * s4[1];
                        o1[0] = v1[0] * c4[2] - v1[1] * s4[2]; o1[1] = v1[1] * c4[2] + v1[0] * s4[2];
                        o1[2] = v1[2] * c4[3] - v1[3] * s4[3]; o1[3] = v1[3] * c4[3] + v1[2] * s4[3];
                        store8(dst + row * 1024 + cb + bj * HALF + cw, o0 * sc, o1 * sc); } }
        } else if (pn < 24) {
#pragma unroll
            for (int ai = 0; ai < 2; ++ai)
#pragma unroll
                for (int m = 0; m < 4; ++m) { const size_t row = row0 + ai * HALF + m * 16;
#pragma unroll
                    for (int bj = 0; bj < 2; ++bj) store8(V + row * 1024 + (pn - 20) * 256 + bj * HALF + cw, acc[ai][bj][m][0], acc[ai][bj][m][1]); }
        } else {
            f32x4 bv[2][2];
#pragma unroll
            for (int bj = 0; bj < 2; ++bj)
#pragma unroll
                for (int n = 0; n < 2; ++n) bv[bj][n] = *(const f32x4*)(gate_b + (pn - 24) * 256 + bj * HALF + cw + 4 * n);
#pragma unroll
            for (int ai = 0; ai < 2; ++ai)
#pragma unroll
                for (int m = 0; m < 4; ++m) { const size_t row = row0 + ai * HALF + m * 16;
#pragma unroll
                    for (int bj = 0; bj < 2; ++bj) { f32x4 g0 = acc[ai][bj][m][0] + bv[bj][0], g1 = acc[ai][bj][m][1] + bv[bj][1];
#pragma unroll
                        for (int i = 0; i < 4; ++i) { g0[i] = 1.0f / (1.0f + __expf(-g0[i])); g1[i] = 1.0f / (1.0f + __expf(-g1[i])); }
                        store8(G + row * 2048 + (pn - 24) * 256 + bj * HALF + cw, g0, g1); } }
        }
    }
};
struct EpiGate1 {
    static constexpr bool PERM = true, AFTER_DRAIN = false;
    const bf16_t* G; bf16_t* T1;
    __device__ __forceinline__ void operator()(const f32x4 (&acc)[2][2][4][2], const Unit& u, int wr, int wc, int fr, int fq) const {
        const int row0 = u.pm * BM + wr * 64 + fr, col0 = u.pn * BM + wc * 32 + 8 * fq;
#pragma unroll
        for (int ai = 0; ai < 2; ++ai)
#pragma unroll
            for (int m = 0; m < 4; ++m) { const size_t row = row0 + ai * HALF + m * 16;
#pragma unroll
                for (int bj = 0; bj < 2; ++bj) { f32x4 g0, g1; load8(G + row * 2048 + col0 + bj * HALF, g0, g1);
                    store8(T1 + row * 1024 + col0 + bj * HALF, acc[ai][bj][m][0] * g0, acc[ai][bj][m][1] * g1); } }
    }
};
struct EpiGate2 {
    static constexpr bool PERM = true, AFTER_DRAIN = false;
    const bf16_t* G; const bf16_t* T1; bf16_t* MG;
    __device__ __forceinline__ void operator()(const f32x4 (&acc)[2][2][4][2], const Unit& u, int wr, int wc, int fr, int fq) const {
        const int row0 = u.pm * BM + wr * 64 + fr, col0 = u.pn * BM + wc * 32 + 8 * fq;
#pragma unroll
        for (int ai = 0; ai < 2; ++ai)
#pragma unroll
            for (int m = 0; m < 4; ++m) { const size_t row = row0 + ai * HALF + m * 16;
#pragma unroll
                for (int bj = 0; bj < 2; ++bj) { f32x4 g0, g1, t0, t1; load8(G + row * 2048 + 1024 + col0 + bj * HALF, g0, g1); load8(T1 + row * 1024 + col0 + bj * HALF, t0, t1);
                    store8(MG + row * 1024 + col0 + bj * HALF, t0 + acc[ai][bj][m][0] * g0, t1 + acc[ai][bj][m][1] * g1); } }
    }
};
template <bool HAS_BASE, int ldc> struct EpiF32 {
    static constexpr bool PERM = false, AFTER_DRAIN = false;
    static constexpr float alpha = 1.189207115002721f;
    const float* base; float* O;
    __device__ __forceinline__ void operator()(const f32x4 (&acc)[2][2][4][2], const Unit& u, int wr, int wc, int fr, int fq) const {
        const int row0 = u.pm * BM + wr * 64 + fr, col0 = u.pn * BM + wc * 32 + 4 * fq;
#pragma unroll
        for (int ai = 0; ai < 2; ++ai)
#pragma unroll
            for (int m = 0; m < 4; ++m) { const size_t row = row0 + ai * HALF + m * 16;
#pragma unroll
                for (int bj = 0; bj < 2; ++bj)
#pragma unroll
                    for (int n = 0; n < 2; ++n) { const size_t o = row * ldc + col0 + bj * HALF + n * 16; f32x4 v = acc[ai][bj][m][n];
                        if constexpr (HAS_BASE) v = v + alpha * *(const f32x4*)(base + o);
                        *(f32x4*)(O + o) = v; } }
    }
};

template <class Epi, class Sched, bool ALIGN_EPI = false, bool SP2 = false>
__device__ __forceinline__ void gemm_phase(PG8_LAS unsigned char* lds, const Gemm g, const Sched& S, const Epi& E) {
    const int tid = threadIdx.x, wid = __builtin_amdgcn_readfirstlane(tid >> 6), lane = tid & 63, wr = wid >> 2, wc = wid & 3, fr = lane & 15, fq = lane >> 4;
    const int K = g.K, nt = K / BK;
    unsigned voffA[2], voffB[2];
#pragma unroll
    for (int i = 0; i < 2; ++i) { int R, C; stage_rc(tid * 16 + i * 8192, R, C); const int Rb = Epi::PERM ? ((R & ~31) + perm32(R & 31)) : R;
        voffA[i] = (unsigned)(R * K + C) * 2u; voffB[i] = (unsigned)(Rb * K + C) * 2u; }
    const size_t kstep = (size_t)(BK * 2);
    const size_t hstep = (size_t)HALF * K * 2;
    const size_t tstep = 2 * hstep;
    const unsigned ldsw = (unsigned)wid * 1024u;
    const int aoff = lds_byte(wr * 64 + fr, fq * 8), boff = lds_byte(wc * 32 + fr, fq * 8);
#define PG8_SA(b, h) (((b) * 2 + (h)) * HTB)
#define PG8_SB(b, h) ((4 + (b) * 2 + (h)) * HTB)
#define PG8_STAGE(bufoff, gbase, voff) do { _Pragma("unroll") for (int _i = 0; _i < 2; ++_i) \
        __builtin_amdgcn_global_load_lds((const unsigned*)((const char*)(gbase) + (voff)[_i]), (PG8_LAS unsigned*)(lds + (bufoff) + ldsw + _i * 8192), 16, 0, 0); } while (0)
#define PG8_LDA(dst, b, h) do { _Pragma("unroll") for (int m = 0; m < 4; ++m) _Pragma("unroll") for (int k = 0; k < 2; ++k) dst[m][k] = *(const PG8_LAS bf16x8*)(lds + PG8_SA(b, h) + aoff + m * 2048 + k * 1024); } while (0)
#define PG8_LDB(dst, b, h) do { _Pragma("unroll") for (int n = 0; n < 2; ++n) _Pragma("unroll") for (int k = 0; k < 2; ++k) dst[n][k] = *(const PG8_LAS bf16x8*)(lds + PG8_SB(b, h) + boff + n * 2048 + k * 1024); } while (0)
#define PG8_MMA(ai, bj, At, Bt) do { __builtin_amdgcn_s_setprio(1); _Pragma("unroll") for (int m = 0; m < 4; ++m) _Pragma("unroll") for (int n = 0; n < 2; ++n) _Pragma("unroll") for (int k = 0; k < 2; ++k) \
        acc[ai][bj][m][n] = __builtin_amdgcn_mfma_f32_16x16x32_bf16(Bt[n][k], At[m][k], acc[ai][bj][m][n], 0, 0, 0); __builtin_amdgcn_s_setprio(0); } while (0)
#define PG8_WAIT_V(n) asm volatile("s_waitcnt vmcnt(" #n ")" ::: "memory")
#define PG8_WAIT_L(n) asm volatile("s_waitcnt lgkmcnt(" #n ")" ::: "memory")
#define PG8_BAR __builtin_amdgcn_s_barrier()
#define PG8_SCHED __builtin_amdgcn_sched_barrier(0)
    Unit cur, nxt; int ui = 0;
    if (!S.next(0, cur)) return;
    f32x4 acc[2][2][4][2];
#pragma unroll
    for (int a = 0; a < 2; ++a)
#pragma unroll
        for (int b = 0; b < 2; ++b)
#pragma unroll
            for (int m = 0; m < 4; ++m)
#pragma unroll
                for (int n = 0; n < 2; ++n) acc[a][b][m][n] = (f32x4){0.f, 0.f, 0.f, 0.f};
    bf16x8 At[4][2], B0[2][2], B1[2][2];
    const char* cA = (const char*)g.A + (size_t)cur.pm * tstep; const char* cB = (const char*)g.Bt + (size_t)cur.pn * tstep;
    S.a_ready(cur);
    if constexpr (SP2) {
        PG8_STAGE(PG8_SB(0, 0), cB, voffB); PG8_STAGE(PG8_SB(0, 1), cB + hstep, voffB); PG8_STAGE(PG8_SA(0, 0), cA, voffA); PG8_STAGE(PG8_SA(0, 1), cA + hstep, voffA);
        if (wr == 1) PG8_BAR;
        PG8_WAIT_V(2); PG8_BAR;
        PG8_STAGE(PG8_SB(1, 0), cB + kstep, voffB); PG8_STAGE(PG8_SA(1, 0), cA + kstep, voffA); PG8_STAGE(PG8_SB(1, 1), cB + hstep + kstep, voffB);
        PG8_WAIT_V(6); PG8_BAR;
    } else {
        PG8_STAGE(PG8_SB(0, 0), cB, voffB); PG8_STAGE(PG8_SA(0, 0), cA, voffA); PG8_STAGE(PG8_SB(0, 1), cB + hstep, voffB); PG8_STAGE(PG8_SA(0, 1), cA + hstep, voffA);
        if (wr == 1) PG8_BAR;
        PG8_WAIT_V(4); PG8_BAR;
        PG8_STAGE(PG8_SB(1, 0), cB + kstep, voffB); PG8_STAGE(PG8_SA(1, 0), cA + kstep, voffA); PG8_STAGE(PG8_SB(1, 1), cB + hstep + kstep, voffB);
        PG8_WAIT_V(6); PG8_BAR;
    }
    for (;;) {
        const bool has_next = S.next(ui + 1, nxt);
        const char* nA = has_next ? (const char*)g.A + (size_t)nxt.pm * tstep : cA; const char* nB = has_next ? (const char*)g.Bt + (size_t)nxt.pn * tstep : cB;
        for (int t = 0; t < nt; t += 2) {
            const bool last = (t == nt - 2);
            const char* a1 = cA + (size_t)(t + 1) * kstep;
            const char* a2 = last ? nA : cA + (size_t)(t + 2) * kstep; const char* b2 = last ? nB : cB + (size_t)(t + 2) * kstep;
            const char* a3 = a2 + kstep; const char* b3 = b2 + kstep;
            if (last && has_next) S.a_ready(nxt);
            if constexpr (SP2) {
            PG8_LDB(B0, 0, 0); PG8_LDB(B1, 0, 1); PG8_SCHED; PG8_LDA(At, 0, 0); PG8_STAGE(PG8_SA(1, 1), a1 + hstep, voffA);
            PG8_WAIT_V(8); PG8_WAIT_L(0); PG8_BAR; PG8_MMA(0, 0, At, B0); PG8_MMA(0, 1, At, B1); PG8_BAR; PG8_SCHED;
            PG8_LDA(At, 0, 1); PG8_STAGE(PG8_SB(0, 0), b2, voffB); PG8_STAGE(PG8_SB(0, 1), b2 + hstep, voffB); PG8_STAGE(PG8_SA(0, 0), a2, voffA);
            PG8_WAIT_V(8); PG8_WAIT_L(0); PG8_BAR; PG8_MMA(1, 0, At, B0); PG8_MMA(1, 1, At, B1); PG8_BAR; PG8_SCHED;
            PG8_LDB(B0, 1, 0); PG8_LDB(B1, 1, 1); PG8_SCHED; PG8_LDA(At, 1, 0); PG8_STAGE(PG8_SA(0, 1), a2 + hstep, voffA);
            PG8_WAIT_V(8); PG8_WAIT_L(0); PG8_BAR; PG8_MMA(0, 0, At, B0); PG8_MMA(0, 1, At, B1); PG8_BAR; PG8_SCHED;
            PG8_LDA(At, 1, 1); PG8_STAGE(PG8_SB(1, 0), b3, voffB); PG8_STAGE(PG8_SB(1, 1), b3 + hstep, voffB); PG8_STAGE(PG8_SA(1, 0), a3, voffA);
            PG8_WAIT_V(8); PG8_WAIT_L(0); PG8_BAR; PG8_MMA(1, 0, At, B0); PG8_MMA(1, 1, At, B1); PG8_BAR; PG8_SCHED;
            } else {
            PG8_LDB(B0, 0, 0); PG8_SCHED; PG8_LDA(At, 0, 0); PG8_STAGE(PG8_SA(1, 1), a1 + hstep, voffA);
            PG8_WAIT_L(8); PG8_BAR; PG8_WAIT_L(0); PG8_MMA(0, 0, At, B0); PG8_BAR; PG8_SCHED;
            PG8_LDB(B1, 0, 1); PG8_STAGE(PG8_SB(0, 0), b2, voffB);
            PG8_BAR; PG8_WAIT_L(0); PG8_MMA(0, 1, At, B1); PG8_BAR;
            PG8_LDA(At, 0, 1); PG8_STAGE(PG8_SA(0, 0), a2, voffA);
            PG8_BAR; PG8_WAIT_L(0); PG8_MMA(1, 0, At, B0); PG8_BAR; PG8_SCHED;
            PG8_STAGE(PG8_SB(0, 1), b2 + hstep, voffB);
            PG8_WAIT_V(6); PG8_BAR; PG8_MMA(1, 1, At, B1); PG8_BAR;
            PG8_LDB(B0, 1, 0); PG8_SCHED; PG8_LDA(At, 1, 0); PG8_STAGE(PG8_SA(0, 1), a2 + hstep, voffA);
            PG8_WAIT_L(8); PG8_BAR; PG8_WAIT_L(0); PG8_MMA(0, 0, At, B0); PG8_BAR; PG8_SCHED;
            PG8_LDB(B1, 1, 1); PG8_STAGE(PG8_SB(1, 0), b3, voffB);
            PG8_BAR; PG8_WAIT_L(0); PG8_MMA(0, 1, At, B1); PG8_BAR;
            PG8_LDA(At, 1, 1); PG8_STAGE(PG8_SA(1, 0), a3, voffA);
            PG8_BAR; PG8_WAIT_L(0); PG8_MMA(1, 0, At, B0); PG8_BAR; PG8_SCHED;
            PG8_STAGE(PG8_SB(1, 1), b3 + hstep, voffB);
            PG8_WAIT_V(6); PG8_BAR; PG8_MMA(1, 1, At, B1); PG8_BAR;
            }
        }
        if constexpr (ALIGN_EPI) { if (wr == 0) PG8_BAR; }
        if constexpr (!Epi::AFTER_DRAIN) { E(acc, cur, wr, wc, fr, fq); S.done(cur); }
        if (!has_next) break;
#pragma unroll
        for (int a = 0; a < 2; ++a)
#pragma unroll
            for (int b = 0; b < 2; ++b)
#pragma unroll
                for (int m = 0; m < 4; ++m)
#pragma unroll
                    for (int n = 0; n < 2; ++n) acc[a][b][m][n] = (f32x4){0.f, 0.f, 0.f, 0.f};
        cur = nxt; cA = nA; cB = nB; ++ui;
        if constexpr (ALIGN_EPI) { if (wr == 1) PG8_BAR; }
    }
    PG8_WAIT_V(0);
    if constexpr (!ALIGN_EPI) { if (wr == 0) PG8_BAR; }
    PG8_BAR;
    if constexpr (Epi::AFTER_DRAIN) { E.fused(acc, cur, wr, wc, fr, fq, lds, wid, lane); S.done(cur); }
#undef PG8_SA
#undef PG8_SB
#undef PG8_STAGE
#undef PG8_LDA
#undef PG8_LDB
#undef PG8_MMA
#undef PG8_WAIT_V
#undef PG8_WAIT_L
#undef PG8_BAR
#undef PG8_SCHED
}
}

constexpr int T = 16384, D = 1024, SEQ = 2048, NBATCH = 8, NIN = 8192;
constexpr int NHEAD = 8, NEXP = 16384;
constexpr float LN_EPS = 1e-5f;
constexpr float ALPHA = 1.189207115002721f;
constexpr float LAM_INIT = 0.2f;
constexpr int NWAVES = 8, NTHREADS = 512;
constexpr int LDS_BYTES = 147456;
constexpr int NPHASES = 9;
constexpr int RING_BYTES = 131072, LDSCTL_OFF = RING_BYTES, MISC_OFF = LDSCTL_OFF + 320;
constexpr int CW_BAR = 4096;
constexpr size_t CTL_ZERO_BYTES = 65536;
#ifndef MK_N_LAUNCHES
#define MK_N_LAUNCHES 1
#endif

typedef unsigned short bf16_t;
typedef short bf16x8 __attribute__((ext_vector_type(8)));
typedef short s16x4 __attribute__((ext_vector_type(4)));
typedef float f32x4 __attribute__((ext_vector_type(4)));
typedef float f32x16 __attribute__((ext_vector_type(16)));
typedef unsigned u32x4 __attribute__((ext_vector_type(4)));
typedef unsigned u32x2 __attribute__((ext_vector_type(2)));
#define LAS __attribute__((address_space(3)))
#define LDS_WAIT() asm volatile("s_waitcnt lgkmcnt(0)" ::: "memory")

constexpr size_t MiB = 1u << 20;
constexpr size_t WS_CTL = 0, WS_CS = 1 * MiB, WS_WCO = 2 * MiB, WS_WAO = 4 * MiB, WS_WO = 6 * MiB, WS_WSC = 8 * MiB;
constexpr size_t WS_WIN = 12 * MiB, WS_XB = 28 * MiB, WS_Z = 60 * MiB, WS_BG = 92 * MiB, WS_Q = 124 * MiB, WS_K = 156 * MiB, WS_V = 188 * MiB;
constexpr size_t WS_UB = 12 * MiB, WS_VB = 28 * MiB, WS_USC = 44 * MiB, WS_VSC = 44 * MiB + 65536;
constexpr size_t WS_T1 = 156 * MiB, WS_MG = 188 * MiB;
constexpr size_t WS_X1B = 76 * MiB;
constexpr size_t WS_SC = 124 * MiB;
constexpr size_t WS_END = 252 * MiB;

__device__ __forceinline__ unsigned f2bf(float f) { unsigned u = __builtin_bit_cast(unsigned, f); return (u + 0x7fffu + ((u >> 16) & 1u)) >> 16; }
__device__ __forceinline__ unsigned pk2(float lo, float hi) { return f2bf(lo) | (f2bf(hi) << 16); }
__device__ __forceinline__ float bflo(unsigned w) { return __uint_as_float(w << 16); }
__device__ __forceinline__ float bfhi(unsigned w) { return __uint_as_float(w & 0xffff0000u); }
__device__ __forceinline__ float wave_sum(float v) {
#pragma unroll
    for (int o = 1; o < 64; o <<= 1) v += __shfl_xor(v, o);
    return v;
}
__device__ __forceinline__ float wave_max(float v) {
#pragma unroll
    for (int o = 1; o < 64; o <<= 1) v = fmaxf(v, __shfl_xor(v, o));
    return v;
}
__device__ __forceinline__ float wave_min(float v) {
#pragma unroll
    for (int o = 1; o < 64; o <<= 1) v = fminf(v, __shfl_xor(v, o));
    return v;
}

__device__ __forceinline__ int win_src(int n) {
    if (n < 2048) { const int i = n >> 8, r = n & 255; return r < 128 ? 128 * i + r : 2048 + 128 * i + (r - 128); }
    if (n < 3072) return 1024 + (n - 2048);
    if (n < 5120) { const int base = n - 3072, which = base >> 10, within = base & 1023, map = within >> 6, p = within & 63; const int d = p < 16 ? (p >> 1) + 8 * (p & 1) : p; return 3072 + which * 1024 + map * 64 + d; }
    return n;
}
template <bool PERMUTE>
__device__ __forceinline__ void transpose_item(const float* W, int K, int N, bf16_t* WT, LAS float* scr, int item, int lane) {
    const int nblk = N / 32, kb = item / nblk, nb = item % nblk, k0 = 64 * kb, n0 = 32 * nb;
    const int nsrc = PERMUTE ? win_src(n0 + (lane & 31)) : n0 + (lane & 31);
#pragma unroll 8
    for (int i = 0; i < 32; ++i) { const int kk = 2 * i + (lane >> 5); scr[kk * 33 + (lane & 31)] = W[(size_t)(k0 + kk) * N + nsrc]; }
    LDS_WAIT();
    const int c = lane & 7;
#pragma unroll
    for (int j = 0; j < 4; ++j) { const int n = (lane >> 3) + 8 * j; const LAS float* s = scr + (8 * c) * 33 + n;
        u32x4 o; o.x = pk2(s[0 * 33], s[1 * 33]); o.y = pk2(s[2 * 33], s[3 * 33]); o.z = pk2(s[4 * 33], s[5 * 33]); o.w = pk2(s[6 * 33], s[7 * 33]);
        *(u32x4*)(WT + (size_t)(n0 + n) * K + k0 + 8 * c) = o; }
    LDS_WAIT();
}
__device__ __forceinline__ void cvt_bf16(const float* src, bf16_t* dst, size_t n, int gtid, int gthreads) {
    const size_t n8 = n / 8;
    for (size_t i = gtid; i < n8; i += gthreads) {
        const f32x4 a = *(const f32x4*)(src + i * 8), b = *(const f32x4*)(src + i * 8 + 4);
        u32x4 o; o.x = pk2(a[0], a[1]); o.y = pk2(a[2], a[3]); o.z = pk2(b[0], b[1]); o.w = pk2(b[2], b[3]);
        *(u32x4*)(dst + i * 8) = o;
    }
}
typedef float f32x2 __attribute__((ext_vector_type(2)));
__device__ __forceinline__ void cvt_fp8_rows(const float* src, unsigned char* dst, float* scale, int nrows, int gw, int ngw, int lane) {
    for (int r = gw; r < nrows; r += ngw) {
        const f32x4* p = (const f32x4*)(src + (size_t)r * 1024) + 4 * lane;
        f32x4 v[4]; float m = 0.f;
#pragma unroll
        for (int j = 0; j < 4; ++j) { v[j] = p[j]; m = fmaxf(m, fmaxf(fmaxf(fabsf(v[j][0]), fabsf(v[j][1])), fmaxf(fabsf(v[j][2]), fabsf(v[j][3])))); }
        m = wave_max(m);
        const float sc = m > 0.f ? 384.0f / m : 1.0f;
        u32x4 o;
#pragma unroll
        for (int j = 0; j < 4; ++j) { int w = __builtin_amdgcn_cvt_pk_fp8_f32(v[j][0] * sc, v[j][1] * sc, 0, false); w = __builtin_amdgcn_cvt_pk_fp8_f32(v[j][2] * sc, v[j][3] * sc, w, true); o[j] = (unsigned)w; }
        *(u32x4*)(dst + (size_t)r * 1024 + 16 * lane) = o;
        if (lane == 0) scale[r] = m > 0.f ? m * (1.0f / 384.0f) : 1.0f;
    }
}
__device__ __forceinline__ void unpack16_fp8(const u32x4 a, float (&f)[16]) {
#pragma unroll
    for (int j = 0; j < 4; ++j) { const f32x2 lo = __builtin_amdgcn_cvt_pk_f32_fp8((int)a[j], false), hi = __builtin_amdgcn_cvt_pk_f32_fp8((int)a[j], true);
        f[4 * j] = lo[0]; f[4 * j + 1] = lo[1]; f[4 * j + 2] = hi[0]; f[4 * j + 3] = hi[1]; }
}
__device__ __forceinline__ void wsc_item(const float* w_pq, const float* sub_keys, bf16_t* Wsc, LAS unsigned char* lds, int item, int tid) {
    const int hc = item >> 4, d0 = (item & 15) * 64;
    LAS float* kl = (LAS float*)lds; LAS float* wl = (LAS float*)(lds + 67584);
    for (int i = tid; i < 128 * 32; i += NTHREADS) { const int n = i >> 5, j4 = (i & 31) * 4; *(LAS f32x4*)(kl + n * 132 + j4) = *(const f32x4*)(sub_keys + ((size_t)hc * 128 + n) * 128 + j4); }
    for (int i = tid; i < 64 * 32; i += NTHREADS) { const int dd = i >> 5, j4 = (i & 31) * 4; *(LAS f32x4*)(wl + dd * 128 + j4) = *(const f32x4*)(w_pq + (size_t)(d0 + dd) * 2048 + hc * 128 + j4); }
    __syncthreads();
    const int n = tid & 127, dq = tid >> 7;
    float acc[16];
#pragma unroll
    for (int i = 0; i < 16; ++i) acc[i] = 0.f;
    for (int j4 = 0; j4 < 128; j4 += 4) {
        const f32x4 kv = *(const LAS f32x4*)(kl + n * 132 + j4);
#pragma unroll
        for (int i = 0; i < 16; ++i) { const f32x4 wv = *(const LAS f32x4*)(wl + (dq * 16 + i) * 128 + j4); acc[i] += kv[0] * wv[0] + kv[1] * wv[1] + kv[2] * wv[2] + kv[3] * wv[3]; }
    }
    u32x4 o0, o1;
    o0.x = pk2(acc[0], acc[1]); o0.y = pk2(acc[2], acc[3]); o0.z = pk2(acc[4], acc[5]); o0.w = pk2(acc[6], acc[7]);
    o1.x = pk2(acc[8], acc[9]); o1.y = pk2(acc[10], acc[11]); o1.z = pk2(acc[12], acc[13]); o1.w = pk2(acc[14], acc[15]);
    bf16_t* dst = Wsc + (size_t)(hc * 128 + n) * 1024 + d0 + dq * 16;
    *(u32x4*)dst = o0; *(u32x4*)(dst + 8) = o1;
    __syncthreads();
}

__device__ __forceinline__ void conv_phase(const bf16_t* Z, bf16_t* BG, const float* conv_w, const float* conv_b, int gtid, int gthreads) {
    for (int it = gtid; it < (T / 16) * 128; it += gthreads) {
        const int rb = it >> 7, cc = it & 127, t0 = rb * 16, c0 = cc * 8;
        float w0[8], w1[8], w2[8], cb[8];
#pragma unroll
        for (int i = 0; i < 8; ++i) { w0[i] = conv_w[c0 + i]; w1[i] = conv_w[1024 + c0 + i]; w2[i] = conv_w[2048 + c0 + i]; cb[i] = conv_b[c0 + i]; }
        float zm2[8], zm1[8];
        if ((t0 & (SEQ - 1)) != 0) {
            const u32x4 a = *(const u32x4*)(Z + (size_t)(t0 - 2) * 1024 + c0), b = *(const u32x4*)(Z + (size_t)(t0 - 1) * 1024 + c0);
            zm2[0] = bflo(a.x); zm2[1] = bfhi(a.x); zm2[2] = bflo(a.y); zm2[3] = bfhi(a.y); zm2[4] = bflo(a.z); zm2[5] = bfhi(a.z); zm2[6] = bflo(a.w); zm2[7] = bfhi(a.w);
            zm1[0] = bflo(b.x); zm1[1] = bfhi(b.x); zm1[2] = bflo(b.y); zm1[3] = bfhi(b.y); zm1[4] = bflo(b.z); zm1[5] = bfhi(b.z); zm1[6] = bflo(b.w); zm1[7] = bfhi(b.w);
        } else {
#pragma unroll
            for (int i = 0; i < 8; ++i) { zm2[i] = 0.f; zm1[i] = 0.f; }
        }
#pragma unroll 4
        for (int r = 0; r < 16; ++r) {
            const size_t o = (size_t)(t0 + r) * 1024 + c0;
            const u32x4 a = *(const u32x4*)(Z + o), g = *(const u32x4*)(BG + o);
            float z[8], bgv[8], y[8];
            z[0] = bflo(a.x); z[1] = bfhi(a.x); z[2] = bflo(a.y); z[3] = bfhi(a.y); z[4] = bflo(a.z); z[5] = bfhi(a.z); z[6] = bflo(a.w); z[7] = bfhi(a.w);
            bgv[0] = bflo(g.x); bgv[1] = bfhi(g.x); bgv[2] = bflo(g.y); bgv[3] = bfhi(g.y); bgv[4] = bflo(g.z); bgv[5] = bfhi(g.z); bgv[6] = bflo(g.w); bgv[7] = bfhi(g.w);
#pragma unroll
            for (int i = 0; i < 8; ++i) { y[i] = bgv[i] * (cb[i] + w0[i] * zm2[i] + w1[i] * zm1[i] + w2[i] * z[i]); zm2[i] = zm1[i]; zm1[i] = z[i]; }
            u32x4 ov; ov.x = pk2(y[0], y[1]); ov.y = pk2(y[2], y[3]); ov.z = pk2(y[4], y[5]); ov.w = pk2(y[6], y[7]);
            *(u32x4*)(BG + o) = ov;
        }
    }
}

namespace att {
constexpr int STAGE = 32768;
constexpr int XCH_OFF = 65536;
__device__ __forceinline__ int crow(int r, int hi) { return (r & 3) + 8 * (r >> 2) + 4 * hi; }
__device__ __forceinline__ s16x4 vtr(const LAS unsigned char* p) { return __builtin_bit_cast(s16x4, __builtin_amdgcn_ds_read_tr16_b64_v4i16((LAS s16x4*)p)); }

__device__ __forceinline__ void attn_unit(int b, int h, int qblk, const bf16_t* Q, const bf16_t* Kg, const bf16_t* Vg, bf16_t* O, const float* subln_g, float lam,
                                          LAS unsigned char* lds, int tid) {
    const int lane = tid & 63, wid = __builtin_amdgcn_readfirstlane(tid >> 6), rg = wid >> 1, c = wid & 1, r = lane & 31, hh = lane >> 5;
    const size_t seq0 = (size_t)b * SEQ;
    const int qs = qblk * 128 + rg * 32;
    bf16x8 qf[4];
    { const bf16_t* qp = Q + (seq0 + qs + r) * 1024 + h * 128 + c * 64 + 8 * hh;
#pragma unroll
      for (int ks = 0; ks < 4; ++ks) qf[ks] = *(const bf16x8*)(qp + 16 * ks); }
    const int kkey = tid >> 3, kch = tid & 7;
    const unsigned kdst = (unsigned)(kkey * 128 + ((kch ^ ((kkey >> 1) & 7)) * 16));
    const int v0key = tid >> 4, vch = tid & 15;
    const unsigned vdst0 = (unsigned)(v0key * 256 + (((vch >> 2) ^ (v0key & 3)) * 64) + (vch & 3) * 16);
    const unsigned vdst1 = vdst0 + 32 * 256;
    const bf16_t* kbase = Kg + seq0 * 1024 + h * 128 + kch * 8;
    const bf16_t* vbase = Vg + seq0 * 1024 + h * 128 + vch * 8;
    const int kswz = (r >> 1) & 7;
    unsigned koff[4];
#pragma unroll
    for (int ks = 0; ks < 4; ++ks) koff[ks] = (unsigned)(c * 8192 + r * 128 + (((ks * 2 + hh) ^ kswz) * 16));
    const int i16 = lane & 15, vq = i16 >> 2, vp = i16 & 3, g16 = (lane >> 4) & 1;
    unsigned voff[4];
#pragma unroll
    for (int dt = 0; dt < 4; ++dt) voff[dt] = (unsigned)(16384 + (4 * hh + vq) * 256 + ((dt ^ vq) * 64) + (16 * g16 + 4 * vp) * 2);

    f32x16 o[4];
#pragma unroll
    for (int dt = 0; dt < 4; ++dt)
#pragma unroll
        for (int i = 0; i < 16; ++i) o[dt][i] = 0.f;
    float mrun = -1e30f, lrun = 0.f;
    const int nt = 2 * qblk + 2;
    const int jmax = (qs + 31) >> 6;

    u32x4 pk0, pk1, pv0, pv1;
    { const size_t ro = (size_t)kkey * 1024; pk0 = *(const u32x4*)(kbase + ro); pk1 = *(const u32x4*)(kbase + ro + 64);
      pv0 = *(const u32x4*)(vbase + (size_t)v0key * 1024); pv1 = *(const u32x4*)(vbase + (size_t)(v0key + 32) * 1024); }
    *(LAS u32x4*)(lds + kdst) = pk0; *(LAS u32x4*)(lds + 8192 + kdst) = pk1; *(LAS u32x4*)(lds + 16384 + vdst0) = pv0; *(LAS u32x4*)(lds + 16384 + vdst1) = pv1;
    __syncthreads();
    for (int j = 0; j < nt; ++j) {
        const LAS unsigned char* st = lds + (j & 1) * STAGE;
        if (j + 1 < nt) { const size_t ro = (size_t)((j + 1) * 64 + kkey) * 1024; pk0 = *(const u32x4*)(kbase + ro); pk1 = *(const u32x4*)(kbase + ro + 64);
            pv0 = *(const u32x4*)(vbase + (size_t)((j + 1) * 64 + v0key) * 1024); pv1 = *(const u32x4*)(vbase + (size_t)((j + 1) * 64 + v0key + 32) * 1024); }
        if (j <= jmax) {
            f32x16 s0, s1;
#pragma unroll
            for (int i = 0; i < 16; ++i) { s0[i] = 0.f; s1[i] = 0.f; }
#pragma unroll
            for (int ks = 0; ks < 4; ++ks) {
                const bf16x8 ka = *(const LAS bf16x8*)(st + koff[ks]), kb = *(const LAS bf16x8*)(st + koff[ks] + 4096);
                s0 = __builtin_amdgcn_mfma_f32_32x32x16_bf16(ka, qf[ks], s0, 0, 0, 0);
                s1 = __builtin_amdgcn_mfma_f32_32x32x16_bf16(kb, qf[ks], s1, 0, 0, 0);
            }
            if (j * 64 + 63 > qs) {
                const int qrel = qs + r - j * 64;
#pragma unroll
                for (int i = 0; i < 16; ++i) { const int kv = crow(i, hh); if (kv > qrel) s0[i] = -INFINITY; if (kv + 32 > qrel) s1[i] = -INFINITY; }
            }
            float mx = fmaxf(s0[0], s1[0]);
#pragma unroll
            for (int i = 1; i < 16; ++i) mx = fmaxf(mx, fmaxf(s0[i], s1[i]));
            mx = fmaxf(mx, __shfl_xor(mx, 32));
            const float mnew = fmaxf(mrun, mx), al = exp2f(mrun - mnew);
            mrun = mnew;
            float ps = 0.f;
#pragma unroll
            for (int i = 0; i < 16; ++i) { s0[i] = exp2f(s0[i] - mnew); s1[i] = exp2f(s1[i] - mnew); ps += s0[i] + s1[i]; }
            lrun = lrun * al + ps;
#pragma unroll
            for (int dt = 0; dt < 4; ++dt)
#pragma unroll
                for (int i = 0; i < 16; ++i) o[dt][i] *= al;
            bf16x8 pf[4];
#pragma unroll
            for (int s = 0; s < 2; ++s) {
                u32x4 w0, w1;
                w0.x = pg8::cvt_pk_bf16(s0[8 * s + 0], s0[8 * s + 1]); w0.y = pg8::cvt_pk_bf16(s0[8 * s + 2], s0[8 * s + 3]); w0.z = pg8::cvt_pk_bf16(s0[8 * s + 4], s0[8 * s + 5]); w0.w = pg8::cvt_pk_bf16(s0[8 * s + 6], s0[8 * s + 7]);
                w1.x = pg8::cvt_pk_bf16(s1[8 * s + 0], s1[8 * s + 1]); w1.y = pg8::cvt_pk_bf16(s1[8 * s + 2], s1[8 * s + 3]); w1.z = pg8::cvt_pk_bf16(s1[8 * s + 4], s1[8 * s + 5]); w1.w = pg8::cvt_pk_bf16(s1[8 * s + 6], s1[8 * s + 7]);
                pf[s] = __builtin_bit_cast(bf16x8, w0); pf[2 + s] = __builtin_bit_cast(bf16x8, w1);
            }
#pragma unroll
            for (int dt = 0; dt < 4; ++dt) {
#pragma unroll
                for (int ks = 0; ks < 4; ++ks) {
                    const s16x4 lo = vtr(st + voff[dt] + ks * 16 * 256), hi = vtr(st + voff[dt] + ks * 16 * 256 + 8 * 256);
                    const bf16x8 va = (bf16x8){lo[0], lo[1], lo[2], lo[3], hi[0], hi[1], hi[2], hi[3]};
                    o[dt] = __builtin_amdgcn_mfma_f32_32x32x16_bf16(va, pf[ks], o[dt], 0, 0, 0);
                }
            }
        }
        if (j + 1 < nt) { LAS unsigned char* sn = lds + ((j + 1) & 1) * STAGE;
            *(LAS u32x4*)(sn + kdst) = pk0; *(LAS u32x4*)(sn + 8192 + kdst) = pk1; *(LAS u32x4*)(sn + 16384 + vdst0) = pv0; *(LAS u32x4*)(sn + 16384 + vdst1) = pv1; }
        __syncthreads();
    }
    const float ltot = lrun + __shfl_xor(lrun, 32);
    const float inv = (c == 0 ? 1.0f : lam) / ltot;
    LAS float* xch = (LAS float*)(lds + XCH_OFF) + rg * 4096 + lane;
    if (c == 1) {
#pragma unroll
        for (int dt = 0; dt < 4; ++dt)
#pragma unroll
            for (int i = 0; i < 16; ++i) xch[(dt * 16 + i) * 64] = o[dt][i] * inv;
    }
    __syncthreads();
    if (c == 0) {
        float ss = 0.f;
#pragma unroll
        for (int dt = 0; dt < 4; ++dt)
#pragma unroll
            for (int i = 0; i < 16; ++i) { const float v = o[dt][i] * inv - xch[(dt * 16 + i) * 64]; o[dt][i] = v; ss += v * v; }
        ss += __shfl_xor(ss, 32);
        const float rs = (1.0f - LAM_INIT) / sqrtf(ss * (1.0f / 128.0f) + LN_EPS);
        bf16_t* op = O + (seq0 + qs + r) * 1024 + h * 128 + 4 * hh;
#pragma unroll
        for (int dt = 0; dt < 4; ++dt)
#pragma unroll
            for (int g = 0; g < 4; ++g) { const int e = dt * 32 + 8 * g;
                const f32x4 gv = *(const f32x4*)(subln_g + e + 4 * hh);
                u32x2 w; w.x = pg8::cvt_pk_bf16(o[dt][4 * g] * rs * gv[0], o[dt][4 * g + 1] * rs * gv[1]); w.y = pg8::cvt_pk_bf16(o[dt][4 * g + 2] * rs * gv[2], o[dt][4 * g + 3] * rs * gv[3]);
                *(u32x2*)(op + e) = w; }
    }
    __syncthreads();
}
}

__device__ __forceinline__ void ln1_phase(float* X, bf16_t* XB, const float* g, const float* bta, int gw, int ngw, int lane) {
    f32x4 gv[4], bv[4];
#pragma unroll
    for (int j = 0; j < 4; ++j) { gv[j] = *(const f32x4*)(g + 4 * lane + 256 * j); bv[j] = *(const f32x4*)(bta + 4 * lane + 256 * j); }
    for (int m = gw; m < T; m += ngw) {
        f32x4* xr = (f32x4*)(X + (size_t)m * D) + lane;
        f32x4 v[4]; float s = 0.f;
#pragma unroll
        for (int j = 0; j < 4; ++j) { v[j] = xr[64 * j]; s += (v[j][0] + v[j][1]) + (v[j][2] + v[j][3]); }
        const float mean = wave_sum(s) * (1.f / D); float s2 = 0.f;
#pragma unroll
        for (int j = 0; j < 4; ++j) { v[j] = v[j] - mean; s2 += (v[j][0] * v[j][0] + v[j][1] * v[j][1]) + (v[j][2] * v[j][2] + v[j][3] * v[j][3]); }
        const float rstd = 1.f / sqrtf(wave_sum(s2) * (1.f / D) + LN_EPS);
        u32x2* o8 = (u32x2*)(XB + (size_t)m * D) + lane;
#pragma unroll
        for (int j = 0; j < 4; ++j) { const f32x4 y = v[j] * rstd * gv[j] + bv[j]; xr[64 * j] = y; u32x2 w; w.x = pk2(y[0], y[1]); w.y = pk2(y[2], y[3]); o8[64 * j] = w; }
    }
}

namespace peer {
constexpr int WAVE_LDS = 4096;
template <int NV>
__device__ __forceinline__ void top16(const float (&v)[NV], LAS float* oval, LAS int* oidx, int lane) {
    float lmx = v[0], lmn = v[0];
#pragma unroll
    for (int q = 1; q < NV; ++q) { lmx = fmaxf(lmx, v[q]); lmn = fminf(lmn, v[q]); }
    float hi = wave_max(lmx), lo = wave_min(lmn);
    lo = lo - fabsf(lo) * 1e-6f - 1e-30f;
    float thr = hi; int need_ties = 1;
    for (int it = 0; it < 64; ++it) {
        const float mid = 0.5f * (lo + hi);
        if (!(mid > lo && mid < hi)) break;
        int cnt = 0;
#pragma unroll
        for (int q = 0; q < NV; ++q) cnt += __popcll(__ballot(v[q] > mid));
        if (cnt == 16) { thr = mid; need_ties = 0; break; }
        if (cnt > 16) lo = mid; else hi = mid;
    }
    const float tie_hi = hi;
    int base = 0;
    if (!need_ties) {
#pragma unroll
        for (int q = 0; q < NV; ++q) { const bool sel = v[q] > thr; const unsigned long long bm = __ballot(sel);
            const int pos = base + (int)__builtin_amdgcn_mbcnt_hi((unsigned)(bm >> 32), __builtin_amdgcn_mbcnt_lo((unsigned)bm, 0u));
            if (sel) { oval[pos] = v[q]; oidx[pos] = lane + 64 * q; }
            base += __popcll(bm); }
    } else {
#pragma unroll
        for (int q = 0; q < NV; ++q) { const bool sel = v[q] > tie_hi; const unsigned long long bm = __ballot(sel);
            const int pos = base + (int)__builtin_amdgcn_mbcnt_hi((unsigned)(bm >> 32), __builtin_amdgcn_mbcnt_lo((unsigned)bm, 0u));
            if (sel && pos < 16) { oval[pos] = v[q]; oidx[pos] = lane + 64 * q; }
            base += __popcll(bm); }
#pragma unroll
        for (int q = 0; q < NV; ++q) { const bool sel = (v[q] <= tie_hi) && (v[q] > lo); const unsigned long long bm = __ballot(sel);
            const int pos = base + (int)__builtin_amdgcn_mbcnt_hi((unsigned)(bm >> 32), __builtin_amdgcn_mbcnt_lo((unsigned)bm, 0u));
            if (sel && pos < 16) { oval[pos] = v[q]; oidx[pos] = lane + 64 * q; }
            base += __popcll(bm); }
    }
    LDS_WAIT();
}

__device__ __forceinline__ void unpack8(const u32x4 a, float (&f)[8]) {
    f[0] = bflo(a.x); f[1] = bfhi(a.x); f[2] = bflo(a.y); f[3] = bfhi(a.y); f[4] = bflo(a.z); f[5] = bfhi(a.z); f[6] = bflo(a.w); f[7] = bfhi(a.w);
}

__device__ __forceinline__ void token(int t, const float* SC, float* X1  , const unsigned char* UB, const unsigned char* VB, const float* USC, const float* VSC, const float* ln_g, const float* ln_b,
                                      LAS unsigned char* wl, int lane) {
    LAS float* s1v = (LAS float*)wl; LAS int* s1i = (LAS int*)(wl + 64); LAS float* s2v = (LAS float*)(wl + 128); LAS int* s2i = (LAS int*)(wl + 192);
    LAS float* cv = (LAS float*)(wl + 256); LAS int* ci = (LAS int*)(wl + 320);
    LAS int* eidx = (LAS int*)(wl + 512); LAS float* gsel = (LAS float*)(wl + 1024); LAS float* wsel = (LAS float*)(wl + 1536);
    const float* sc = SC + (size_t)t * 2048;
    for (int h = 0; h < NHEAD; ++h) {
        float a[2], bq[2];
        a[0] = sc[h * 256 + lane]; a[1] = sc[h * 256 + 64 + lane]; bq[0] = sc[h * 256 + 128 + lane]; bq[1] = sc[h * 256 + 192 + lane];
        top16<2>(a, s1v, s1i, lane);
        top16<2>(bq, s2v, s2i, lane);
        float cand[4];
#pragma unroll
        for (int q = 0; q < 4; ++q) { const int idx = lane + 64 * q; cand[q] = s1v[idx >> 4] + s2v[idx & 15]; }
        top16<4>(cand, cv, ci, lane);
        {
            const float v = cv[lane & 15]; const int code = ci[lane & 15];
            float mx = v;
#pragma unroll
            for (int o = 1; o < 16; o <<= 1) mx = fmaxf(mx, __shfl_xor(mx, o));
            const float e = __expf(v - mx); float sm = e;
#pragma unroll
            for (int o = 1; o < 16; o <<= 1) sm += __shfl_xor(sm, o);
            if (lane < 16) { gsel[h * 16 + lane] = e / sm; eidx[h * 16 + lane] = s1i[code >> 4] * 128 + s2i[code & 15]; }
        }
        LDS_WAIT();
    }
    float xr[16];
    { const f32x4* xp = (const f32x4*)(X1 + (size_t)t * D) + 4 * lane;
#pragma unroll
      for (int j = 0; j < 4; ++j) { const f32x4 a0 = xp[j]; xr[4 * j] = a0[0]; xr[4 * j + 1] = a0[1]; xr[4 * j + 2] = a0[2]; xr[4 * j + 3] = a0[3]; } }
    const int hb5 = (lane >> 5) & 1, hb4 = (lane >> 4) & 1, hb3 = (lane >> 3) & 1, hb2 = (lane >> 2) & 1;
    for (int k0 = 0; k0 < 128; k0 += 16) {
        u32x4 ra[16];
#pragma unroll
        for (int e = 0; e < 16; ++e) { const int ei = __builtin_amdgcn_readfirstlane(eidx[k0 + e]); ra[e] = *(const u32x4*)(UB + (size_t)ei * D + 16 * lane); }
        float s[16];
#pragma unroll
        for (int e = 0; e < 16; ++e) { float f[16]; unpack16_fp8(ra[e], f); float d = 0.f;
#pragma unroll
            for (int i = 0; i < 16; ++i) d += xr[i] * f[i];
            s[e] = d; }
        float r8[8], r4[4], r2[2], r1;
#pragma unroll
        for (int i = 0; i < 8; ++i) { const float mine = hb5 ? s[8 + i] : s[i], oth = hb5 ? s[i] : s[8 + i]; r8[i] = mine + __shfl_xor(oth, 32); }
#pragma unroll
        for (int i = 0; i < 4; ++i) { const float mine = hb4 ? r8[4 + i] : r8[i], oth = hb4 ? r8[i] : r8[4 + i]; r4[i] = mine + __shfl_xor(oth, 16); }
#pragma unroll
        for (int i = 0; i < 2; ++i) { const float mine = hb3 ? r4[2 + i] : r4[i], oth = hb3 ? r4[i] : r4[2 + i]; r2[i] = mine + __shfl_xor(oth, 8); }
        { const float mine = hb2 ? r2[1] : r2[0], oth = hb2 ? r2[0] : r2[1]; r1 = mine + __shfl_xor(oth, 4); }
        r1 += __shfl_xor(r1, 2); r1 += __shfl_xor(r1, 1);
        const int ke = k0 + hb5 * 8 + hb4 * 4 + hb3 * 2 + hb2;
        const int ei = eidx[ke];
        const float dot = r1 * USC[ei];
        const float act = 0.5f * dot * (1.0f + erff(dot * 0.70710678118654752f));
        if ((lane & 3) == 0) wsel[ke] = gsel[ke] * act * VSC[ei];
    }
    LDS_WAIT();
    float acc[16];
#pragma unroll
    for (int i = 0; i < 16; ++i) acc[i] = 0.f;
    for (int k0 = 0; k0 < 128; k0 += 16) {
        u32x4 ra[16];
#pragma unroll
        for (int e = 0; e < 16; ++e) { const int ei = __builtin_amdgcn_readfirstlane(eidx[k0 + e]); ra[e] = *(const u32x4*)(VB + (size_t)ei * D + 16 * lane); }
#pragma unroll
        for (int e = 0; e < 16; ++e) { float f[16]; unpack16_fp8(ra[e], f); const float wk = wsel[k0 + e];
#pragma unroll
            for (int i = 0; i < 16; ++i) acc[i] += wk * f[i]; }
    }
    float s = 0.f;
#pragma unroll
    for (int i = 0; i < 16; ++i) { acc[i] = ALPHA * xr[i] + acc[i]; s += acc[i]; }
    const float mean = wave_sum(s) * (1.f / D); float s2 = 0.f;
#pragma unroll
    for (int i = 0; i < 16; ++i) { acc[i] -= mean; s2 += acc[i] * acc[i]; }
    const float rstd = 1.f / sqrtf(wave_sum(s2) * (1.f / D) + LN_EPS);
    { const f32x4* gp = (const f32x4*)ln_g + 4 * lane; const f32x4* bp = (const f32x4*)ln_b + 4 * lane; f32x4* op = (f32x4*)(X1 + (size_t)t * D) + 4 * lane;
#pragma unroll
      for (int j = 0; j < 4; ++j) { const f32x4 g0 = gp[j], b0 = bp[j]; f32x4 y;
#pragma unroll
          for (int i = 0; i < 4; ++i) y[i] = acc[4 * j + i] * rstd * g0[i] + b0[i];
          op[j] = y; } }
}
}

#define GAS __attribute__((address_space(1)))
typedef GAS unsigned gu32;
#define XB_TMO      128
#define XB_XCNT(j)  (256  + 64 * (j))
#define XB_XSUB(j)  (1280 + 64 * (j))
#define XB_XGEN(j)  (2304 + 64 * (j))
#define XB_TOP      3328
#define XB_TOPGEN   3392
#define XCD_BAR_WORDS 3456
#define XB_SPIN_CAP (1u << 18)

__device__ __forceinline__ unsigned xb_ld(unsigned* p)              { return __hip_atomic_load(p, __ATOMIC_RELAXED, __HIP_MEMORY_SCOPE_AGENT); }
__device__ __forceinline__ unsigned xb_add(unsigned* p, unsigned v) { return __hip_atomic_fetch_add(p, v, __ATOMIC_RELAXED, __HIP_MEMORY_SCOPE_AGENT); }
__device__ __forceinline__ unsigned xb_xcc_id() { return (unsigned)__builtin_amdgcn_s_getreg((3 << 11) | 20) & 0xFu; }
#define XB_SPIN(cond, bar) do { unsigned _sp = 0; while (cond) { __builtin_amdgcn_s_sleep(1); \
    if ((++_sp & 255u) == 0u) { if (xb_ld(&(bar)[XB_TMO])) break; if (_sp > XB_SPIN_CAP) { atomicAdd(&(bar)[XB_TMO], 1u); break; } } } } while (0)

struct XcdBarrier {
    unsigned* bar; unsigned x;
    volatile LAS unsigned* st;
};

__device__ __forceinline__ XcdBarrier xcd_barrier_post(unsigned* bar, volatile LAS unsigned* st) {
    XcdBarrier b; b.bar = bar; b.x = xb_xcc_id(); b.st = st;
    if (threadIdx.x == 0) (void)xb_add(&bar[XB_XCNT(b.x)], 1u);
    return b;
}
__device__ __forceinline__ void xcd_barrier_complete(unsigned* bar, unsigned x, unsigned& nloc, unsigned& nx) {
    const unsigned G = gridDim.x * gridDim.y * gridDim.z;
    unsigned sum, cnt, mine, sp = 0u;
    for (;;) {
        sum = 0u; cnt = 0u; mine = 0u;
#pragma unroll
        for (unsigned j = 0; j < 16; ++j) { const unsigned c = xb_ld(&bar[XB_XCNT(j)]); sum += c; cnt += (c > 0u) ? 1u : 0u; mine = (j == x) ? c : mine; }
        if (sum == G) break;
        __builtin_amdgcn_s_sleep(1);
        if ((++sp & 255u) == 0u) { if (xb_ld(&bar[XB_TMO])) break; if (sp > XB_SPIN_CAP) { atomicAdd(&bar[XB_TMO], 1u); break; } }
    }
    nloc = mine > 0u ? mine : 1u; nx = cnt > 0u ? cnt : 1u;
}

__device__ __forceinline__ void xcd_barrier(const XcdBarrier& b) {
    asm volatile("s_waitcnt vmcnt(0)" ::: "memory");
    __syncthreads();
    if (threadIdx.x == 0) {
        unsigned* bar = b.bar;
        __builtin_amdgcn_s_waitcnt(0);
        unsigned nloc = b.st[0], nx = b.st[1];
        if (nloc == 0u) { xcd_barrier_complete(bar, b.x, nloc, nx); b.st[0] = nloc; b.st[1] = nx; }
        const unsigned old = xb_add(&bar[XB_XSUB(b.x)], 1u);
        const unsigned gen = old / nloc;
        if (old + 1u == (gen + 1u) * nloc) {
            __builtin_amdgcn_fence(__ATOMIC_RELEASE, "agent");
            asm volatile("s_waitcnt vmcnt(0)" ::: "memory");
            const unsigned og = xb_add(&bar[XB_TOP], 1u);
            const unsigned tg = og / nx;
            if (og + 1u == (tg + 1u) * nx) xb_add(&bar[XB_TOPGEN], 1u);
            else XB_SPIN(xb_ld(&bar[XB_TOPGEN]) == tg, bar);
            __builtin_amdgcn_fence(__ATOMIC_ACQUIRE, "agent");
            xb_add(&bar[XB_XGEN(b.x)], 1u);
            asm volatile("s_waitcnt vmcnt(0)" ::: "memory");
        } else {
            XB_SPIN(xb_ld(&bar[XB_XGEN(b.x)]) == gen, bar);
            __builtin_amdgcn_fence(__ATOMIC_ACQUIRE, "agent");
            asm volatile("s_waitcnt vmcnt(0)" ::: "memory");
        }
    }
    __syncthreads();
}

struct Args {
    const float *x; const int* positions; const float *w_in, *conv_w, *conv_b, *gate_b, *lq1, *lk1, *lq2, *lk2, *subln_g, *w_conv_out, *w_attn_out, *w_o, *ln1_g, *ln1_b, *w_pq, *sub_keys, *u_tab, *v_tab, *ln2_g, *ln2_b;
    float* out; unsigned char* ws; int ph_lo, ph_hi;
};

__global__ void __launch_bounds__(NTHREADS, 2) fwd_kernel(Args a) {
    extern __shared__ __attribute__((aligned(16))) unsigned char lds_raw[];
    LAS unsigned char* lds = (LAS unsigned char*)lds_raw;
    const int tid = threadIdx.x, lane = tid & 63, wave = __builtin_amdgcn_readfirstlane(tid >> 6);
    const int G = gridDim.x, bx = blockIdx.x;
    const int gw = bx * NWAVES + wave, ngw = G * NWAVES, gtid = bx * NTHREADS + tid, gthreads = G * NTHREADS;
    unsigned char* ws = a.ws;
    bf16_t* Wt_in = (bf16_t*)(ws + WS_WIN); bf16_t* Wt_co = (bf16_t*)(ws + WS_WCO); bf16_t* Wt_ao = (bf16_t*)(ws + WS_WAO); bf16_t* Wt_o = (bf16_t*)(ws + WS_WO); bf16_t* Wt_sc = (bf16_t*)(ws + WS_WSC);
    float* CS = (float*)(ws + WS_CS);
    bf16_t* XB = (bf16_t*)(ws + WS_XB); bf16_t* Zb = (bf16_t*)(ws + WS_Z); bf16_t* BG = (bf16_t*)(ws + WS_BG); bf16_t* Qb = (bf16_t*)(ws + WS_Q); bf16_t* Kb = (bf16_t*)(ws + WS_K); bf16_t* Vb = (bf16_t*)(ws + WS_V);
    bf16_t* Gb = (bf16_t*)a.out;
    unsigned char* UB = ws + WS_UB; unsigned char* VB = ws + WS_VB; float* USC = (float*)(ws + WS_USC); float* VSC = (float*)(ws + WS_VSC); bf16_t* T1 = (bf16_t*)(ws + WS_T1); bf16_t* MG = (bf16_t*)(ws + WS_MG);
    bf16_t* X1B = (bf16_t*)(ws + WS_X1B); float* SC = (float*)(ws + WS_SC);
    const int lo = a.ph_lo, hi = a.ph_hi;
    for (int u = tid; u < (LDS_BYTES - LDSCTL_OFF) / 4; u += NTHREADS) ((LAS unsigned*)(lds + LDSCTL_OFF))[u] = 0u;
    __syncthreads();
    XcdBarrier bar; bar.bar = (unsigned*)(ws + WS_CTL) + CW_BAR; bar.x = 0; bar.st = nullptr;
    if (MK_N_LAUNCHES == 1) bar = xcd_barrier_post((unsigned*)(ws + WS_CTL) + CW_BAR, (volatile LAS unsigned*)(lds + MISC_OFF) + 8);
#define IN(k) (lo <= (k) && (k) < hi)
#define SEAM(k) do { if (IN(k) && IN((k) + 1)) xcd_barrier(bar); } while (0)

    if (IN(0)) {
        for (int it = bx; it < 256; it += G) wsc_item(a.w_pq, a.sub_keys, Wt_sc, lds, it, tid);
        LAS float* scr = (LAS float*)(lds + wave * 16384);
        constexpr int I_IN = (D / 64) * (NIN / 32), I_SQ = (D / 64) * (D / 32);
        for (int it = gw; it < I_IN + 3 * I_SQ; it += ngw) {
            int r = it;
            if (r < I_IN) { transpose_item<true>(a.w_in, D, NIN, Wt_in, scr, r, lane); continue; } r -= I_IN;
            if (r < I_SQ) { transpose_item<false>(a.w_conv_out, D, D, Wt_co, scr, r, lane); continue; } r -= I_SQ;
            if (r < I_SQ) { transpose_item<false>(a.w_attn_out, D, D, Wt_ao, scr, r, lane); continue; } r -= I_SQ;
            transpose_item<false>(a.w_o, D, D, Wt_o, scr, r, lane);
        }
        cvt_bf16(a.x, XB, (size_t)T * D, gtid, gthreads);
        for (int i = gtid; i < T * 8; i += gthreads) { const int t = i >> 3, f = i & 7;
            const float inv_freq = powf(500000.0f, -(float)f * 0.125f); const float ang = (float)a.positions[t] * inv_freq;
            CS[t * 16 + f] = cosf(ang); CS[t * 16 + 8 + f] = sinf(ang); }
    }
    SEAM(0);
    if (IN(1)) {
        pg8::Gemm g{XB, Wt_in, T, NIN, D}; pg8::StaticOrder S; S.init(T, NIN, G, bx);
        pg8::EpiProj E{Zb, BG, Qb, Kb, Vb, Gb, a.gate_b, CS};
        pg8::gemm_phase<pg8::EpiProj, pg8::StaticOrder, true, true>(lds, g, S, E);
    }
    SEAM(1);
    if (IN(2)) {
        conv_phase(Zb, BG, a.conv_w, a.conv_b, gtid, gthreads);
        float lam;
        { const float p1 = wave_sum(a.lq1[lane] * a.lk1[lane]), p2 = wave_sum(a.lq2[lane] * a.lk2[lane]); lam = __expf(p1) - __expf(p2) + LAM_INIT; }
        for (int it = bx; it < 512; it += G) {
            const int bh = it >> 3, pq = it & 7, b = bh >> 3, h = bh & 7;
            att::attn_unit(b, h, 15 - pq, Qb, Kb, Vb, Qb, a.subln_g, lam, lds, tid);
            att::attn_unit(b, h, pq, Qb, Kb, Vb, Qb, a.subln_g, lam, lds, tid);
        }
    }
    SEAM(2);
    if (IN(3)) {
        cvt_fp8_rows(a.u_tab, UB, USC, NEXP, gw, ngw, lane);
        cvt_fp8_rows(a.v_tab, VB, VSC, NEXP, gw, ngw, lane);
        pg8::Gemm g{BG, Wt_co, T, D, D}; pg8::StaticOrder S; S.init(T, D, G, bx);
        pg8::EpiGate1 E{Gb, T1};
        pg8::gemm_phase<pg8::EpiGate1, pg8::StaticOrder, true, true>(lds, g, S, E);
    }
    SEAM(3);
    if (IN(4)) {
        pg8::Gemm g{Qb, Wt_ao, T, D, D}; pg8::StaticOrder S; S.init(T, D, G, bx);
        pg8::EpiGate2 E{Gb, T1, MG};
        pg8::gemm_phase<pg8::EpiGate2, pg8::StaticOrder, true, true>(lds, g, S, E);
    }
    SEAM(4);
    if (IN(5)) {
        pg8::Gemm g{MG, Wt_o, T, D, D}; pg8::StaticOrder S; S.init(T, D, G, bx);
        pg8::EpiF32<true, 1024> E{a.x, a.out};
        pg8::gemm_phase<pg8::EpiF32<true, 1024>, pg8::StaticOrder, true, true>(lds, g, S, E);
    }
    SEAM(5);
    if (IN(6)) ln1_phase(a.out, X1B, a.ln1_g, a.ln1_b, gw, ngw, lane);
    SEAM(6);
    if (IN(7)) {
        pg8::Gemm g{X1B, Wt_sc, T, 2048, D}; pg8::StaticOrder S; S.init(T, 2048, G, bx);
        pg8::EpiF32<false, 2048> E{nullptr, SC};
        pg8::gemm_phase<pg8::EpiF32<false, 2048>, pg8::StaticOrder, true, true>(lds, g, S, E);
    }
    SEAM(7);
    if (IN(8)) {
        LAS unsigned char* wl = lds + wave * peer::WAVE_LDS;
        for (int t = gw; t < T; t += ngw) peer::token(t, SC, a.out, UB, VB, USC, VSC, a.ln2_g, a.ln2_b, wl, lane);
    }
#undef IN
#undef SEAM
}

extern "C" void kernel_launch(void* const* d_in, const int* in_sizes, int n_in, void* d_out, int out_size, void* d_ws, size_t ws_size, hipStream_t stream) {
    static int grid = 0;
    if (grid == 0) {
        if (n_in != 22 || out_size != T * D || ws_size < WS_END) { fprintf(stderr, "kernel_launch: unexpected shapes (n_in %d, out %d, ws %zu); nothing launched\n", n_in, out_size, ws_size); grid = -1; return; }
        int dev = 0, cus = 0, per_cu = 0;
        if (hipGetDevice(&dev) != hipSuccess || hipDeviceGetAttribute(&cus, hipDeviceAttributeMultiprocessorCount, dev) != hipSuccess) { grid = -1; return; }
        if (hipFuncSetAttribute((const void*)fwd_kernel, hipFuncAttributeMaxDynamicSharedMemorySize, LDS_BYTES) != hipSuccess) { fprintf(stderr, "kernel_launch: hipFuncSetAttribute failed\n"); grid = -1; return; }
        if (hipOccupancyMaxActiveBlocksPerMultiprocessor(&per_cu, (const void*)fwd_kernel, NTHREADS, LDS_BYTES) != hipSuccess || per_cu < 1) { fprintf(stderr, "kernel_launch: occupancy query failed (%d)\n", per_cu); (void)hipGetLastError(); per_cu = 1; }
        grid = cus * per_cu;
    }
    if (grid < 0) return;
    if (hipMemsetAsync((char*)d_ws + WS_CTL, 0, CTL_ZERO_BYTES, stream) != hipSuccess) { fprintf(stderr, "kernel_launch: hipMemsetAsync failed\n"); return; }
    Args a{};
    a.x = (const float*)d_in[0]; a.positions = (const int*)d_in[1]; a.w_in = (const float*)d_in[2]; a.conv_w = (const float*)d_in[3]; a.conv_b = (const float*)d_in[4]; a.gate_b = (const float*)d_in[5];
    a.lq1 = (const float*)d_in[6]; a.lk1 = (const float*)d_in[7]; a.lq2 = (const float*)d_in[8]; a.lk2 = (const float*)d_in[9]; a.subln_g = (const float*)d_in[10];
    a.w_conv_out = (const float*)d_in[11]; a.w_attn_out = (const float*)d_in[12]; a.w_o = (const float*)d_in[13]; a.ln1_g = (const float*)d_in[14]; a.ln1_b = (const float*)d_in[15];
    a.w_pq = (const float*)d_in[16]; a.sub_keys = (const float*)d_in[17]; a.u_tab = (const float*)d_in[18]; a.v_tab = (const float*)d_in[19]; a.ln2_g = (const float*)d_in[20]; a.ln2_b = (const float*)d_in[21];
    a.out = (float*)d_out; a.ws = (unsigned char*)d_ws;
#if MK_N_LAUNCHES == 1
    a.ph_lo = 0; a.ph_hi = NPHASES;
    void* args[] = {&a};
    hipError_t e = hipLaunchCooperativeKernel((const void*)fwd_kernel, dim3(grid), dim3(NTHREADS), args, LDS_BYTES, stream);
    if (e != hipSuccess) fprintf(stderr, "kernel_launch: cooperative launch failed: %s (grid %d)\n", hipGetErrorString(e), grid);
#else
    for (int p = 0; p < NPHASES; ++p) { a.ph_lo = p; a.ph_hi = p + 1; hipLaunchKernelGGL(fwd_kernel, dim3(grid), dim3(NTHREADS), LDS_BYTES, stream, a); }
#endif
}
```

```cpp
#include <hip/hip_runtime.h>
#include <hip/hip_cooperative_groups.h>
#include <cstdio>
#include <cstdint>
namespace cg = cooperative_groups;
namespace pg8 {
#define PG8_LAS __attribute__((address_space(3)))
typedef unsigned short bf16_t;
typedef short bf16x8 __attribute__((ext_vector_type(8)));
typedef float f32x4 __attribute__((ext_vector_type(4)));
typedef unsigned u32x4 __attribute__((ext_vector_type(4)));
constexpr int BM = 256, BK = 64, HALF = 128, HTB = HALF * BK * 2  , STAGE_BYTES = 8 * HTB, NXCD = 8, WGM = 8;

__host__ __device__ __forceinline__ int lds_byte(int r, int c) { const int st = (r >> 4) * 2 + (c >> 5), rr = r & 15, cc = c & 31, ob = rr * 64 + cc * 2; return st * 1024 + (ob ^ (((ob >> 9) & 1) << 5)); }
__host__ __device__ __forceinline__ void stage_rc(int b, int& R, int& C) { const int st = b / 1024, sb = b % 1024, swz = sb ^ (((sb >> 9) & 1) << 5); R = (st >> 1) * 16 + swz / 64; C = (st & 1) * 32 + (swz % 64) / 2; }
__host__ __device__ __forceinline__ int perm32(int rho) { const int n = rho >> 4, i = rho & 15; return 8 * (i >> 2) + 4 * n + (i & 3); }

struct Unit { int pm, pn; };
struct Gemm { const bf16_t* A; const bf16_t* Bt; int M, N, K; };

struct StaticOrder {
    int nM, nN, nwg, G, c;
    __host__ __device__ void init(int M, int N, int G_, int c_) { nM = M / BM; nN = N / BM; nwg = nM * nN; G = G_; c = c_; }
    __host__ __device__ bool next(int i, Unit& u) const {
        const long L = (long)i * G + c; if (L >= nwg) return false;
        int wgid = (int)L; { const int q = nwg / NXCD, r = nwg % NXCD, xcd = wgid % NXCD, off = wgid / NXCD; wgid = (xcd < r ? xcd * (q + 1) : r * (q + 1) + (xcd - r) * q) + off; }
        const int nig = WGM * nN, gid = wgid / nig, fm = gid * WGM, gsz = (nM - fm) < WGM ? (nM - fm) : WGM;
        u.pm = fm + ((wgid % nig) % gsz); u.pn = (wgid % nig) / gsz; return true;
    }
    __device__ __forceinline__ void a_ready(const Unit&) const {}
    __device__ __forceinline__ void done(const Unit&) const {}
};


__device__ __forceinline__ unsigned cvt_pk_bf16(float lo, float hi) { unsigned r; asm volatile("v_cvt_pk_bf16_f32 %0, %1, %2" : "=v"(r) : "v"(lo), "v"(hi)); return r; }
__device__ __forceinline__ void store8(bf16_t* p, f32x4 v0, f32x4 v1) {
    u32x4 w; w.x = cvt_pk_bf16(v0[0], v0[1]); w.y = cvt_pk_bf16(v0[2], v0[3]); w.z = cvt_pk_bf16(v1[0], v1[1]); w.w = cvt_pk_bf16(v1[2], v1[3]);
    *(u32x4*)p = w;
}
__device__ __forceinline__ void load8(const bf16_t* p, f32x4& v0, f32x4& v1) {
    const u32x4 w = *(const u32x4*)p;
    v0[0] = __uint_as_float(w.x << 16); v0[1] = __uint_as_float(w.x & 0xffff0000u); v0[2] = __uint_as_float(w.y << 16); v0[3] = __uint_as_float(w.y & 0xffff0000u);
    v1[0] = __uint_as_float(w.z << 16); v1[1] = __uint_as_float(w.z & 0xffff0000u); v1[2] = __uint_as_float(w.w << 16); v1[3] = __uint_as_float(w.w & 0xffff0000u);
}
constexpr float QSCALE = 0.125f * 1.4426950408889634f;

struct EpiProj {
    static constexpr bool PERM = true, AFTER_DRAIN = false;
    bf16_t *Z, *BG, *Q, *Kk, *V, *G; const float* gate_b; const float* CS;
    __device__ __forceinline__ void operator()(const f32x4 (&acc)[2][2][4][2], const Unit& u, int wr, int wc, int fr, int fq) const {
        const int row0 = u.pm * BM + wr * 64 + fr, pn = u.pn, cw = wc * 32 + 8 * fq;
        if (pn < 8) {
#pragma unroll
            for (int ai = 0; ai < 2; ++ai)
#pragma unroll
                for (int m = 0; m < 4; ++m) { const size_t row = row0 + ai * HALF + m * 16;
                    store8(Z + row * 1024 + pn * 128 + cw, acc[ai][0][m][0] * acc[ai][1][m][0], acc[ai][0][m][1] * acc[ai][1][m][1]); }
        } else if (pn < 12) {
#pragma unroll
            for (int ai = 0; ai < 2; ++ai)
#pragma unroll
                for (int m = 0; m < 4; ++m) { const size_t row = row0 + ai * HALF + m * 16;
#pragma unroll
                    for (int bj = 0; bj < 2; ++bj) store8(BG + row * 1024 + (pn - 8) * 256 + bj * HALF + cw, acc[ai][bj][m][0], acc[ai][bj][m][1]); }
        } else if (pn < 20) {
            const bool isq = pn < 16; bf16_t* dst = isq ? Q : Kk; const int cb = ((pn - 12) & 3) * 256; const float sc = isq ? QSCALE : 1.0f;
            const bool rot = ((wc & 1) == 0) && (fq < 2);
#pragma unroll
            for (int ai = 0; ai < 2; ++ai)
#pragma unroll
                for (int m = 0; m < 4; ++m) { const size_t row = row0 + ai * HALF + m * 16;
                    f32x4 c4 = *(const f32x4*)(CS + row * 16 + 4 * (fq & 1)), s4 = *(const f32x4*)(CS + row * 16 + 8 + 4 * (fq & 1));
                    if (!rot) { c4 = (f32x4){1.f, 1.f, 1.f, 1.f}; s4 = (f32x4){0.f, 0.f, 0.f, 0.f}; }
#pragma unroll
                    for (int bj = 0; bj < 2; ++bj) { const f32x4 v0 = acc[ai][bj][m][0], v1 = acc[ai][bj][m][1]; f32x4 o0, o1;
                        o0[0] = v0[0] * c4[0] - v0[1] * s4[0]; o0[1] = v0[1] * c4[0] + v0[0] * s4[0];
                        o0[2] = v0[2] * c4[1] - v0[3] * s4[1]; o0[3] = v0[3] * c4[1] + v0[2] * s4[1];
                        o1[0] = v1[0] * c4[2] - v1[1] * s4[2]; o1[1] = v1[1] * c4[2] + v1[0] * s4[2];
                        o1[2] = v1[2] * c4[3] - v1[3] * s4[3]; o1[3] = v1[3] * c4[3] + v1[2] * s4[3];
                        store8(dst + row * 1024 + cb + bj * HALF + cw, o0 * sc, o1 * sc); } }
        } else if (pn < 24) {
#pragma unroll
            for (int ai = 0; ai < 2; ++ai)
#pragma unroll
                for (int m = 0; m < 4; ++m) { const size_t row = row0 + ai * HALF + m * 16;
#pragma unroll
                    for (int bj = 0; bj < 2; ++bj) store8(V + row * 1024 + (pn - 20) * 256 + bj * HALF + cw, acc[ai][bj][m][0], acc[ai][bj][m][1]); }
        } else {
            f32x4 bv[2][2];
#pragma unroll
            for (int bj = 0; bj < 2; ++bj)
#pragma unroll
                for (int n = 0; n < 2; ++n) bv[bj][n] = *(const f32x4*)(gate_b + (pn - 24) * 256 + bj * HALF + cw + 4 * n);
#pragma unroll
            for (int ai = 0; ai < 2; ++ai)
#pragma unroll
                for (int m = 0; m < 4; ++m) { const size_t row = row0 + ai * HALF + m * 16;
#pragma unroll
                    for (int bj = 0; bj < 2; ++bj) { f32x4 g0 = acc[ai][bj][m][0] + bv[bj][0], g1 = acc[ai][bj][m][1] + bv[bj][1];
#pragma unroll
                        for (int i = 0; i < 4; ++i) { g0[i] = 1.0f / (1.0f + __expf(-g0[i])); g1[i] = 1.0f / (1.0f + __expf(-g1[i])); }
                        store8(G + row * 2048 + (pn - 24) * 256 + bj * HALF + cw, g0, g1); } }
        }
    }
};
struct EpiGate1 {
    static constexpr bool PERM = true, AFTER_DRAIN = false;
    const bf16_t* G; bf16_t* T1;
    __device__ __forceinline__ void operator()(const f32x4 (&acc)[2][2][4][2], const Unit& u, int wr, int wc, int fr, int fq) const {
        const int row0 = u.pm * BM + wr * 64 + fr, col0 = u.pn * BM + wc * 32 + 8 * fq;
#pragma unroll
        for (int ai = 0; ai < 2; ++ai)
#pragma unroll
            for (int m = 0; m < 4; ++m) { const size_t row = row0 + ai * HALF + m * 16;
#pragma unroll
                for (int bj = 0; bj < 2; ++bj) { f32x4 g0, g1; load8(G + row * 2048 + col0 + bj * HALF, g0, g1);
                    store8(T1 + row * 1024 + col0 + bj * HALF, acc[ai][bj][m][0] * g0, acc[ai][bj][m][1] * g1); } }
    }
};
struct EpiGate2 {
    static constexpr bool PERM = true, AFTER_DRAIN = false;
    const bf16_t* G; const bf16_t* T1; bf16_t* MG;
    __device__ __forceinline__ void operator()(const f32x4 (&acc)[2][2][4][2], const Unit& u, int wr, int wc, int fr, int fq) const {
        const int row0 = u.pm * BM + wr * 64 + fr, col0 = u.pn * BM + wc * 32 + 8 * fq;
#pragma unroll
        for (int ai = 0; ai < 2; ++ai)
#pragma unroll
            for (int m = 0; m < 4; ++m) { const size_t row = row0 + ai * HALF + m * 16;
#pragma unroll
                for (int bj = 0; bj < 2; ++bj) { f32x4 g0, g1, t0, t1; load8(G + row * 2048 + 1024 + col0 + bj * HALF, g0, g1); load8(T1 + row * 1024 + col0 + bj * HALF, t0, t1);
                    store8(MG + row * 1024 + col0 + bj * HALF, t0 + acc[ai][bj][m][0] * g0, t1 + acc[ai][bj][m][1] * g1); } }
    }
};
template <bool HAS_BASE, int ldc> struct EpiF32 {
    static constexpr bool PERM = false, AFTER_DRAIN = false;
    static constexpr float alpha = 1.189207115002721f;
    const float* base; float* O;
    __device__ __forceinline__ void operator()(const f32x4 (&acc)[2][2][4][2], const Unit& u, int wr, int wc, int fr, int fq) const {
        const int row0 = u.pm * BM + wr * 64 + fr, col0 = u.pn * BM + wc * 32 + 4 * fq;
#pragma unroll
        for (int ai = 0; ai < 2; ++ai)
#pragma unroll
            for (int m = 0; m < 4; ++m) { const size_t row = row0 + ai * HALF + m * 16;
#pragma unroll
                for (int bj = 0; bj < 2; ++bj)
#pragma unroll
                    for (int n = 0; n < 2; ++n) { const size_t o = row * ldc + col0 + bj * HALF + n * 16; f32x4 v = acc[ai][bj][m][n];
                        if constexpr (HAS_BASE) v = v + alpha * *(const f32x4*)(base + o);
                        *(f32x4*)(O + o) = v; } }
    }
};

template <class Epi, class Sched, bool ALIGN_EPI = false, bool SP2 = false>
__device__ __forceinline__ void gemm_phase(PG8_LAS unsigned char* lds, const Gemm g, const Sched& S, const Epi& E) {
    const int tid = threadIdx.x, wid = __builtin_amdgcn_readfirstlane(tid >> 6), lane = tid & 63, wr = wid >> 2, wc = wid & 3, fr = lane & 15, fq = lane >> 4;
    const int K = g.K, nt = K / BK;
    unsigned voffA[2], voffB[2];
#pragma unroll
    for (int i = 0; i < 2; ++i) { int R, C; stage_rc(tid * 16 + i * 8192, R, C); const int Rb = Epi::PERM ? ((R & ~31) + perm32(R & 31)) : R;
        voffA[i] = (unsigned)(R * K + C) * 2u; voffB[i] = (unsigned)(Rb * K + C) * 2u; }
    const size_t kstep = (size_t)(BK * 2);
    const size_t hstep = (size_t)HALF * K * 2;
    const size_t tstep = 2 * hstep;
    const unsigned ldsw = (unsigned)wid * 1024u;
    const int aoff = lds_byte(wr * 64 + fr, fq * 8), boff = lds_byte(wc * 32 + fr, fq * 8);
#define PG8_SA(b, h) (((b) * 2 + (h)) * HTB)
#define PG8_SB(b, h) ((4 + (b) * 2 + (h)) * HTB)
#define PG8_STAGE(bufoff, gbase, voff) do { _Pragma("unroll") for (int _i = 0; _i < 2; ++_i) \
        __builtin_amdgcn_global_load_lds((const unsigned*)((const char*)(gbase) + (voff)[_i]), (PG8_LAS unsigned*)(lds + (bufoff) + ldsw + _i * 8192), 16, 0, 0); } while (0)
#define PG8_LDA(dst, b, h) do { _Pragma("unroll") for (int m = 0; m < 4; ++m) _Pragma("unroll") for (int k = 0; k < 2; ++k) dst[m][k] = *(const PG8_LAS bf16x8*)(lds + PG8_SA(b, h) + aoff + m * 2048 + k * 1024); } while (0)
#define PG8_LDB(dst, b, h) do { _Pragma("unroll") for (int n = 0; n < 2; ++n) _Pragma("unroll") for (int k = 0; k < 2; ++k) dst[n][k] = *(const PG8_LAS bf16x8*)(lds + PG8_SB(b, h) + boff + n * 2048 + k * 1024); } while (0)
#define PG8_MMA(ai, bj, At, Bt) do { __builtin_amdgcn_s_setprio(1); _Pragma("unroll") for (int m = 0; m < 4; ++m) _Pragma("unroll") for (int n = 0; n < 2; ++n) _Pragma("unroll") for (int k = 0; k < 2; ++k) \
        acc[ai][bj][m][n] = __builtin_amdgcn_mfma_f32_16x16x32_bf16(Bt[n][k], At[m][k], acc[ai][bj][m][n], 0, 0, 0); __builtin_amdgcn_s_setprio(0); } while (0)
#define PG8_WAIT_V(n) asm volatile("s_waitcnt vmcnt(" #n ")" ::: "memory")
#define PG8_WAIT_L(n) asm volatile("s_waitcnt lgkmcnt(" #n ")" ::: "memory")
#define PG8_BAR __builtin_amdgcn_s_barrier()
#define PG8_SCHED __builtin_amdgcn_sched_barrier(0)
    Unit cur, nxt; int ui = 0;
    if (!S.next(0, cur)) return;
    f32x4 acc[2][2][4][2];
#pragma unroll
    for (int a = 0; a < 2; ++a)
#pragma unroll
        for (int b = 0; b < 2; ++b)
#pragma unroll
            for (int m = 0; m < 4; ++m)
#pragma unroll
                for (int n = 0; n < 2; ++n) acc[a][b][m][n] = (f32x4){0.f, 0.f, 0.f, 0.f};
    bf16x8 At[4][2], B0[2][2], B1[2][2];
    const char* cA = (const char*)g.A + (size_t)cur.pm * tstep; const char* cB = (const char*)g.Bt + (size_t)cur.pn * tstep;
    S.a_ready(cur);
    if constexpr (SP2) {
        PG8_STAGE(PG8_SB(0, 0), cB, voffB); PG8_STAGE(PG8_SB(0, 1), cB + hstep, voffB); PG8_STAGE(PG8_SA(0, 0), cA, voffA); PG8_STAGE(PG8_SA(0, 1), cA + hstep, voffA);
        if (wr == 1) PG8_BAR;
        PG8_WAIT_V(2); PG8_BAR;
        PG8_STAGE(PG8_SB(1, 0), cB + kstep, voffB); PG8_STAGE(PG8_SA(1, 0), cA + kstep, voffA); PG8_STAGE(PG8_SB(1, 1), cB + hstep + kstep, voffB);
        PG8_WAIT_V(6); PG8_BAR;
    } else {
        PG8_STAGE(PG8_SB(0, 0), cB, voffB); PG8_STAGE(PG8_SA(0, 0), cA, voffA); PG8_STAGE(PG8_SB(0, 1), cB + hstep, voffB); PG8_STAGE(PG8_SA(0, 1), cA + hstep, voffA);
        if (wr == 1) PG8_BAR;
        PG8_WAIT_V(4); PG8_BAR;
        PG8_STAGE(PG8_SB(1, 0), cB + kstep, voffB); PG8_STAGE(PG8_SA(1, 0), cA + kstep, voffA); PG8_STAGE(PG8_SB(1, 1), cB + hstep + kstep, voffB);
        PG8_WAIT_V(6); PG8_BAR;
    }
    for (;;) {
        const bool has_next = S.next(ui + 1, nxt);
        const char* nA = has_next ? (const char*)g.A + (size_t)nxt.pm * tstep : cA; const char* nB = has_next ? (const char*)g.Bt + (size_t)nxt.pn * tstep : cB;
        for (int t = 0; t < nt; t += 2) {
            const bool last = (t == nt - 2);
            const char* a1 = cA + (size_t)(t + 1) * kstep;
            const char* a2 = last ? nA : cA + (size_t)(t + 2) * kstep; const char* b2 = last ? nB : cB + (size_t)(t + 2) * kstep;
            const char* a3 = a2 + kstep; const char* b3 = b2 + kstep;
            if (last && has_next) S.a_ready(nxt);
            if constexpr (SP2) {
            PG8_LDB(B0, 0, 0); PG8_LDB(B1, 0, 1); PG8_SCHED; PG8_LDA(At, 0, 0); PG8_STAGE(PG8_SA(1, 1), a1 + hstep, voffA);
            PG8_WAIT_V(8); PG8_WAIT_L(0); PG8_BAR; PG8_MMA(0, 0, At, B0); PG8_MMA(0, 1, At, B1); PG8_BAR; PG8_SCHED;
            PG8_LDA(At, 0, 1); PG8_STAGE(PG8_SB(0, 0), b2, voffB); PG8_STAGE(PG8_SB(0, 1), b2 + hstep, voffB); PG8_STAGE(PG8_SA(0, 0), a2, voffA);
            PG8_WAIT_V(8); PG8_WAIT_L(0); PG8_BAR; PG8_MMA(1, 0, At, B0); PG8_MMA(1, 1, At, B1); PG8_BAR; PG8_SCHED;
            PG8_LDB(B0, 1, 0); PG8_LDB(B1, 1, 1); PG8_SCHED; PG8_LDA(At, 1, 0); PG8_STAGE(PG8_SA(0, 1), a2 + hstep, voffA);
            PG8_WAIT_V(8); PG8_WAIT_L(0); PG8_BAR; PG8_MMA(0, 0, At, B0); PG8_MMA(0, 1, At, B1); PG8_BAR; PG8_SCHED;
            PG8_LDA(At, 1, 1); PG8_STAGE(PG8_SB(1, 0), b3, voffB); PG8_STAGE(PG8_SB(1, 1), b3 + hstep, voffB); PG8_STAGE(PG8_SA(1, 0), a3, voffA);
            PG8_WAIT_V(8); PG8_WAIT_L(0); PG8_BAR; PG8_MMA(1, 0, At, B0); PG8_MMA(1, 1, At, B1); PG8_BAR; PG8_SCHED;
            } else {
            PG8_LDB(B0, 0, 0); PG8_SCHED; PG8_LDA(At, 0, 0); PG8_STAGE(PG8_SA(1, 1), a1 + hstep, voffA);
            PG8_WAIT_L(8); PG8_BAR; PG8_WAIT_L(0); PG8_MMA(0, 0, At, B0); PG8_BAR; PG8_SCHED;
            PG8_LDB(B1, 0, 1); PG8_STAGE(PG8_SB(0, 0), b2, voffB);
            PG8_BAR; PG8_WAIT_L(0); PG8_MMA(0, 1, At, B1); PG8_BAR;
            PG8_LDA(At, 0, 1); PG8_STAGE(PG8_SA(0, 0), a2, voffA);
            PG8_BAR; PG8_WAIT_L(0); PG8_MMA(1, 0, At, B0); PG8_BAR; PG8_SCHED;
            PG8_STAGE(PG8_SB(0, 1), b2 + hstep, voffB);
            PG8_WAIT_V(6); PG8_BAR; PG8_MMA(1, 1, At, B1); PG8_BAR;
            PG8_LDB(B0, 1, 0); PG8_SCHED; PG8_LDA(At, 1, 0); PG8_STAGE(PG8_SA(0, 1), a2 + hstep, voffA);
            PG8_WAIT_L(8); PG8_BAR; PG8_WAIT_L(0); PG8_MMA(0, 0, At, B0); PG8_BAR; PG8_SCHED;
            PG8_LDB(B1, 1, 1); PG8_STAGE(PG8_SB(1, 0), b3, voffB);
            PG8_BAR; PG8_WAIT_L(0); PG8_MMA(0, 1, At, B1); PG8_BAR;
            PG8_LDA(At, 1, 1); PG8_STAGE(PG8_SA(1, 0), a3, voffA);
            PG8_BAR; PG8_WAIT_L(0); PG8_MMA(1, 0, At, B0); PG8_BAR; PG8_SCHED;
            PG8_STAGE(PG8_SB(1, 1), b3 + hstep, voffB);
            PG8_WAIT_V(6); PG8_BAR; PG8_MMA(1, 1, At, B1); PG8_BAR;
            }
        }
        if constexpr (ALIGN_EPI) { if (wr == 0) PG8_BAR; }
        if constexpr (!Epi::AFTER_DRAIN) { E(acc, cur, wr, wc, fr, fq); S.done(cur); }
        if (!has_next) break;
#pragma unroll
        for (int a = 0; a < 2; ++a)
#pragma unroll
            for (int b = 0; b < 2; ++b)
#pragma unroll
                for (int m = 0; m < 4; ++m)
#pragma unroll
                    for (int n = 0; n < 2; ++n) acc[a][b][m][n] = (f32x4){0.f, 0.f, 0.f, 0.f};
        cur = nxt; cA = nA; cB = nB; ++ui;
        if constexpr (ALIGN_EPI) { if (wr == 1) PG8_BAR; }
    }
    PG8_WAIT_V(0);
    if constexpr (!ALIGN_EPI) { if (wr == 0) PG8_BAR; }
    PG8_BAR;
    if constexpr (Epi::AFTER_DRAIN) { E.fused(acc, cur, wr, wc, fr, fq, lds, wid, lane); S.done(cur); }
#undef PG8_SA
#undef PG8_SB
#undef PG8_STAGE
#undef PG8_LDA
#undef PG8_LDB
#undef PG8_MMA
#undef PG8_WAIT_V
#undef PG8_WAIT_L
#undef PG8_BAR
#undef PG8_SCHED
}
}

constexpr int T = 16384, D = 1024, SEQ = 2048, NBATCH = 8, NIN = 8192;
constexpr int NHEAD = 8, NEXP = 16384;
constexpr float LN_EPS = 1e-5f;
constexpr float ALPHA = 1.189207115002721f;
constexpr float LAM_INIT = 0.2f;
constexpr int NWAVES = 8, NTHREADS = 512;
constexpr int LDS_BYTES = 147456;
constexpr int NPHASES = 9;
constexpr int RING_BYTES = 131072, LDSCTL_OFF = RING_BYTES, MISC_OFF = LDSCTL_OFF + 320;
constexpr int CW_BAR = 4096;
constexpr size_t CTL_ZERO_BYTES = 65536;
#ifndef PROBE_REP
#define PROBE_REP -1
#endif
#ifndef PROBE_SUB
#define PROBE_SUB 0
#endif
#ifndef MK_N_LAUNCHES
#define MK_N_LAUNCHES 1
#endif

typedef unsigned short bf16_t;
typedef short bf16x8 __attribute__((ext_vector_type(8)));
typedef short s16x4 __attribute__((ext_vector_type(4)));
typedef float f32x4 __attribute__((ext_vector_type(4)));
typedef float f32x16 __attribute__((ext_vector_type(16)));
typedef unsigned u32x4 __attribute__((ext_vector_type(4)));
typedef unsigned u32x2 __attribute__((ext_vector_type(2)));
#define LAS __attribute__((address_space(3)))
#define LDS_WAIT() asm volatile("s_waitcnt lgkmcnt(0)" ::: "memory")

constexpr size_t MiB = 1u << 20;
constexpr size_t WS_CTL = 0, WS_CS = 1 * MiB, WS_WCO = 2 * MiB, WS_WAO = 4 * MiB, WS_WO = 6 * MiB, WS_WSC = 8 * MiB;
constexpr size_t WS_WIN = 12 * MiB, WS_XB = 28 * MiB, WS_Z = 60 * MiB, WS_BG = 92 * MiB, WS_Q = 124 * MiB, WS_K = 156 * MiB, WS_V = 188 * MiB;
constexpr size_t WS_UB = 12 * MiB, WS_VB = 28 * MiB, WS_USC = 44 * MiB, WS_VSC = 44 * MiB + 65536;
constexpr size_t WS_T1 = 156 * MiB, WS_MG = 188 * MiB;
constexpr size_t WS_X1B = 76 * MiB;
constexpr size_t WS_SC = 124 * MiB;
constexpr size_t WS_END = 252 * MiB;

__device__ __forceinline__ unsigned f2bf(float f) { unsigned u = __builtin_bit_cast(unsigned, f); return (u + 0x7fffu + ((u >> 16) & 1u)) >> 16; }
__device__ __forceinline__ unsigned pk2(float lo, float hi) { return f2bf(lo) | (f2bf(hi) << 16); }
__device__ __forceinline__ float bflo(unsigned w) { return __uint_as_float(w << 16); }
__device__ __forceinline__ float bfhi(unsigned w) { return __uint_as_float(w & 0xffff0000u); }
__device__ __forceinline__ float wave_sum(float v) {
#pragma unroll
    for (int o = 1; o < 64; o <<= 1) v += __shfl_xor(v, o);
    return v;
}
__device__ __forceinline__ float wave_max(float v) {
#pragma unroll
    for (int o = 1; o < 64; o <<= 1) v = fmaxf(v, __shfl_xor(v, o));
    return v;
}
__device__ __forceinline__ float wave_min(float v) {
#pragma unroll
    for (int o = 1; o < 64; o <<= 1) v = fminf(v, __shfl_xor(v, o));
    return v;
}

__device__ __forceinline__ int win_src(int n) {
    if (n < 2048) { const int i = n >> 8, r = n & 255; return r < 128 ? 128 * i + r : 2048 + 128 * i + (r - 128); }
    if (n < 3072) return 1024 + (n - 2048);
    if (n < 5120) { const int base = n - 3072, which = base >> 10, within = base & 1023, map = within >> 6, p = within & 63; const int d = p < 16 ? (p >> 1) + 8 * (p & 1) : p; return 3072 + which * 1024 + map * 64 + d; }
    return n;
}
template <bool PERMUTE>
__device__ __forceinline__ void transpose_item(const float* W, int K, int N, bf16_t* WT, LAS float* scr, int item, int lane) {
    const int nblk = N / 32, kb = item / nblk, nb = item % nblk, k0 = 64 * kb, n0 = 32 * nb;
    const int nsrc = PERMUTE ? win_src(n0 + (lane & 31)) : n0 + (lane & 31);
#pragma unroll 8
    for (int i = 0; i < 32; ++i) { const int kk = 2 * i + (lane >> 5); scr[kk * 33 + (lane & 31)] = W[(size_t)(k0 + kk) * N + nsrc]; }
    LDS_WAIT();
    const int c = lane & 7;
#pragma unroll
    for (int j = 0; j < 4; ++j) { const int n = (lane >> 3) + 8 * j; const LAS float* s = scr + (8 * c) * 33 + n;
        u32x4 o; o.x = pk2(s[0 * 33], s[1 * 33]); o.y = pk2(s[2 * 33], s[3 * 33]); o.z = pk2(s[4 * 33], s[5 * 33]); o.w = pk2(s[6 * 33], s[7 * 33]);
        *(u32x4*)(WT + (size_t)(n0 + n) * K + k0 + 8 * c) = o; }
    LDS_WAIT();
}
__device__ __forceinline__ void cvt_bf16(const float* src, bf16_t* dst, size_t n, int gtid, int gthreads) {
    const size_t n8 = n / 8;
    for (size_t i = gtid; i < n8; i += gthreads) {
        const f32x4 a = *(const f32x4*)(src + i * 8), b = *(const f32x4*)(src + i * 8 + 4);
        u32x4 o; o.x = pk2(a[0], a[1]); o.y = pk2(a[2], a[3]); o.z = pk2(b[0], b[1]); o.w = pk2(b[2], b[3]);
        *(u32x4*)(dst + i * 8) = o;
    }
}
typedef float f32x2 __attribute__((ext_vector_type(2)));
__device__ __forceinline__ void cvt_fp8_rows(const float* src, unsigned char* dst, float* scale, int nrows, int gw, int ngw, int lane) {
    for (int r = gw; r < nrows; r += ngw) {
        const f32x4* p = (const f32x4*)(src + (size_t)r * 1024) + 4 * lane;
        f32x4 v[4]; float m = 0.f;
#pragma unroll
        for (int j = 0; j < 4; ++j) { v[j] = p[j]; m = fmaxf(m, fmaxf(fmaxf(fabsf(v[j][0]), fabsf(v[j][1])), fmaxf(fabsf(v[j][2]), fabsf(v[j][3])))); }
        m = wave_max(m);
        const float sc = m > 0.f ? 384.0f / m : 1.0f;
        u32x4 o;
#pragma unroll
        for (int j = 0; j < 4; ++j) { int w = __builtin_amdgcn_cvt_pk_fp8_f32(v[j][0] * sc, v[j][1] * sc, 0, false); w = __builtin_amdgcn_cvt_pk_fp8_f32(v[j][2] * sc, v[j][3] * sc, w, true); o[j] = (unsigned)w; }
        *(u32x4*)(dst + ((size_t)(lane >> 3) * nrows + r) * 128 + 16 * (lane & 7)) = o;
        if (lane == 0) scale[r] = m > 0.f ? m * (1.0f / 384.0f) : 1.0f;
    }
}
__device__ __forceinline__ void unpack16_fp8(const u32x4 a, float (&f)[16]) {
#pragma unroll
    for (int j = 0; j < 4; ++j) { const f32x2 lo = __builtin_amdgcn_cvt_pk_f32_fp8((int)a[j], false), hi = __builtin_amdgcn_cvt_pk_f32_fp8((int)a[j], true);
        f[4 * j] = lo[0]; f[4 * j + 1] = lo[1]; f[4 * j + 2] = hi[0]; f[4 * j + 3] = hi[1]; }
}
__device__ __forceinline__ void wsc_item(const float* w_pq, const float* sub_keys, bf16_t* Wsc, LAS unsigned char* lds, int item, int tid) {
    const int hc = item >> 4, d0 = (item & 15) * 64;
    LAS float* kl = (LAS float*)lds; LAS float* wl = (LAS float*)(lds + 67584);
    for (int i = tid; i < 128 * 32; i += NTHREADS) { const int n = i >> 5, j4 = (i & 31) * 4; *(LAS f32x4*)(kl + n * 132 + j4) = *(const f32x4*)(sub_keys + ((size_t)hc * 128 + n) * 128 + j4); }
    for (int i = tid; i < 64 * 32; i += NTHREADS) { const int dd = i >> 5, j4 = (i & 31) * 4; *(LAS f32x4*)(wl + dd * 128 + j4) = *(const f32x4*)(w_pq + (size_t)(d0 + dd) * 2048 + hc * 128 + j4); }
    __syncthreads();
    const int n = tid & 127, dq = tid >> 7;
    float acc[16];
#pragma unroll
    for (int i = 0; i < 16; ++i) acc[i] = 0.f;
    for (int j4 = 0; j4 < 128; j4 += 4) {
        const f32x4 kv = *(const LAS f32x4*)(kl + n * 132 + j4);
#pragma unroll
        for (int i = 0; i < 16; ++i) { const f32x4 wv = *(const LAS f32x4*)(wl + (dq * 16 + i) * 128 + j4); acc[i] += kv[0] * wv[0] + kv[1] * wv[1] + kv[2] * wv[2] + kv[3] * wv[3]; }
    }
    u32x4 o0, o1;
    o0.x = pk2(acc[0], acc[1]); o0.y = pk2(acc[2], acc[3]); o0.z = pk2(acc[4], acc[5]); o0.w = pk2(acc[6], acc[7]);
    o1.x = pk2(acc[8], acc[9]); o1.y = pk2(acc[10], acc[11]); o1.z = pk2(acc[12], acc[13]); o1.w = pk2(acc[14], acc[15]);
    bf16_t* dst = Wsc + (size_t)(hc * 128 + n) * 1024 + d0 + dq * 16;
    *(u32x4*)dst = o0; *(u32x4*)(dst + 8) = o1;
    __syncthreads();
}

__device__ __forceinline__ void conv_phase(const bf16_t* Z, const bf16_t* BG, bf16_t* OUT, const float* conv_w, const float* conv_b, int gtid, int gthreads) {
    for (int it = gtid; it < (T / 16) * 128; it += gthreads) {
        const int rb = it >> 7, cc = it & 127, t0 = rb * 16, c0 = cc * 8;
        float w0[8], w1[8], w2[8], cb[8];
#pragma unroll
        for (int i = 0; i < 8; ++i) { w0[i] = conv_w[c0 + i]; w1[i] = conv_w[1024 + c0 + i]; w2[i] = conv_w[2048 + c0 + i]; cb[i] = conv_b[c0 + i]; }
        float zm2[8], zm1[8];
        if ((t0 & (SEQ - 1)) != 0) {
            const u32x4 a = *(const u32x4*)(Z + (size_t)(t0 - 2) * 1024 + c0), b = *(const u32x4*)(Z + (size_t)(t0 - 1) * 1024 + c0);
            zm2[0] = bflo(a.x); zm2[1] = bfhi(a.x); zm2[2] = bflo(a.y); zm2[3] = bfhi(a.y); zm2[4] = bflo(a.z); zm2[5] = bfhi(a.z); zm2[6] = bflo(a.w); zm2[7] = bfhi(a.w);
            zm1[0] = bflo(b.x); zm1[1] = bfhi(b.x); zm1[2] = bflo(b.y); zm1[3] = bfhi(b.y); zm1[4] = bflo(b.z); zm1[5] = bfhi(b.z); zm1[6] = bflo(b.w); zm1[7] = bfhi(b.w);
        } else {
#pragma unroll
            for (int i = 0; i < 8; ++i) { zm2[i] = 0.f; zm1[i] = 0.f; }
        }
#pragma unroll 4
        for (int r = 0; r < 16; ++r) {
            const size_t o = (size_t)(t0 + r) * 1024 + c0;
            const u32x4 a = *(const u32x4*)(Z + o), g = *(const u32x4*)(BG + o);
            float z[8], bgv[8], y[8];
            z[0] = bflo(a.x); z[1] = bfhi(a.x); z[2] = bflo(a.y); z[3] = bfhi(a.y); z[4] = bflo(a.z); z[5] = bfhi(a.z); z[6] = bflo(a.w); z[7] = bfhi(a.w);
            bgv[0] = bflo(g.x); bgv[1] = bfhi(g.x); bgv[2] = bflo(g.y); bgv[3] = bfhi(g.y); bgv[4] = bflo(g.z); bgv[5] = bfhi(g.z); bgv[6] = bflo(g.w); bgv[7] = bfhi(g.w);
#pragma unroll
            for (int i = 0; i < 8; ++i) { y[i] = bgv[i] * (cb[i] + w0[i] * zm2[i] + w1[i] * zm1[i] + w2[i] * z[i]); zm2[i] = zm1[i]; zm1[i] = z[i]; }
            u32x4 ov; ov.x = pk2(y[0], y[1]); ov.y = pk2(y[2], y[3]); ov.z = pk2(y[4], y[5]); ov.w = pk2(y[6], y[7]);
            *(u32x4*)(OUT + o) = ov;
        }
    }
}

namespace att {
constexpr int STAGE = 32768;
constexpr int XCH_OFF = 65536;
__device__ __forceinline__ int crow(int r, int hi) { return (r & 3) + 8 * (r >> 2) + 4 * hi; }
__device__ __forceinline__ s16x4 vtr(const LAS unsigned char* p) { return __builtin_bit_cast(s16x4, __builtin_amdgcn_ds_read_tr16_b64_v4i16((LAS s16x4*)p)); }

__device__ __forceinline__ void attn_unit(int b, int h, int qblk, const bf16_t* Q, const bf16_t* Kg, const bf16_t* Vg, bf16_t* O, const float* subln_g, float lam,
                                          LAS unsigned char* lds, int tid) {
    const int lane = tid & 63, wid = __builtin_amdgcn_readfirstlane(tid >> 6), rg = wid >> 1, c = wid & 1, r = lane & 31, hh = lane >> 5;
    const size_t seq0 = (size_t)b * SEQ;
    const int qs = qblk * 128 + rg * 32;
    bf16x8 qf[4];
    { const bf16_t* qp = Q + (seq0 + qs + r) * 1024 + h * 128 + c * 64 + 8 * hh;
#pragma unroll
      for (int ks = 0; ks < 4; ++ks) qf[ks] = *(const bf16x8*)(qp + 16 * ks); }
    const int kkey = tid >> 3, kch = tid & 7;
    const unsigned kdst = (unsigned)(kkey * 128 + ((kch ^ ((kkey >> 1) & 7)) * 16));
    const int v0key = tid >> 4, vch = tid & 15;
    const unsigned vdst0 = (unsigned)(v0key * 256 + (((vch >> 2) ^ (v0key & 3)) * 64) + (vch & 3) * 16);
    const unsigned vdst1 = vdst0 + 32 * 256;
    const bf16_t* kbase = Kg + seq0 * 1024 + h * 128 + kch * 8;
    const bf16_t* vbase = Vg + seq0 * 1024 + h * 128 + vch * 8;
    const int kswz = (r >> 1) & 7;
    unsigned koff[4];
#pragma unroll
    for (int ks = 0; ks < 4; ++ks) koff[ks] = (unsigned)(c * 8192 + r * 128 + (((ks * 2 + hh) ^ kswz) * 16));
    const int i16 = lane & 15, vq = i16 >> 2, vp = i16 & 3, g16 = (lane >> 4) & 1;
    unsigned voff[4];
#pragma unroll
    for (int dt = 0; dt < 4; ++dt) voff[dt] = (unsigned)(16384 + (4 * hh + vq) * 256 + ((dt ^ vq) * 64) + (16 * g16 + 4 * vp) * 2);

    f32x16 o[4];
#pragma unroll
    for (int dt = 0; dt < 4; ++dt)
#pragma unroll
        for (int i = 0; i < 16; ++i) o[dt][i] = 0.f;
    float mrun = -1e30f, lrun = 0.f;
    const int nt = 2 * qblk + 2;
    const int jmax = (qs + 31) >> 6;

    u32x4 pk0, pk1, pv0, pv1;
    { const size_t ro = (size_t)kkey * 1024; pk0 = *(const u32x4*)(kbase + ro); pk1 = *(const u32x4*)(kbase + ro + 64);
      pv0 = *(const u32x4*)(vbase + (size_t)v0key * 1024); pv1 = *(const u32x4*)(vbase + (size_t)(v0key + 32) * 1024); }
    *(LAS u32x4*)(lds + kdst) = pk0; *(LAS u32x4*)(lds + 8192 + kdst) = pk1; *(LAS u32x4*)(lds + 16384 + vdst0) = pv0; *(LAS u32x4*)(lds + 16384 + vdst1) = pv1;
    __syncthreads();
    for (int j = 0; j < nt; ++j) {
        const LAS unsigned char* st = lds + (j & 1) * STAGE;
        if (j + 1 < nt) { const size_t ro = (size_t)((j + 1) * 64 + kkey) * 1024; pk0 = *(const u32x4*)(kbase + ro); pk1 = *(const u32x4*)(kbase + ro + 64);
            pv0 = *(const u32x4*)(vbase + (size_t)((j + 1) * 64 + v0key) * 1024); pv1 = *(const u32x4*)(vbase + (size_t)((j + 1) * 64 + v0key + 32) * 1024); }
        if (j <= jmax) {
            f32x16 s0, s1;
#pragma unroll
            for (int i = 0; i < 16; ++i) { s0[i] = 0.f; s1[i] = 0.f; }
#pragma unroll
            for (int ks = 0; ks < 4; ++ks) {
                const bf16x8 ka = *(const LAS bf16x8*)(st + koff[ks]), kb = *(const LAS bf16x8*)(st + koff[ks] + 4096);
                s0 = __builtin_amdgcn_mfma_f32_32x32x16_bf16(ka, qf[ks], s0, 0, 0, 0);
                s1 = __builtin_amdgcn_mfma_f32_32x32x16_bf16(kb, qf[ks], s1, 0, 0, 0);
            }
            if (j * 64 + 63 > qs) {
                const int qrel = qs + r - j * 64;
#pragma unroll
                for (int i = 0; i < 16; ++i) { const int kv = crow(i, hh); if (kv > qrel) s0[i] = -INFINITY; if (kv + 32 > qrel) s1[i] = -INFINITY; }
            }
            float mx = fmaxf(s0[0], s1[0]);
#pragma unroll
            for (int i = 1; i < 16; ++i) mx = fmaxf(mx, fmaxf(s0[i], s1[i]));
            mx = fmaxf(mx, __shfl_xor(mx, 32));
            const float mnew = fmaxf(mrun, mx), al = exp2f(mrun - mnew);
            mrun = mnew;
            float ps = 0.f;
#pragma unroll
            for (int i = 0; i < 16; ++i) { s0[i] = exp2f(s0[i] - mnew); s1[i] = exp2f(s1[i] - mnew); ps += s0[i] + s1[i]; }
            lrun = lrun * al + ps;
#pragma unroll
            for (int dt = 0; dt < 4; ++dt)
#pragma unroll
                for (int i = 0; i < 16; ++i) o[dt][i] *= al;
            bf16x8 pf[4];
#pragma unroll
            for (int s = 0; s < 2; ++s) {
                u32x4 w0, w1;
                w0.x = pg8::cvt_pk_bf16(s0[8 * s + 0], s0[8 * s + 1]); w0.y = pg8::cvt_pk_bf16(s0[8 * s + 2], s0[8 * s + 3]); w0.z = pg8::cvt_pk_bf16(s0[8 * s + 4], s0[8 * s + 5]); w0.w = pg8::cvt_pk_bf16(s0[8 * s + 6], s0[8 * s + 7]);
                w1.x = pg8::cvt_pk_bf16(s1[8 * s + 0], s1[8 * s + 1]); w1.y = pg8::cvt_pk_bf16(s1[8 * s + 2], s1[8 * s + 3]); w1.z = pg8::cvt_pk_bf16(s1[8 * s + 4], s1[8 * s + 5]); w1.w = pg8::cvt_pk_bf16(s1[8 * s + 6], s1[8 * s + 7]);
                pf[s] = __builtin_bit_cast(bf16x8, w0); pf[2 + s] = __builtin_bit_cast(bf16x8, w1);
            }
#pragma unroll
            for (int dt = 0; dt < 4; ++dt) {
#pragma unroll
                for (int ks = 0; ks < 4; ++ks) {
                    const s16x4 lo = vtr(st + voff[dt] + ks * 16 * 256), hi = vtr(st + voff[dt] + ks * 16 * 256 + 8 * 256);
                    const bf16x8 va = (bf16x8){lo[0], lo[1], lo[2], lo[3], hi[0], hi[1], hi[2], hi[3]};
                    o[dt] = __builtin_amdgcn_mfma_f32_32x32x16_bf16(va, pf[ks], o[dt], 0, 0, 0);
                }
            }
        }
        if (j + 1 < nt) { LAS unsigned char* sn = lds + ((j + 1) & 1) * STAGE;
            *(LAS u32x4*)(sn + kdst) = pk0; *(LAS u32x4*)(sn + 8192 + kdst) = pk1; *(LAS u32x4*)(sn + 16384 + vdst0) = pv0; *(LAS u32x4*)(sn + 16384 + vdst1) = pv1; }
        __syncthreads();
    }
    const float ltot = lrun + __shfl_xor(lrun, 32);
    const float inv = (c == 0 ? 1.0f : lam) / ltot;
    LAS float* xch = (LAS float*)(lds + XCH_OFF) + rg * 4096 + lane;
    if (c == 1) {
#pragma unroll
        for (int dt = 0; dt < 4; ++dt)
#pragma unroll
            for (int i = 0; i < 16; ++i) xch[(dt * 16 + i) * 64] = o[dt][i] * inv;
    }
    __syncthreads();
    if (c == 0) {
        float ss = 0.f;
#pragma unroll
        for (int dt = 0; dt < 4; ++dt)
#pragma unroll
            for (int i = 0; i < 16; ++i) { const float v = o[dt][i] * inv - xch[(dt * 16 + i) * 64]; o[dt][i] = v; ss += v * v; }
        ss += __shfl_xor(ss, 32);
        const float rs = (1.0f - LAM_INIT) / sqrtf(ss * (1.0f / 128.0f) + LN_EPS);
        bf16_t* op = O + (seq0 + qs + r) * 1024 + h * 128 + 4 * hh;
#pragma unroll
        for (int dt = 0; dt < 4; ++dt)
#pragma unroll
            for (int g = 0; g < 4; ++g) { const int e = dt * 32 + 8 * g;
                const f32x4 gv = *(const f32x4*)(subln_g + e + 4 * hh);
                u32x2 w; w.x = pg8::cvt_pk_bf16(o[dt][4 * g] * rs * gv[0], o[dt][4 * g + 1] * rs * gv[1]); w.y = pg8::cvt_pk_bf16(o[dt][4 * g + 2] * rs * gv[2], o[dt][4 * g + 3] * rs * gv[3]);
                *(u32x2*)(op + e) = w; }
    }
    __syncthreads();
}
}

__device__ __forceinline__ void ln1_phase(const float* X, float* XO, bf16_t* XB, const float* g, const float* bta, int gw, int ngw, int lane) {
    f32x4 gv[4], bv[4];
#pragma unroll
    for (int j = 0; j < 4; ++j) { gv[j] = *(const f32x4*)(g + 4 * lane + 256 * j); bv[j] = *(const f32x4*)(bta + 4 * lane + 256 * j); }
    for (int m = gw; m < T; m += ngw) {
        const f32x4* xr = (const f32x4*)(X + (size_t)m * D) + lane; f32x4* xo = (f32x4*)(XO + (size_t)m * D) + lane;
        f32x4 v[4]; float s = 0.f;
#pragma unroll
        for (int j = 0; j < 4; ++j) { v[j] = xr[64 * j]; s += (v[j][0] + v[j][1]) + (v[j][2] + v[j][3]); }
        const float mean = wave_sum(s) * (1.f / D); float s2 = 0.f;
#pragma unroll
        for (int j = 0; j < 4; ++j) { v[j] = v[j] - mean; s2 += (v[j][0] * v[j][0] + v[j][1] * v[j][1]) + (v[j][2] * v[j][2] + v[j][3] * v[j][3]); }
        const float rstd = 1.f / sqrtf(wave_sum(s2) * (1.f / D) + LN_EPS);
        u32x2* o8 = (u32x2*)(XB + (size_t)m * D) + lane;
#pragma unroll
        for (int j = 0; j < 4; ++j) { const f32x4 y = v[j] * rstd * gv[j] + bv[j]; xo[64 * j] = y; u32x2 w; w.x = pk2(y[0], y[1]); w.y = pk2(y[2], y[3]); o8[64 * j] = w; }
    }
}

namespace peer {
template <int NV>
__device__ __forceinline__ void top16(const float (&v)[NV], LAS float* oval, LAS int* oidx, int lane) {
    float lmx = v[0], lmn = v[0];
#pragma unroll
    for (int q = 1; q < NV; ++q) { lmx = fmaxf(lmx, v[q]); lmn = fminf(lmn, v[q]); }
    float hi = wave_max(lmx), lo = wave_min(lmn);
    lo = lo - fabsf(lo) * 1e-6f - 1e-30f;
    float thr = hi; int need_ties = 1;
    for (int it = 0; it < 64; ++it) {
        const float mid = 0.5f * (lo + hi);
        if (!(mid > lo && mid < hi)) break;
        int cnt = 0;
#pragma unroll
        for (int q = 0; q < NV; ++q) cnt += __popcll(__ballot(v[q] > mid));
        if (cnt == 16) { thr = mid; need_ties = 0; break; }
        if (cnt > 16) lo = mid; else hi = mid;
    }
    const float tie_hi = hi;
    int base = 0;
    if (!need_ties) {
#pragma unroll
        for (int q = 0; q < NV; ++q) { const bool sel = v[q] > thr; const unsigned long long bm = __ballot(sel);
            const int pos = base + (int)__builtin_amdgcn_mbcnt_hi((unsigned)(bm >> 32), __builtin_amdgcn_mbcnt_lo((unsigned)bm, 0u));
            if (sel) { oval[pos] = v[q]; oidx[pos] = lane + 64 * q; }
            base += __popcll(bm); }
    } else {
#pragma unroll
        for (int q = 0; q < NV; ++q) { const bool sel = v[q] > tie_hi; const unsigned long long bm = __ballot(sel);
            const int pos = base + (int)__builtin_amdgcn_mbcnt_hi((unsigned)(bm >> 32), __builtin_amdgcn_mbcnt_lo((unsigned)bm, 0u));
            if (sel && pos < 16) { oval[pos] = v[q]; oidx[pos] = lane + 64 * q; }
            base += __popcll(bm); }
#pragma unroll
        for (int q = 0; q < NV; ++q) { const bool sel = (v[q] <= tie_hi) && (v[q] > lo); const unsigned long long bm = __ballot(sel);
            const int pos = base + (int)__builtin_amdgcn_mbcnt_hi((unsigned)(bm >> 32), __builtin_amdgcn_mbcnt_lo((unsigned)bm, 0u));
            if (sel && pos < 16) { oval[pos] = v[q]; oidx[pos] = lane + 64 * q; }
            base += __popcll(bm); }
    }
    LDS_WAIT();
}

__device__ __forceinline__ void retrieve(int t, const float* SC, LAS unsigned char* scr, LAS int* EI, LAS float* GW, int lane) {
    LAS float* s1v = (LAS float*)scr; LAS int* s1i = (LAS int*)(scr + 64); LAS float* s2v = (LAS float*)(scr + 128); LAS int* s2i = (LAS int*)(scr + 192);
    LAS float* cv = (LAS float*)(scr + 256); LAS int* ci = (LAS int*)(scr + 320);
    const float* sc = SC + (size_t)t * 2048;
#pragma unroll 1
    for (int h = 0; h < NHEAD; ++h) {
        float a[2], bq[2];
        a[0] = sc[h * 256 + lane]; a[1] = sc[h * 256 + 64 + lane]; bq[0] = sc[h * 256 + 128 + lane]; bq[1] = sc[h * 256 + 192 + lane];
        top16<2>(a, s1v, s1i, lane);
        top16<2>(bq, s2v, s2i, lane);
        float cand[4];
#pragma unroll
        for (int q = 0; q < 4; ++q) { const int idx = lane + 64 * q; cand[q] = s1v[idx >> 4] + s2v[idx & 15]; }
        top16<4>(cand, cv, ci, lane);
        {
            const float v = cv[lane & 15]; const int code = ci[lane & 15];
            float mx = v;
#pragma unroll
            for (int o = 1; o < 16; o <<= 1) mx = fmaxf(mx, __shfl_xor(mx, o));
            const float ex = __expf(v - mx); float sm = ex;
#pragma unroll
            for (int o = 1; o < 16; o <<= 1) sm += __shfl_xor(sm, o);
            const int k = h * 16 + lane, p = (k & 7) * 16 + (k >> 3);
            if (lane < 16) { GW[p] = ex / sm; EI[p] = s1i[code >> 4] * 128 + s2i[code & 15]; }
        }
        LDS_WAIT();
    }
}

__device__ __forceinline__ int okey(float f) { const int b = __float_as_int(f); return b ^ ((b >> 31) & 0x7fffffff); }
__device__ __forceinline__ float okey_inv(int k) { return __int_as_float(k ^ ((k >> 31) & 0x7fffffff)); }
__device__ __forceinline__ int med3i(int a, int b, int c) { int r; asm("v_med3_i32 %0, %1, %2, %3" : "=v"(r) : "v"(a), "v"(b), "v"(c)); return r; }
__device__ __forceinline__ void ins16(int (&t)[16], int x) {
#pragma unroll
    for (int i = 15; i >= 1; --i) t[i] = med3i(t[i], t[i - 1], x);
    t[0] = max(t[0], x);
}
__device__ __forceinline__ void retrieve4(int t0, int jb, const float* SC, LAS int* IDX, LAS int* EI, LAS float* GW, int lane) {
    const int tl = lane >> 4, h = (lane >> 1) & 7, cc = lane & 1;
    const f32x4* lp = (const f32x4*)(SC + (size_t)(t0 + tl) * 2048 + (h * 2 + cc) * 128);
    int t[16];
#pragma unroll
    for (int i = 0; i < 16; ++i) t[i] = (int)0x80000000;
#pragma unroll 2
    for (int q4 = 0; q4 < 32; q4 += 4) {
        f32x4 v[4];
#pragma unroll
        for (int q = 0; q < 4; ++q) v[q] = lp[q4 + q];
#pragma unroll
        for (int q = 0; q < 4; ++q)
#pragma unroll
            for (int e = 0; e < 4; ++e) ins16(t, (okey(v[q][e]) & ~127) | (127 - (4 * (q4 + q) + e)));
    }
    float val[16], pv[16];
    { u32x4 w;
#pragma unroll
      for (int q = 0; q < 4; ++q) {
#pragma unroll
          for (int e = 0; e < 4; ++e) { val[4 * q + e] = okey_inv(t[4 * q + e] & ~127); w[e] = (unsigned)(127 - (t[4 * q + e] & 127)); }
          *(LAS u32x4*)(IDX + lane * 16 + 4 * q) = w; } }
#pragma unroll
    for (int i = 0; i < 16; ++i) pv[i] = __shfl_xor(val[i], 1);
    float s1v[16], s2v[16];
#pragma unroll
    for (int i = 0; i < 16; ++i) { s1v[i] = cc ? pv[i] : val[i]; s2v[i] = cc ? val[i] : pv[i]; }
    int ct[16];
#pragma unroll
    for (int i = 0; i < 16; ++i) ct[i] = (int)0x80000000;
#pragma unroll
    for (int i = 0; i < 16; ++i)
#pragma unroll
        for (int j = 0; j < 16; ++j)
            if ((i + 1) * (j + 1) <= 16) ins16(ct, (okey(s1v[i] + s2v[j]) & ~255) | (255 - (i * 16 + j)));
    float ev[16]; float sm = 0.f; const float v0 = okey_inv(ct[0] & ~255);
#pragma unroll
    for (int r = 0; r < 16; ++r) { ev[r] = __expf(okey_inv(ct[r] & ~255) - v0); sm += ev[r]; }
    const float inv = 1.0f / sm;
    LDS_WAIT();
#pragma unroll
    for (int rr = 0; rr < 8; ++rr) {
        int ka = ct[rr], kb = ct[8 + rr]; float ga = ev[rr], gb = ev[8 + rr];
        asm volatile("" : "+v"(ka), "+v"(kb), "+v"(ga), "+v"(gb));
        const int key = cc ? kb : ka; const float gg = (cc ? gb : ga) * inv;
        const int code = 255 - (key & 255), i1 = IDX[(lane & ~1) * 16 + (code >> 4)], i2 = IDX[(lane | 1) * 16 + (code & 15)];
        const int k = h * 16 + 8 * cc + rr, p = (k & 7) * 16 + (k >> 3);
        EI[(jb + tl) * 128 + p] = i1 * 128 + i2; GW[(jb + tl) * 128 + p] = gg;
    }
    LDS_WAIT();
}

constexpr int TOK = 8;
constexpr int WAVE_LDS = 12288;
__device__ __forceinline__ void wave_tokens(int t0, const float* SC, float* X  , const unsigned char* UB, const unsigned char* VB, const float* USC, const float* VSC,
                                            const float* ln_g, const float* ln_b, LAS unsigned char* wl, int lane) {
    LAS int* EI = (LAS int*)wl; LAS float* GW = (LAS float*)(wl + 4096); LAS float* PD = (LAS float*)(wl + 8192);
    for (int rp = (PROBE_SUB == 1 ? 0 : 1); rp < 2; ++rp)
#pragma unroll 1
    for (int jb = 0; jb < TOK; jb += 4) retrieve4(t0 + jb, jb, SC, (LAS int*)(wl + 8192), EI, GW, lane);
    const int g = lane >> 3, c = lane & 7;
    const int b0 = lane & 1, b1 = (lane >> 1) & 1, b2 = (lane >> 2) & 1, b3 = (lane >> 3) & 1, b4 = (lane >> 4) & 1, b5 = (lane >> 5) & 1;
    for (int rp = (PROBE_SUB == 2 ? 0 : 1); rp < 2; ++rp) {
    LDS_WAIT();
    for (int i = lane; i < TOK * 128; i += 64) PD[i] = 0.f;
    LDS_WAIT();
#pragma unroll 1
    for (int s = 0; s < 8; ++s) {
#pragma unroll 1
        for (int j = 0; j < TOK; ++j) {
            float xs[16];
            { const f32x4* xp = (const f32x4*)(X + (size_t)(t0 + j) * D + 128 * s + 16 * c);
#pragma unroll
              for (int q = 0; q < 4; ++q) { const f32x4 v = xp[q]; xs[4 * q] = v[0]; xs[4 * q + 1] = v[1]; xs[4 * q + 2] = v[2]; xs[4 * q + 3] = v[3]; } }
            int ex[16];
#pragma unroll
            for (int q = 0; q < 4; ++q) { const u32x4 v = *(const LAS u32x4*)(EI + j * 128 + g * 16 + 4 * q); ex[4 * q] = (int)v[0]; ex[4 * q + 1] = (int)v[1]; ex[4 * q + 2] = (int)v[2]; ex[4 * q + 3] = (int)v[3]; }
            float sm[16];
#pragma unroll
            for (int hb = 0; hb < 2; ++hb) {
                u32x4 ra[8];
#pragma unroll
                for (int i = 0; i < 8; ++i) ra[i] = *(const u32x4*)(UB + (((unsigned)s * NEXP + (unsigned)ex[8 * hb + i]) * 128u + 16u * (unsigned)c));
#pragma unroll
                for (int i = 0; i < 8; ++i) { float f[16]; unpack16_fp8(ra[i], f); float d = 0.f;
#pragma unroll
                    for (int q = 0; q < 16; ++q) d += xs[q] * f[q];
                    sm[8 * hb + i] = d; }
                __builtin_amdgcn_sched_barrier(0);
            }
            float r8[8], r4[4], r2[2];
#pragma unroll
            for (int i = 0; i < 8; ++i) { const float mine = b2 ? sm[8 + i] : sm[i], oth = b2 ? sm[i] : sm[8 + i]; r8[i] = mine + __shfl_xor(oth, 4); }
#pragma unroll
            for (int i = 0; i < 4; ++i) { const float mine = b1 ? r8[4 + i] : r8[i], oth = b1 ? r8[i] : r8[4 + i]; r4[i] = mine + __shfl_xor(oth, 2); }
#pragma unroll
            for (int i = 0; i < 2; ++i) { const float mine = b0 ? r4[2 + i] : r4[i], oth = b0 ? r4[i] : r4[2 + i]; r2[i] = mine + __shfl_xor(oth, 1); }
            LAS float* pd = PD + j * 128 + 16 * c + g;
            pd[0] += r2[0]; pd[8] += r2[1];
        }
    }
    }
    LDS_WAIT();
#pragma unroll 1
    for (int j = 0; j < TOK; ++j) {
#pragma unroll
        for (int q = 0; q < 2; ++q) { const int k = lane + 64 * q, p = (k & 7) * 16 + (k >> 3); const int ei = EI[j * 128 + p];
            const float dot = PD[j * 128 + k] * USC[ei];
            const float act = 0.5f * dot * (1.0f + erff(dot * 0.70710678118654752f));
            GW[j * 128 + p] *= act * VSC[ei]; }
    }
    LDS_WAIT();
#pragma unroll 1
    for (int s = 0; s < 8; ++s) {
#pragma unroll 1
        for (int j = 0; j < TOK; ++j) {
            int ex[16]; float wk[16];
#pragma unroll
            for (int q = 0; q < 4; ++q) { const u32x4 v = *(const LAS u32x4*)(EI + j * 128 + g * 16 + 4 * q); ex[4 * q] = (int)v[0]; ex[4 * q + 1] = (int)v[1]; ex[4 * q + 2] = (int)v[2]; ex[4 * q + 3] = (int)v[3];
                const f32x4 w = *(const LAS f32x4*)(GW + j * 128 + g * 16 + 4 * q); wk[4 * q] = w[0]; wk[4 * q + 1] = w[1]; wk[4 * q + 2] = w[2]; wk[4 * q + 3] = w[3]; }
            float acc[16];
#pragma unroll
            for (int q = 0; q < 16; ++q) acc[q] = 0.f;
#pragma unroll
            for (int hb = 0; hb < 2; ++hb) {
                u32x4 ra[8];
#pragma unroll
                for (int i = 0; i < 8; ++i) ra[i] = *(const u32x4*)(VB + (((unsigned)s * NEXP + (unsigned)ex[8 * hb + i]) * 128u + 16u * (unsigned)c));
#pragma unroll
                for (int i = 0; i < 8; ++i) { float f[16]; unpack16_fp8(ra[i], f);
#pragma unroll
                    for (int q = 0; q < 16; ++q) acc[q] += wk[8 * hb + i] * f[q]; }
                __builtin_amdgcn_sched_barrier(0);
            }
            float r8[8], r4[4], r2[2];
#pragma unroll
            for (int i = 0; i < 8; ++i) { const float mine = b5 ? acc[8 + i] : acc[i], oth = b5 ? acc[i] : acc[8 + i]; r8[i] = mine + __shfl_xor(oth, 32); }
#pragma unroll
            for (int i = 0; i < 4; ++i) { const float mine = b4 ? r8[4 + i] : r8[i], oth = b4 ? r8[i] : r8[4 + i]; r4[i] = mine + __shfl_xor(oth, 16); }
#pragma unroll
            for (int i = 0; i < 2; ++i) { const float mine = b3 ? r4[2 + i] : r4[i], oth = b3 ? r4[i] : r4[2 + i]; r2[i] = mine + __shfl_xor(oth, 8); }
            f32x2* xp = (f32x2*)(X + (size_t)(t0 + j) * D + 128 * s + 16 * c + 2 * g);
            const f32x2 xv = *xp; f32x2 o; o[0] = ALPHA * xv[0] + r2[0]; o[1] = ALPHA * xv[1] + r2[1];
            *xp = o;
        }
    }
    asm volatile("s_waitcnt vmcnt(0)" ::: "memory");
#pragma unroll 1
    for (int j = 0; j < TOK; ++j) {
        f32x4* xp = (f32x4*)(X + (size_t)(t0 + j) * D) + 4 * lane;
        f32x4 v[4]; float sum = 0.f;
#pragma unroll
        for (int q = 0; q < 4; ++q) { v[q] = xp[q]; sum += (v[q][0] + v[q][1]) + (v[q][2] + v[q][3]); }
        const float mean = wave_sum(sum) * (1.f / D); float s2 = 0.f;
#pragma unroll
        for (int q = 0; q < 4; ++q) { v[q] = v[q] - mean; s2 += (v[q][0] * v[q][0] + v[q][1] * v[q][1]) + (v[q][2] * v[q][2] + v[q][3] * v[q][3]); }
        const float rstd = 1.f / sqrtf(wave_sum(s2) * (1.f / D) + LN_EPS);
        const f32x4* gp = (const f32x4*)ln_g + 4 * lane; const f32x4* bp = (const f32x4*)ln_b + 4 * lane;
#pragma unroll
        for (int q = 0; q < 4; ++q) xp[q] = v[q] * rstd * gp[q] + bp[q];
    }
}
}

#define GAS __attribute__((address_space(1)))
typedef GAS unsigned gu32;
#define XB_TMO      128
#define XB_XCNT(j)  (256  + 64 * (j))
#define XB_XSUB(j)  (1280 + 64 * (j))
#define XB_XGEN(j)  (2304 + 64 * (j))
#define XB_TOP      3328
#define XB_TOPGEN   3392
#define XCD_BAR_WORDS 3456
#define XB_SPIN_CAP (1u << 18)

__device__ __forceinline__ unsigned xb_ld(unsigned* p)              { return __hip_atomic_load(p, __ATOMIC_RELAXED, __HIP_MEMORY_SCOPE_AGENT); }
__device__ __forceinline__ unsigned xb_add(unsigned* p, unsigned v) { return __hip_atomic_fetch_add(p, v, __ATOMIC_RELAXED, __HIP_MEMORY_SCOPE_AGENT); }
__device__ __forceinline__ unsigned xb_xcc_id() { return (unsigned)__builtin_amdgcn_s_getreg((3 << 11) | 20) & 0xFu; }
#define XB_SPIN(cond, bar) do { unsigned _sp = 0; while (cond) { __builtin_amdgcn_s_sleep(1); \
    if ((++_sp & 255u) == 0u) { if (xb_ld(&(bar)[XB_TMO])) break; if (_sp > XB_SPIN_CAP) { atomicAdd(&(bar)[XB_TMO], 1u); break; } } } } while (0)

struct XcdBarrier {
    unsigned* bar; unsigned x;
    volatile LAS unsigned* st;
};

__device__ __forceinline__ XcdBarrier xcd_barrier_post(unsigned* bar, volatile LAS unsigned* st) {
    XcdBarrier b; b.bar = bar; b.x = xb_xcc_id(); b.st = st;
    if (threadIdx.x == 0) (void)xb_add(&bar[XB_XCNT(b.x)], 1u);
    return b;
}
__device__ __forceinline__ void xcd_barrier_complete(unsigned* bar, unsigned x, unsigned& nloc, unsigned& nx) {
    const unsigned G = gridDim.x * gridDim.y * gridDim.z;
    unsigned sum, cnt, mine, sp = 0u;
    for (;;) {
        sum = 0u; cnt = 0u; mine = 0u;
#pragma unroll
        for (unsigned j = 0; j < 16; ++j) { const unsigned c = xb_ld(&bar[XB_XCNT(j)]); sum += c; cnt += (c > 0u) ? 1u : 0u; mine = (j == x) ? c : mine; }
        if (sum == G) break;
        __builtin_amdgcn_s_sleep(1);
        if ((++sp & 255u) == 0u) { if (xb_ld(&bar[XB_TMO])) break; if (sp > XB_SPIN_CAP) { atomicAdd(&bar[XB_TMO], 1u); break; } }
    }
    nloc = mine > 0u ? mine : 1u; nx = cnt > 0u ? cnt : 1u;
}

__device__ __forceinline__ void xcd_barrier(const XcdBarrier& b) {
    asm volatile("s_waitcnt vmcnt(0)" ::: "memory");
    __syncthreads();
    if (threadIdx.x == 0) {
        unsigned* bar = b.bar;
        __builtin_amdgcn_s_waitcnt(0);
        unsigned nloc = b.st[0], nx = b.st[1];
        if (nloc == 0u) { xcd_barrier_complete(bar, b.x, nloc, nx); b.st[0] = nloc; b.st[1] = nx; }
        const unsigned old = xb_add(&bar[XB_XSUB(b.x)], 1u);
        const unsigned gen = old / nloc;
        if (old + 1u == (gen + 1u) * nloc) {
            __builtin_amdgcn_fence(__ATOMIC_RELEASE, "agent");
            asm volatile("s_waitcnt vmcnt(0)" ::: "memory");
            const unsigned og = xb_add(&bar[XB_TOP], 1u);
            const unsigned tg = og / nx;
            if (og + 1u == (tg + 1u) * nx) xb_add(&bar[XB_TOPGEN], 1u);
            else XB_SPIN(xb_ld(&bar[XB_TOPGEN]) == tg, bar);
            __builtin_amdgcn_fence(__ATOMIC_ACQUIRE, "agent");
            xb_add(&bar[XB_XGEN(b.x)], 1u);
            asm volatile("s_waitcnt vmcnt(0)" ::: "memory");
        } else {
            XB_SPIN(xb_ld(&bar[XB_XGEN(b.x)]) == gen, bar);
            __builtin_amdgcn_fence(__ATOMIC_ACQUIRE, "agent");
            asm volatile("s_waitcnt vmcnt(0)" ::: "memory");
        }
    }
    __syncthreads();
}

struct Args {
    const float *x; const int* positions; const float *w_in, *conv_w, *conv_b, *gate_b, *lq1, *lk1, *lq2, *lk2, *subln_g, *w_conv_out, *w_attn_out, *w_o, *ln1_g, *ln1_b, *w_pq, *sub_keys, *u_tab, *v_tab, *ln2_g, *ln2_b;
    float* out; unsigned char* ws; int ph_lo, ph_hi;
};

__global__ void __launch_bounds__(NTHREADS, 2) fwd_kernel(Args a) {
    extern __shared__ __attribute__((aligned(16))) unsigned char lds_raw[];
    LAS unsigned char* lds = (LAS unsigned char*)lds_raw;
    const int tid = threadIdx.x, lane = tid & 63, wave = __builtin_amdgcn_readfirstlane(tid >> 6);
    const int G = gridDim.x, bx = blockIdx.x;
    const int gw = bx * NWAVES + wave, ngw = G * NWAVES, gtid = bx * NTHREADS + tid, gthreads = G * NTHREADS;
    unsigned char* ws = a.ws;
    bf16_t* Wt_in = (bf16_t*)(ws + WS_WIN); bf16_t* Wt_co = (bf16_t*)(ws + WS_WCO); bf16_t* Wt_ao = (bf16_t*)(ws + WS_WAO); bf16_t* Wt_o = (bf16_t*)(ws + WS_WO); bf16_t* Wt_sc = (bf16_t*)(ws + WS_WSC);
    float* CS = (float*)(ws + WS_CS);
    bf16_t* XB = (bf16_t*)(ws + WS_XB); bf16_t* Zb = (bf16_t*)(ws + WS_Z); bf16_t* BG = (bf16_t*)(ws + WS_BG); bf16_t* Qb = (bf16_t*)(ws + WS_Q); bf16_t* Kb = (bf16_t*)(ws + WS_K); bf16_t* Vb = (bf16_t*)(ws + WS_V);
    bf16_t* Gb = (bf16_t*)a.out;
    unsigned char* UB = ws + WS_UB; unsigned char* VB = ws + WS_VB; float* USC = (float*)(ws + WS_USC); float* VSC = (float*)(ws + WS_VSC); bf16_t* T1 = (bf16_t*)(ws + WS_T1); bf16_t* MG = (bf16_t*)(ws + WS_MG);
    bf16_t* X1B = (bf16_t*)(ws + WS_X1B); float* SC = (float*)(ws + WS_SC);
    const int lo = a.ph_lo, hi = a.ph_hi;
    for (int u = tid; u < (LDS_BYTES - LDSCTL_OFF) / 4; u += NTHREADS) ((LAS unsigned*)(lds + LDSCTL_OFF))[u] = 0u;
    __syncthreads();
    XcdBarrier bar; bar.bar = (unsigned*)(ws + WS_CTL) + CW_BAR; bar.x = 0; bar.st = nullptr;
    if (MK_N_LAUNCHES == 1) bar = xcd_barrier_post((unsigned*)(ws + WS_CTL) + CW_BAR, (volatile LAS unsigned*)(lds + MISC_OFF) + 8);
#define IN(k) (lo <= (k) && (k) < hi)
#define REPS(k) for (int rep = (PROBE_REP == (k) ? 0 : 1); rep < 2; ++rep)
#define SEAM(k) do { if (IN(k) && IN((k) + 1)) xcd_barrier(bar); } while (0)

    if (IN(0)) REPS(0) {
        for (int it = bx; it < 256; it += G) wsc_item(a.w_pq, a.sub_keys, Wt_sc, lds, it, tid);
        LAS float* scr = (LAS float*)(lds + wave * 16384);
        constexpr int I_IN = (D / 64) * (NIN / 32), I_SQ = (D / 64) * (D / 32);
        for (int it = gw; it < I_IN + 3 * I_SQ; it += ngw) {
            int r = it;
            if (r < I_IN) { transpose_item<true>(a.w_in, D, NIN, Wt_in, scr, r, lane); continue; } r -= I_IN;
            if (r < I_SQ) { transpose_item<false>(a.w_conv_out, D, D, Wt_co, scr, r, lane); continue; } r -= I_SQ;
            if (r < I_SQ) { transpose_item<false>(a.w_attn_out, D, D, Wt_ao, scr, r, lane); continue; } r -= I_SQ;
            transpose_item<false>(a.w_o, D, D, Wt_o, scr, r, lane);
        }
        cvt_bf16(a.x, XB, (size_t)T * D, gtid, gthreads);
        for (int i = gtid; i < T * 8; i += gthreads) { const int t = i >> 3, f = i & 7;
            const float inv_freq = powf(500000.0f, -(float)f * 0.125f); const float ang = (float)a.positions[t] * inv_freq;
            CS[t * 16 + f] = cosf(ang); CS[t * 16 + 8 + f] = sinf(ang); }
    }
    SEAM(0);
    if (IN(1)) REPS(1) {
        pg8::Gemm g{XB, Wt_in, T, NIN, D}; pg8::StaticOrder S; S.init(T, NIN, G, bx);
        pg8::EpiProj E{Zb, BG, Qb, Kb, Vb, Gb, a.gate_b, CS};
        pg8::gemm_phase<pg8::EpiProj, pg8::StaticOrder, true, true>(lds, g, S, E);
    }
    SEAM(1);
    if (IN(2)) REPS(2) {
        bf16_t* Oatt = rep ? Qb : (bf16_t*)(ws + 12 * MiB);
        conv_phase(Zb, BG, rep ? BG : (bf16_t*)(ws + 28 * MiB), a.conv_w, a.conv_b, gtid, gthreads);
        float lam;
        { const float p1 = wave_sum(a.lq1[lane] * a.lk1[lane]), p2 = wave_sum(a.lq2[lane] * a.lk2[lane]); lam = __expf(p1) - __expf(p2) + LAM_INIT; }
        for (int it = bx; it < 512; it += G) {
            const int bh = it >> 3, pq = it & 7, b = bh >> 3, h = bh & 7;
            att::attn_unit(b, h, 15 - pq, Qb, Kb, Vb, Oatt, a.subln_g, lam, lds, tid);
            att::attn_unit(b, h, pq, Qb, Kb, Vb, Oatt, a.subln_g, lam, lds, tid);
        }
    }
    SEAM(2);
    if (IN(3)) REPS(3) {
        cvt_fp8_rows(a.u_tab, UB, USC, NEXP, gw, ngw, lane);
        cvt_fp8_rows(a.v_tab, VB, VSC, NEXP, gw, ngw, lane);
        pg8::Gemm g{BG, Wt_co, T, D, D}; pg8::StaticOrder S; S.init(T, D, G, bx);
        pg8::EpiGate1 E{Gb, T1};
        pg8::gemm_phase<pg8::EpiGate1, pg8::StaticOrder, true, true>(lds, g, S, E);
    }
    SEAM(3);
    if (IN(4)) REPS(4) {
        pg8::Gemm g{Qb, Wt_ao, T, D, D}; pg8::StaticOrder S; S.init(T, D, G, bx);
        pg8::EpiGate2 E{Gb, T1, MG};
        pg8::gemm_phase<pg8::EpiGate2, pg8::StaticOrder, true, true>(lds, g, S, E);
    }
    SEAM(4);
    if (IN(5)) REPS(5) {
        pg8::Gemm g{MG, Wt_o, T, D, D}; pg8::StaticOrder S; S.init(T, D, G, bx);
        pg8::EpiF32<true, 1024> E{a.x, a.out};
        pg8::gemm_phase<pg8::EpiF32<true, 1024>, pg8::StaticOrder, true, true>(lds, g, S, E);
    }
    SEAM(5);
    if (IN(6)) REPS(6) ln1_phase(a.out, rep ? a.out : (float*)(ws + 124 * MiB), X1B, a.ln1_g, a.ln1_b, gw, ngw, lane);
    SEAM(6);
    if (IN(7)) REPS(7) {
        pg8::Gemm g{X1B, Wt_sc, T, 2048, D}; pg8::StaticOrder S; S.init(T, 2048, G, bx);
        pg8::EpiF32<false, 2048> E{nullptr, SC};
        pg8::gemm_phase<pg8::EpiF32<false, 2048>, pg8::StaticOrder, true, true>(lds, g, S, E);
    }
    SEAM(7);
    if (IN(8)) REPS(8) {
        LAS unsigned char* wl = lds + wave * peer::WAVE_LDS;
        for (int t0 = gw * peer::TOK; t0 < T; t0 += ngw * peer::TOK) peer::wave_tokens(t0, SC, a.out, UB, VB, USC, VSC, a.ln2_g, a.ln2_b, wl, lane);
    }
#undef IN
#undef SEAM
}

extern "C" void kernel_launch(void* const* d_in, const int* in_sizes, int n_in, void* d_out, int out_size, void* d_ws, size_t ws_size, hipStream_t stream) {
    static int grid = 0;
    if (grid == 0) {
        if (n_in != 22 || out_size != T * D || ws_size < WS_END) { fprintf(stderr, "kernel_launch: unexpected shapes (n_in %d, out %d, ws %zu); nothing launched\n", n_in, out_size, ws_size); grid = -1; return; }
        int dev = 0, cus = 0, per_cu = 0;
        if (hipGetDevice(&dev) != hipSuccess || hipDeviceGetAttribute(&cus, hipDeviceAttributeMultiprocessorCount, dev) != hipSuccess) { grid = -1; return; }
        if (hipFuncSetAttribute((const void*)fwd_kernel, hipFuncAttributeMaxDynamicSharedMemorySize, LDS_BYTES) != hipSuccess) { fprintf(stderr, "kernel_launch: hipFuncSetAttribute failed\n"); grid = -1; return; }
        if (hipOccupancyMaxActiveBlocksPerMultiprocessor(&per_cu, (const void*)fwd_kernel, NTHREADS, LDS_BYTES) != hipSuccess || per_cu < 1) { fprintf(stderr, "kernel_launch: occupancy query failed (%d)\n", per_cu); (void)hipGetLastError(); per_cu = 1; }
        grid = cus * per_cu;
    }
    if (grid < 0) return;
    if (hipMemsetAsync((char*)d_ws + WS_CTL, 0, CTL_ZERO_BYTES, stream) != hipSuccess) { fprintf(stderr, "kernel_launch: hipMemsetAsync failed\n"); return; }
    Args a{};
    a.x = (const float*)d_in[0]; a.positions = (const int*)d_in[1]; a.w_in = (const float*)d_in[2]; a.conv_w = (const float*)d_in[3]; a.conv_b = (const float*)d_in[4]; a.gate_b = (const float*)d_in[5];
    a.lq1 = (const float*)d_in[6]; a.lk1 = (const float*)d_in[7]; a.lq2 = (const float*)d_in[8]; a.lk2 = (const float*)d_in[9]; a.subln_g = (const float*)d_in[10];
    a.w_conv_out = (const float*)d_in[11]; a.w_attn_out = (const float*)d_in[12]; a.w_o = (const float*)d_in[13]; a.ln1_g = (const float*)d_in[14]; a.ln1_b = (const float*)d_in[15];
    a.w_pq = (const float*)d_in[16]; a.sub_keys = (const float*)d_in[17]; a.u_tab = (const float*)d_in[18]; a.v_tab = (const float*)d_in[19]; a.ln2_g = (const float*)d_in[20]; a.ln2_b = (const float*)d_in[21];
    a.out = (float*)d_out; a.ws = (unsigned char*)d_ws;
#if MK_N_LAUNCHES == 1
    a.ph_lo = 0; a.ph_hi = NPHASES;
    void* args[] = {&a};
    hipError_t e = hipLaunchCooperativeKernel((const void*)fwd_kernel, dim3(grid), dim3(NTHREADS), args, LDS_BYTES, stream);
    if (e != hipSuccess) fprintf(stderr, "kernel_launch: cooperative launch failed: %s (grid %d)\n", hipGetErrorString(e), grid);
#else
    for (int p = 0; p < NPHASES; ++p) { a.ph_lo = p; a.ph_hi = p + 1; hipLaunchKernelGGL(fwd_kernel, dim3(grid), dim3(NTHREADS), LDS_BYTES, stream, a); }
#endif
}
```

```cpp
#include <hip/hip_runtime.h>
#include <hip/hip_cooperative_groups.h>
#include <cstdio>
#include <cstdint>
namespace cg = cooperative_groups;
namespace pg8 {
#define PG8_LAS __attribute__((address_space(3)))
typedef unsigned short bf16_t;
typedef short bf16x8 __attribute__((ext_vector_type(8)));
typedef float f32x4 __attribute__((ext_vector_type(4)));
typedef unsigned u32x4 __attribute__((ext_vector_type(4)));
constexpr int BM = 256, BK = 64, HALF = 128, HTB = HALF * BK * 2  , STAGE_BYTES = 8 * HTB, NXCD = 8, WGM = 8;

__host__ __device__ __forceinline__ int lds_byte(int r, int c) { const int st = (r >> 4) * 2 + (c >> 5), rr = r & 15, cc = c & 31, ob = rr * 64 + cc * 2; return st * 1024 + (ob ^ (((ob >> 9) & 1) << 5)); }
__host__ __device__ __forceinline__ void stage_rc(int b, int& R, int& C) { const int st = b / 1024, sb = b % 1024, swz = sb ^ (((sb >> 9) & 1) << 5); R = (st >> 1) * 16 + swz / 64; C = (st & 1) * 32 + (swz % 64) / 2; }
__host__ __device__ __forceinline__ int perm32(int rho) { const int n = rho >> 4, i = rho & 15; return 8 * (i >> 2) + 4 * n + (i & 3); }

struct Unit { int pm, pn; };
struct Gemm { const bf16_t* A; const bf16_t* Bt; int M, N, K; };

struct StaticOrder {
    int nM, nN, nwg, G, c;
    __host__ __device__ void init(int M, int N, int G_, int c_) { nM = M / BM; nN = N / BM; nwg = nM * nN; G = G_; c = c_; }
    __host__ __device__ bool next(int i, Unit& u) const {
        const long L = (long)i * G + c; if (L >= nwg) return false;
        int wgid = (int)L; { const int q = nwg / NXCD, r = nwg % NXCD, xcd = wgid % NXCD, off = wgid / NXCD; wgid = (xcd < r ? xcd * (q + 1) : r * (q + 1) + (xcd - r) * q) + off; }
        const int nig = WGM * nN, gid = wgid / nig, fm = gid * WGM, gsz = (nM - fm) < WGM ? (nM - fm) : WGM;
        u.pm = fm + ((wgid % nig) % gsz); u.pn = (wgid % nig) / gsz; return true;
    }
    __device__ __forceinline__ void a_ready(const Unit&) const {}
    __device__ __forceinline__ void done(const Unit&) const {}
};


__device__ __forceinline__ unsigned cvt_pk_bf16(float lo, float hi) { unsigned r; asm volatile("v_cvt_pk_bf16_f32 %0, %1, %2" : "=v"(r) : "v"(lo), "v"(hi)); return r; }
__device__ __forceinline__ void store8(bf16_t* p, f32x4 v0, f32x4 v1) {
    u32x4 w; w.x = cvt_pk_bf16(v0[0], v0[1]); w.y = cvt_pk_bf16(v0[2], v0[3]); w.z = cvt_pk_bf16(v1[0], v1[1]); w.w = cvt_pk_bf16(v1[2], v1[3]);
    *(u32x4*)p = w;
}
__device__ __forceinline__ void load8(const bf16_t* p, f32x4& v0, f32x4& v1) {
    const u32x4 w = *(const u32x4*)p;
    v0[0] = __uint_as_float(w.x << 16); v0[1] = __uint_as_float(w.x & 0xffff0000u); v0[2] = __uint_as_float(w.y << 16); v0[3] = __uint_as_float(w.y & 0xffff0000u);
    v1[0] = __uint_as_float(w.z << 16); v1[1] = __uint_as_float(w.z & 0xffff0000u); v1[2] = __uint_as_float(w.w << 16); v1[3] = __uint_as_float(w.w & 0xffff0000u);
}
constexpr float QSCALE = 0.125f * 1.4426950408889634f;

struct EpiProj {
    static constexpr bool PERM = true, AFTER_DRAIN = false;
    bf16_t *Z, *BG, *Q, *Kk, *V, *G; const float* gate_b; const float* CS;
    __device__ __forceinline__ void operator()(const f32x4 (&acc)[2][2][4][2], const Unit& u, int wr, int wc, int fr, int fq) const {
        const int row0 = u.pm * BM + wr * 64 + fr, pn = u.pn, cw = wc * 32 + 8 * fq;
        if (pn < 8) {
#pragma unroll
            for (int ai = 0; ai < 2; ++ai)
#pragma unroll
                for (int m = 0; m < 4; ++m) { const size_t row = row0 + ai * HALF + m * 16;
                    store8(Z + row * 1024 + pn * 128 + cw, acc[ai][0][m][0] * acc[ai][1][m][0], acc[ai][0][m][1] * acc[ai][1][m][1]); }
        } else if (pn < 12) {
#pragma unroll
            for (int ai = 0; ai < 2; ++ai)
#pragma unroll
                for (int m = 0; m < 4; ++m) { const size_t row = row0 + ai * HALF + m * 16;
#pragma unroll
                    for (int bj = 0; bj < 2; ++bj) store8(BG + row * 1024 + (pn - 8) * 256 + bj * HALF + cw, acc[ai][bj][m][0], acc[ai][bj][m][1]); }
        } else if (pn < 20) {
            const bool isq = pn < 16; bf16_t* dst = isq ? Q : Kk; const int cb = ((pn - 12) & 3) * 256; const float sc = isq ? QSCALE : 1.0f;
            const bool rot = ((wc & 1) == 0) && (fq < 2);
#pragma unroll
            for (int ai = 0; ai < 2; ++ai)
#pragma unroll
                for (int m = 0; m < 4; ++m) { const size_t row = row0 + ai * HALF + m * 16;
                    f32x4 c4 = *(const f32x4*)(CS + row * 16 + 4 * (fq & 1)), s4 = *(const f32x4*)(CS + row * 16 + 8 + 4 * (fq & 1));
                    if (!rot) { c4 = (f32x4){1.f, 1.f, 1.f, 1.f}; s4 = (f32x4){0.f, 0.f, 0.f, 0.f}; }
#pragma unroll
                    for (int bj = 0; bj < 2; ++bj) { const f32x4 v0 = acc[ai][bj][m][0], v1 = acc[ai][bj][m][1]; f32x4 o0, o1;
                        o0[0] = v0[0] * c4[0] - v0[1] * s4[0]; o0[1] = v0[1] * c4[0] + v0[0] * s4[0];
                        o0[2] = v0[2] * c4[1] - v0[3] * s4[1]; o0[3] = v0[3] * c4[1] + v0[2] * s4[1];
                        o1[0] = v1[0] * c4[2] - v1[1] * s4[2]; o1[1] = v1[1] * c4[2] + v1[0] * s4[2];
                        o1[2] = v1[2] * c4[3] - v1[3] * s4[3]; o1[3] = v1[3] * c4[3] + v1[2] * s4[3];
                        store8(dst + row * 1024 + cb + bj * HALF + cw, o0 * sc, o1 * sc); } }
        } else if (pn < 24) {
#pragma unroll
            for (int ai = 0; ai < 2; ++ai)
#pragma unroll
                for (int m = 0; m < 4; ++m) { const size_t row = row0 + ai * HALF + m * 16;
#pragma unroll
                    for (int bj = 0; bj < 2; ++bj) store8(V + row * 1024 + (pn - 20) * 256 + bj * HALF + cw, acc[ai][bj][m][0], acc[ai][bj][m][1]); }
        } else {
            f32x4 bv[2][2];
#pragma unroll
            for (int bj = 0; bj < 2; ++bj)
#pragma unroll
                for (int n = 0; n < 2; ++n) bv[bj][n] = *(const f32x4*)(gate_b + (pn - 24) * 256 + bj * HALF + cw + 4 * n);
#pragma unroll
            for (int ai = 0; ai < 2; ++ai)
#pragma unroll
                for (int m = 0; m < 4; ++m) { const size_t row = row0 + ai * HALF + m * 16;
#pragma unroll
                    for (int bj = 0; bj < 2; ++bj) { f32x4 g0 = acc[ai][bj][m][0] + bv[bj][0], g1 = acc[ai][bj][m][1] + bv[bj][1];
#pragma unroll
                        for (int i = 0; i < 4; ++i) { g0[i] = 1.0f / (1.0f + __expf(-g0[i])); g1[i] = 1.0f / (1.0f + __expf(-g1[i])); }
                        store8(G + row * 2048 + (pn - 24) * 256 + bj * HALF + cw, g0, g1); } }
        }
    }
};
struct EpiGate1 {
    static constexpr bool PERM = true, AFTER_DRAIN = false;
    const bf16_t* G; bf16_t* T1;
    __device__ __forceinline__ void operator()(const f32x4 (&acc)[2][2][4][2], const Unit& u, int wr, int wc, int fr, int fq) const {
        const int row0 = u.pm * BM + wr * 64 + fr, col0 = u.pn * BM + wc * 32 + 8 * fq;
#pragma unroll
        for (int ai = 0; ai < 2; ++ai)
#pragma unroll
            for (int m = 0; m < 4; ++m) { const size_t row = row0 + ai * HALF + m * 16;
#pragma unroll
                for (int bj = 0; bj < 2; ++bj) { f32x4 g0, g1; load8(G + row * 2048 + col0 + bj * HALF, g0, g1);
                    store8(T1 + row * 1024 + col0 + bj * HALF, acc[ai][bj][m][0] * g0, acc[ai][bj][m][1] * g1); } }
    }
};
struct EpiGate2 {
    static constexpr bool PERM = true, AFTER_DRAIN = false;
    const bf16_t* G; const bf16_t* T1; bf16_t* MG;
    __device__ __forceinline__ void operator()(const f32x4 (&acc)[2][2][4][2], const Unit& u, int wr, int wc, int fr, int fq) const {
        const int row0 = u.pm * BM + wr * 64 + fr, col0 = u.pn * BM + wc * 32 + 8 * fq;
#pragma unroll
        for (int ai = 0; ai < 2; ++ai)
#pragma unroll
            for (int m = 0; m < 4; ++m) { const size_t row = row0 + ai * HALF + m * 16;
#pragma unroll
                for (int bj = 0; bj < 2; ++bj) { f32x4 g0, g1, t0, t1; load8(G + row * 2048 + 1024 + col0 + bj * HALF, g0, g1); load8(T1 + row * 1024 + col0 + bj * HALF, t0, t1);
                    store8(MG + row * 1024 + col0 + bj * HALF, t0 + acc[ai][bj][m][0] * g0, t1 + acc[ai][bj][m][1] * g1); } }
    }
};
template <bool HAS_BASE, int ldc> struct EpiF32 {
    static constexpr bool PERM = false, AFTER_DRAIN = false;
    static constexpr float alpha = 1.189207115002721f;
    const float* base; float* O;
    __device__ __forceinline__ void operator()(const f32x4 (&acc)[2][2][4][2], const Unit& u, int wr, int wc, int fr, int fq) const {
        const int row0 = u.pm * BM + wr * 64 + fr, col0 = u.pn * BM + wc * 32 + 4 * fq;
#pragma unroll
        for (int ai = 0; ai < 2; ++ai)
#pragma unroll
            for (int m = 0; m < 4; ++m) { const size_t row = row0 + ai * HALF + m * 16;
#pragma unroll
                for (int bj = 0; bj < 2; ++bj)
#pragma unroll
                    for (int n = 0; n < 2; ++n) { const size_t o = row * ldc + col0 + bj * HALF + n * 16; f32x4 v = acc[ai][bj][m][n];
                        if constexpr (HAS_BASE) v = v + alpha * *(const f32x4*)(base + o);
                        *(f32x4*)(O + o) = v; } }
    }
};

template <class Epi, class Sched, bool ALIGN_EPI = false, bool SP2 = false>
__device__ __forceinline__ void gemm_phase(PG8_LAS unsigned char* lds, const Gemm g, const Sched& S, const Epi& E) {
    const int tid = threadIdx.x, wid = __builtin_amdgcn_readfirstlane(tid >> 6), lane = tid & 63, wr = wid >> 2, wc = wid & 3, fr = lane & 15, fq = lane >> 4;
    const int K = g.K, nt = K / BK;
    unsigned voffA[2], voffB[2];
#pragma unroll
    for (int i = 0; i < 2; ++i) { int R, C; stage_rc(tid * 16 + i * 8192, R, C); const int Rb = Epi::PERM ? ((R & ~31) + perm32(R & 31)) : R;
        voffA[i] = (unsigned)(R * K + C) * 2u; voffB[i] = (unsigned)(Rb * K + C) * 2u; }
    const size_t kstep = (size_t)(BK * 2);
    const size_t hstep = (size_t)HALF * K * 2;
    const size_t tstep = 2 * hstep;
    const unsigned ldsw = (unsigned)wid * 1024u;
    const int aoff = lds_byte(wr * 64 + fr, fq * 8), boff = lds_byte(wc * 32 + fr, fq * 8);
#define PG8_SA(b, h) (((b) * 2 + (h)) * HTB)
#define PG8_SB(b, h) ((4 + (b) * 2 + (h)) * HTB)
#define PG8_STAGE(bufoff, gbase, voff) do { _Pragma("unroll") for (int _i = 0; _i < 2; ++_i) \
        __builtin_amdgcn_global_load_lds((const unsigned*)((const char*)(gbase) + (voff)[_i]), (PG8_LAS unsigned*)(lds + (bufoff) + ldsw + _i * 8192), 16, 0, 0); } while (0)
#define PG8_LDA(dst, b, h) do { _Pragma("unroll") for (int m = 0; m < 4; ++m) _Pragma("unroll") for (int k = 0; k < 2; ++k) dst[m][k] = *(const PG8_LAS bf16x8*)(lds + PG8_SA(b, h) + aoff + m * 2048 + k * 1024); } while (0)
#define PG8_LDB(dst, b, h) do { _Pragma("unroll") for (int n = 0; n < 2; ++n) _Pragma("unroll") for (int k = 0; k < 2; ++k) dst[n][k] = *(const PG8_LAS bf16x8*)(lds + PG8_SB(b, h) + boff + n * 2048 + k * 1024); } while (0)
#define PG8_MMA(ai, bj, At, Bt) do { __builtin_amdgcn_s_setprio(1); _Pragma("unroll") for (int m = 0; m < 4; ++m) _Pragma("unroll") for (int n = 0; n < 2; ++n) _Pragma("unroll") for (int k = 0; k < 2; ++k) \
        acc[ai][bj][m][n] = __builtin_amdgcn_mfma_f32_16x16x32_bf16(Bt[n][k], At[m][k], acc[ai][bj][m][n], 0, 0, 0); __builtin_amdgcn_s_setprio(0); } while (0)
#define PG8_WAIT_V(n) asm volatile("s_waitcnt vmcnt(" #n ")" ::: "memory")
#define PG8_WAIT_L(n) asm volatile("s_waitcnt lgkmcnt(" #n ")" ::: "memory")
#define PG8_BAR __builtin_amdgcn_s_barrier()
#define PG8_SCHED __builtin_amdgcn_sched_barrier(0)
    Unit cur, nxt; int ui = 0;
    if (!S.next(0, cur)) return;
    f32x4 acc[2][2][4][2];
#pragma unroll
    for (int a = 0; a < 2; ++a)
#pragma unroll
        for (int b = 0; b < 2; ++b)
#pragma unroll
            for (int m = 0; m < 4; ++m)
#pragma unroll
                for (int n = 0; n < 2; ++n) acc[a][b][m][n] = (f32x4){0.f, 0.f, 0.f, 0.f};
    bf16x8 At[4][2], B0[2][2], B1[2][2];
    const char* cA = (const char*)g.A + (size_t)cur.pm * tstep; const char* cB = (const char*)g.Bt + (size_t)cur.pn * tstep;
    S.a_ready(cur);
    if constexpr (SP2) {
        PG8_STAGE(PG8_SB(0, 0), cB, voffB); PG8_STAGE(PG8_SB(0, 1), cB + hstep, voffB); PG8_STAGE(PG8_SA(0, 0), cA, voffA); PG8_STAGE(PG8_SA(0, 1), cA + hstep, voffA);
        if (wr == 1) PG8_BAR;
        PG8_WAIT_V(2); PG8_BAR;
        PG8_STAGE(PG8_SB(1, 0), cB + kstep, voffB); PG8_STAGE(PG8_SA(1, 0), cA + kstep, voffA); PG8_STAGE(PG8_SB(1, 1), cB + hstep + kstep, voffB);
        PG8_WAIT_V(6); PG8_BAR;
    } else {
        PG8_STAGE(PG8_SB(0, 0), cB, voffB); PG8_STAGE(PG8_SA(0, 0), cA, voffA); PG8_STAGE(PG8_SB(0, 1), cB + hstep, voffB); PG8_STAGE(PG8_SA(0, 1), cA + hstep, voffA);
        if (wr == 1) PG8_BAR;
        PG8_WAIT_V(4); PG8_BAR;
        PG8_STAGE(PG8_SB(1, 0), cB + kstep, voffB); PG8_STAGE(PG8_SA(1, 0), cA + kstep, voffA); PG8_STAGE(PG8_SB(1, 1), cB + hstep + kstep, voffB);
        PG8_WAIT_V(6); PG8_BAR;
    }
    for (;;) {
        const bool has_next = S.next(ui + 1, nxt);
        const char* nA = has_next ? (const char*)g.A + (size_t)nxt.pm * tstep : cA; const char* nB = has_next ? (const char*)g.Bt + (size_t)nxt.pn * tstep : cB;
        for (int t = 0; t < nt; t += 2) {
            const bool last = (t == nt - 2);
            const char* a1 = cA + (size_t)(t + 1) * kstep;
            const char* a2 = last ? nA : cA + (size_t)(t + 2) * kstep; const char* b2 = last ? nB : cB + (size_t)(t + 2) * kstep;
            const char* a3 = a2 + kstep; const char* b3 = b2 + kstep;
            if (last && has_next) S.a_ready(nxt);
            if constexpr (SP2) {
            PG8_LDB(B0, 0, 0); PG8_LDB(B1, 0, 1); PG8_SCHED; PG8_LDA(At, 0, 0); PG8_STAGE(PG8_SA(1, 1), a1 + hstep, voffA);
            PG8_WAIT_V(8); PG8_WAIT_L(0); PG8_BAR; PG8_MMA(0, 0, At, B0); PG8_MMA(0, 1, At, B1); PG8_BAR; PG8_SCHED;
            PG8_LDA(At, 0, 1); PG8_STAGE(PG8_SB(0, 0), b2, voffB); PG8_STAGE(PG8_SB(0, 1), b2 + hstep, voffB); PG8_STAGE(PG8_SA(0, 0), a2, voffA);
            PG8_WAIT_V(8); PG8_WAIT_L(0); PG8_BAR; PG8_MMA(1, 0, At, B0); PG8_MMA(1, 1, At, B1); PG8_BAR; PG8_SCHED;
            PG8_LDB(B0, 1, 0); PG8_LDB(B1, 1, 1); PG8_SCHED; PG8_LDA(At, 1, 0); PG8_STAGE(PG8_SA(0, 1), a2 + hstep, voffA);
            PG8_WAIT_V(8); PG8_WAIT_L(0); PG8_BAR; PG8_MMA(0, 0, At, B0); PG8_MMA(0, 1, At, B1); PG8_BAR; PG8_SCHED;
            PG8_LDA(At, 1, 1); PG8_STAGE(PG8_SB(1, 0), b3, voffB); PG8_STAGE(PG8_SB(1, 1), b3 + hstep, voffB); PG8_STAGE(PG8_SA(1, 0), a3, voffA);
            PG8_WAIT_V(8); PG8_WAIT_L(0); PG8_BAR; PG8_MMA(1, 0, At, B0); PG8_MMA(1, 1, At, B1); PG8_BAR; PG8_SCHED;
            } else {
            PG8_LDB(B0, 0, 0); PG8_SCHED; PG8_LDA(At, 0, 0); PG8_STAGE(PG8_SA(1, 1), a1 + hstep, voffA);
            PG8_WAIT_L(8); PG8_BAR; PG8_WAIT_L(0); PG8_MMA(0, 0, At, B0); PG8_BAR; PG8_SCHED;
            PG8_LDB(B1, 0, 1); PG8_STAGE(PG8_SB(0, 0), b2, voffB);
            PG8_BAR; PG8_WAIT_L(0); PG8_MMA(0, 1, At, B1); PG8_BAR;
            PG8_LDA(At, 0, 1); PG8_STAGE(PG8_SA(0, 0), a2, voffA);
            PG8_BAR; PG8_WAIT_L(0); PG8_MMA(1, 0, At, B0); PG8_BAR; PG8_SCHED;
            PG8_STAGE(PG8_SB(0, 1), b2 + hstep, voffB);
            PG8_WAIT_V(6); PG8_BAR; PG8_MMA(1, 1, At, B1); PG8_BAR;
            PG8_LDB(B0, 1, 0); PG8_SCHED; PG8_LDA(At, 1, 0); PG8_STAGE(PG8_SA(0, 1), a2 + hstep, voffA);
            PG8_WAIT_L(8); PG8_BAR; PG8_WAIT_L(0); PG8_MMA(0, 0, At, B0); PG8_BAR; PG8_SCHED;
            PG8_LDB(B1, 1, 1); PG8_STAGE(PG8_SB(1, 0), b3, voffB);
            PG8_BAR; PG8_WAIT_L(0); PG8_MMA(0, 1, At, B1); PG8_BAR;
            PG8_LDA(At, 1, 1); PG8_STAGE(PG8_SA(1, 0), a3, voffA);
            PG8_BAR; PG8_WAIT_L(0); PG8_MMA(1, 0, At, B0); PG8_BAR; PG8_SCHED;
            PG8_STAGE(PG8_SB(1, 1), b3 + hstep, voffB);
            PG8_WAIT_V(6); PG8_BAR; PG8_MMA(1, 1, At, B1); PG8_BAR;
            }
        }
        if constexpr (ALIGN_EPI) { if (wr == 0) PG8_BAR; }
        if constexpr (!Epi::AFTER_DRAIN) { E(acc, cur, wr, wc, fr, fq); S.done(cur); }
        if (!has_next) break;
#pragma unroll
        for (int a = 0; a < 2; ++a)
#pragma unroll
            for (int b = 0; b < 2; ++b)
#pragma unroll
                for (int m = 0; m < 4; ++m)
#pragma unroll
                    for (int n = 0; n < 2; ++n) acc[a][b][m][n] = (f32x4){0.f, 0.f, 0.f, 0.f};
        cur = nxt; cA = nA; cB = nB; ++ui;
        if constexpr (ALIGN_EPI) { if (wr == 1) PG8_BAR; }
    }
    PG8_WAIT_V(0);
    if constexpr (!ALIGN_EPI) { if (wr == 0) PG8_BAR; }
    PG8_BAR;
    if constexpr (Epi::AFTER_DRAIN) { E.fused(acc, cur, wr, wc, fr, fq, lds, wid, lane); S.done(cur); }
#undef PG8_SA
#undef PG8_SB
#undef PG8_STAGE
#undef PG8_LDA
#undef PG8_LDB
#undef PG8_MMA
#undef PG8_WAIT_V
#undef PG8_WAIT_L
#undef PG8_BAR
#undef PG8_SCHED
}
}

constexpr int T = 16384, D = 1024, SEQ = 2048, NBATCH = 8, NIN = 8192;
constexpr int NHEAD = 8, NEXP = 16384;
constexpr float LN_EPS = 1e-5f;
constexpr float ALPHA = 1.189207115002721f;
constexpr float LAM_INIT = 0.2f;
constexpr int NWAVES = 8, NTHREADS = 512;
constexpr int LDS_BYTES = 147456;
constexpr int NPHASES = 9;
constexpr int RING_BYTES = 131072, LDSCTL_OFF = RING_BYTES, MISC_OFF = LDSCTL_OFF + 320;
constexpr int CW_BAR = 4096;
constexpr size_t CTL_ZERO_BYTES = 65536;
#ifndef PROBE_REP
#define PROBE_REP -1
#endif
#ifndef PROBE_SUB
#define PROBE_SUB 0
#endif
#ifndef MK_N_LAUNCHES
#define MK_N_LAUNCHES 1
#endif

typedef unsigned short bf16_t;
typedef short bf16x8 __attribute__((ext_vector_type(8)));
typedef short s16x4 __attribute__((ext_vector_type(4)));
typedef float f32x4 __attribute__((ext_vector_type(4)));
typedef float f32x16 __attribute__((ext_vector_type(16)));
typedef unsigned u32x4 __attribute__((ext_vector_type(4)));
typedef unsigned u32x2 __attribute__((ext_vector_type(2)));
#define LAS __attribute__((address_space(3)))
#define LDS_WAIT() asm volatile("s_waitcnt lgkmcnt(0)" ::: "memory")

constexpr size_t MiB = 1u << 20;
constexpr size_t WS_CTL = 0, WS_CS = 1 * MiB, WS_WCO = 2 * MiB, WS_WAO = 4 * MiB, WS_WO = 6 * MiB, WS_WSC = 8 * MiB;
constexpr size_t WS_WIN = 12 * MiB, WS_XB = 28 * MiB, WS_Z = 60 * MiB, WS_BG = 92 * MiB, WS_Q = 124 * MiB, WS_K = 156 * MiB, WS_V = 188 * MiB;
constexpr size_t WS_UB = 12 * MiB, WS_VB = 28 * MiB, WS_USC = 44 * MiB, WS_VSC = 44 * MiB + 65536;
constexpr size_t WS_T1 = 156 * MiB, WS_MG = 188 * MiB;
constexpr size_t WS_X1B = 76 * MiB;
constexpr size_t WS_SC = 124 * MiB;
constexpr size_t WS_END = 252 * MiB;

__device__ __forceinline__ unsigned f2bf(float f) { unsigned u = __builtin_bit_cast(unsigned, f); return (u + 0x7fffu + ((u >> 16) & 1u)) >> 16; }
__device__ __forceinline__ unsigned pk2(float lo, float hi) { return f2bf(lo) | (f2bf(hi) << 16); }
__device__ __forceinline__ float bflo(unsigned w) { return __uint_as_float(w << 16); }
__device__ __forceinline__ float bfhi(unsigned w) { return __uint_as_float(w & 0xffff0000u); }
__device__ __forceinline__ float wave_sum(float v) {
#pragma unroll
    for (int o = 1; o < 64; o <<= 1) v += __shfl_xor(v, o);
    return v;
}
__device__ __forceinline__ float wave_max(float v) {
#pragma unroll
    for (int o = 1; o < 64; o <<= 1) v = fmaxf(v, __shfl_xor(v, o));
    return v;
}
__device__ __forceinline__ float wave_min(float v) {
#pragma unroll
    for (int o = 1; o < 64; o <<= 1) v = fminf(v, __shfl_xor(v, o));
    return v;
}

__device__ __forceinline__ int win_src(int n) {
    if (n < 2048) { const int i = n >> 8, r = n & 255; return r < 128 ? 128 * i + r : 2048 + 128 * i + (r - 128); }
    if (n < 3072) return 1024 + (n - 2048);
    if (n < 5120) { const int base = n - 3072, which = base >> 10, within = base & 1023, map = within >> 6, p = within & 63; const int d = p < 16 ? (p >> 1) + 8 * (p & 1) : p; return 3072 + which * 1024 + map * 64 + d; }
    return n;
}
template <bool PERMUTE>
__device__ __forceinline__ void transpose_item(const float* W, int K, int N, bf16_t* WT, LAS float* scr, int item, int lane) {
    const int nblk = N / 32, kb = item / nblk, nb = item % nblk, k0 = 64 * kb, n0 = 32 * nb;
    const int nsrc = PERMUTE ? win_src(n0 + (lane & 31)) : n0 + (lane & 31);
#pragma unroll 8
    for (int i = 0; i < 32; ++i) { const int kk = 2 * i + (lane >> 5); scr[kk * 33 + (lane & 31)] = W[(size_t)(k0 + kk) * N + nsrc]; }
    LDS_WAIT();
    const int c = lane & 7;
#pragma unroll
    for (int j = 0; j < 4; ++j) { const int n = (lane >> 3) + 8 * j; const LAS float* s = scr + (8 * c) * 33 + n;
        u32x4 o; o.x = pk2(s[0 * 33], s[1 * 33]); o.y = pk2(s[2 * 33], s[3 * 33]); o.z = pk2(s[4 * 33], s[5 * 33]); o.w = pk2(s[6 * 33], s[7 * 33]);
        *(u32x4*)(WT + (size_t)(n0 + n) * K + k0 + 8 * c) = o; }
    LDS_WAIT();
}
__device__ __forceinline__ void cvt_bf16(const float* src, bf16_t* dst, size_t n, int gtid, int gthreads) {
    const size_t n8 = n / 8;
    for (size_t i = gtid; i < n8; i += gthreads) {
        const f32x4 a = *(const f32x4*)(src + i * 8), b = *(const f32x4*)(src + i * 8 + 4);
        u32x4 o; o.x = pk2(a[0], a[1]); o.y = pk2(a[2], a[3]); o.z = pk2(b[0], b[1]); o.w = pk2(b[2], b[3]);
        *(u32x4*)(dst + i * 8) = o;
    }
}
typedef float f32x2 __attribute__((ext_vector_type(2)));
__device__ __forceinline__ void cvt_fp8_rows(const float* src, unsigned char* dst, float* scale, int nrows, int gw, int ngw, int lane) {
    for (int r = gw; r < nrows; r += ngw) {
        const f32x4* p = (const f32x4*)(src + (size_t)r * 1024) + 4 * lane;
        f32x4 v[4]; float m = 0.f;
#pragma unroll
        for (int j = 0; j < 4; ++j) { v[j] = p[j]; m = fmaxf(m, fmaxf(fmaxf(fabsf(v[j][0]), fabsf(v[j][1])), fmaxf(fabsf(v[j][2]), fabsf(v[j][3])))); }
        m = wave_max(m);
        const float sc = m > 0.f ? 384.0f / m : 1.0f;
        u32x4 o;
#pragma unroll
        for (int j = 0; j < 4; ++j) { int w = __builtin_amdgcn_cvt_pk_fp8_f32(v[j][0] * sc, v[j][1] * sc, 0, false); w = __builtin_amdgcn_cvt_pk_fp8_f32(v[j][2] * sc, v[j][3] * sc, w, true); o[j] = (unsigned)w; }
        *(u32x4*)(dst + ((size_t)(lane >> 3) * nrows + r) * 128 + 16 * (lane & 7)) = o;
        if (lane == 0) scale[r] = m > 0.f ? m * (1.0f / 384.0f) : 1.0f;
    }
}
__device__ __forceinline__ void unpack16_fp8(const u32x4 a, float (&f)[16]) {
#pragma unroll
    for (int j = 0; j < 4; ++j) { const f32x2 lo = __builtin_amdgcn_cvt_pk_f32_fp8((int)a[j], false), hi = __builtin_amdgcn_cvt_pk_f32_fp8((int)a[j], true);
        f[4 * j] = lo[0]; f[4 * j + 1] = lo[1]; f[4 * j + 2] = hi[0]; f[4 * j + 3] = hi[1]; }
}
__device__ __forceinline__ void wsc_item(const float* w_pq, const float* sub_keys, bf16_t* Wsc, LAS unsigned char* lds, int item, int tid) {
    const int hc = item >> 4, d0 = (item & 15) * 64;
    LAS float* kl = (LAS float*)lds; LAS float* wl = (LAS float*)(lds + 67584);
    for (int i = tid; i < 128 * 32; i += NTHREADS) { const int n = i >> 5, j4 = (i & 31) * 4; *(LAS f32x4*)(kl + n * 132 + j4) = *(const f32x4*)(sub_keys + ((size_t)hc * 128 + n) * 128 + j4); }
    for (int i = tid; i < 64 * 32; i += NTHREADS) { const int dd = i >> 5, j4 = (i & 31) * 4; *(LAS f32x4*)(wl + dd * 128 + j4) = *(const f32x4*)(w_pq + (size_t)(d0 + dd) * 2048 + hc * 128 + j4); }
    __syncthreads();
    const int n = tid & 127, dq = tid >> 7;
    float acc[16];
#pragma unroll
    for (int i = 0; i < 16; ++i) acc[i] = 0.f;
    for (int j4 = 0; j4 < 128; j4 += 4) {
        const f32x4 kv = *(const LAS f32x4*)(kl + n * 132 + j4);
#pragma unroll
        for (int i = 0; i < 16; ++i) { const f32x4 wv = *(const LAS f32x4*)(wl + (dq * 16 + i) * 128 + j4); acc[i] += kv[0] * wv[0] + kv[1] * wv[1] + kv[2] * wv[2] + kv[3] * wv[3]; }
    }
    u32x4 o0, o1;
    o0.x = pk2(acc[0], acc[1]); o0.y = pk2(acc[2], acc[3]); o0.z = pk2(acc[4], acc[5]); o0.w = pk2(acc[6], acc[7]);
    o1.x = pk2(acc[8], acc[9]); o1.y = pk2(acc[10], acc[11]); o1.z = pk2(acc[12], acc[13]); o1.w = pk2(acc[14], acc[15]);
    bf16_t* dst = Wsc + (size_t)(hc * 128 + n) * 1024 + d0 + dq * 16;
    *(u32x4*)dst = o0; *(u32x4*)(dst + 8) = o1;
    __syncthreads();
}

__device__ __forceinline__ void conv_phase(const bf16_t* Z, const bf16_t* BG, bf16_t* OUT, const float* conv_w, const float* conv_b, int gtid, int gthreads) {
    for (int it = gtid; it < (T / 16) * 128; it += gthreads) {
        const int rb = it >> 7, cc = it & 127, t0 = rb * 16, c0 = cc * 8;
        float w0[8], w1[8], w2[8], cb[8];
#pragma unroll
        for (int i = 0; i < 8; ++i) { w0[i] = conv_w[c0 + i]; w1[i] = conv_w[1024 + c0 + i]; w2[i] = conv_w[2048 + c0 + i]; cb[i] = conv_b[c0 + i]; }
        float zm2[8], zm1[8];
        if ((t0 & (SEQ - 1)) != 0) {
            const u32x4 a = *(const u32x4*)(Z + (size_t)(t0 - 2) * 1024 + c0), b = *(const u32x4*)(Z + (size_t)(t0 - 1) * 1024 + c0);
            zm2[0] = bflo(a.x); zm2[1] = bfhi(a.x); zm2[2] = bflo(a.y); zm2[3] = bfhi(a.y); zm2[4] = bflo(a.z); zm2[5] = bfhi(a.z); zm2[6] = bflo(a.w); zm2[7] = bfhi(a.w);
            zm1[0] = bflo(b.x); zm1[1] = bfhi(b.x); zm1[2] = bflo(b.y); zm1[3] = bfhi(b.y); zm1[4] = bflo(b.z); zm1[5] = bfhi(b.z); zm1[6] = bflo(b.w); zm1[7] = bfhi(b.w);
        } else {
#pragma unroll
            for (int i = 0; i < 8; ++i) { zm2[i] = 0.f; zm1[i] = 0.f; }
        }
#pragma unroll 4
        for (int r = 0; r < 16; ++r) {
            const size_t o = (size_t)(t0 + r) * 1024 + c0;
            const u32x4 a = *(const u32x4*)(Z + o), g = *(const u32x4*)(BG + o);
            float z[8], bgv[8], y[8];
            z[0] = bflo(a.x); z[1] = bfhi(a.x); z[2] = bflo(a.y); z[3] = bfhi(a.y); z[4] = bflo(a.z); z[5] = bfhi(a.z); z[6] = bflo(a.w); z[7] = bfhi(a.w);
            bgv[0] = bflo(g.x); bgv[1] = bfhi(g.x); bgv[2] = bflo(g.y); bgv[3] = bfhi(g.y); bgv[4] = bflo(g.z); bgv[5] = bfhi(g.z); bgv[6] = bflo(g.w); bgv[7] = bfhi(g.w);
#pragma unroll
            for (int i = 0; i < 8; ++i) { y[i] = bgv[i] * (cb[i] + w0[i] * zm2[i] + w1[i] * zm1[i] + w2[i] * z[i]); zm2[i] = zm1[i]; zm1[i] = z[i]; }
            u32x4 ov; ov.x = pk2(y[0], y[1]); ov.y = pk2(y[2], y[3]); ov.z = pk2(y[4], y[5]); ov.w = pk2(y[6], y[7]);
            *(u32x4*)(OUT + o) = ov;
        }
    }
}

namespace att {
constexpr int STAGE = 32768;
constexpr int XCH_OFF = 65536;
__device__ __forceinline__ int crow(int r, int hi) { return (r & 3) + 8 * (r >> 2) + 4 * hi; }
__device__ __forceinline__ s16x4 vtr(const LAS unsigned char* p) { return __builtin_bit_cast(s16x4, __builtin_amdgcn_ds_read_tr16_b64_v4i16((LAS s16x4*)p)); }

__device__ __forceinline__ void attn_unit(int b, int h, int qblk, const bf16_t* Q, const bf16_t* Kg, const bf16_t* Vg, bf16_t* O, const float* subln_g, float lam,
                                          LAS unsigned char* lds, int tid) {
    const int lane = tid & 63, wid = __builtin_amdgcn_readfirstlane(tid >> 6), rg = wid >> 1, c = wid & 1, r = lane & 31, hh = lane >> 5;
    const size_t seq0 = (size_t)b * SEQ;
    const int qs = qblk * 128 + rg * 32;
    bf16x8 qf[4];
    { const bf16_t* qp = Q + (seq0 + qs + r) * 1024 + h * 128 + c * 64 + 8 * hh;
#pragma unroll
      for (int ks = 0; ks < 4; ++ks) qf[ks] = *(const bf16x8*)(qp + 16 * ks); }
    const int kkey = tid >> 3, kch = tid & 7;
    const unsigned kdst = (unsigned)(kkey * 128 + ((kch ^ ((kkey >> 1) & 7)) * 16));
    const int v0key = tid >> 4, vch = tid & 15;
    const unsigned vdst0 = (unsigned)(v0key * 256 + (((vch >> 2) ^ (v0key & 3)) * 64) + (vch & 3) * 16);
    const unsigned vdst1 = vdst0 + 32 * 256;
    const bf16_t* kbase = Kg + seq0 * 1024 + h * 128 + kch * 8;
    const bf16_t* vbase = Vg + seq0 * 1024 + h * 128 + vch * 8;
    const int kswz = (r >> 1) & 7;
    unsigned koff[4];
#pragma unroll
    for (int ks = 0; ks < 4; ++ks) koff[ks] = (unsigned)(c * 8192 + r * 128 + (((ks * 2 + hh) ^ kswz) * 16));
    const int i16 = lane & 15, vq = i16 >> 2, vp = i16 & 3, g16 = (lane >> 4) & 1;
    unsigned voff[4];
#pragma unroll
    for (int dt = 0; dt < 4; ++dt) voff[dt] = (unsigned)(16384 + (4 * hh + vq) * 256 + ((dt ^ vq) * 64) + (16 * g16 + 4 * vp) * 2);

    f32x16 o[4];
#pragma unroll
    for (int dt = 0; dt < 4; ++dt)
#pragma unroll
        for (int i = 0; i < 16; ++i) o[dt][i] = 0.f;
    float mrun = 0.f, lrun = 0.f;
    f32x16 negm;
#pragma unroll
    for (int i = 0; i < 16; ++i) negm[i] = 0.f;
    const int nt = 2 * qblk + 2;
    const int jmax = (qs + 31) >> 6;

    u32x4 pk0, pk1, pv0, pv1;
    { const size_t ro = (size_t)kkey * 1024; pk0 = *(const u32x4*)(kbase + ro); pk1 = *(const u32x4*)(kbase + ro + 64);
      pv0 = *(const u32x4*)(vbase + (size_t)v0key * 1024); pv1 = *(const u32x4*)(vbase + (size_t)(v0key + 32) * 1024); }
    *(LAS u32x4*)(lds + kdst) = pk0; *(LAS u32x4*)(lds + 8192 + kdst) = pk1; *(LAS u32x4*)(lds + 16384 + vdst0) = pv0; *(LAS u32x4*)(lds + 16384 + vdst1) = pv1;
    __syncthreads();
    __builtin_amdgcn_s_waitcnt(0x0F70);
    for (int j = 0; j < nt; ++j) {
        const LAS unsigned char* st = lds + (j & 1) * STAGE;
        if (j + 1 < nt) { const size_t ro = (size_t)((j + 1) * 64 + kkey) * 1024; pk0 = *(const u32x4*)(kbase + ro); pk1 = *(const u32x4*)(kbase + ro + 64);
            pv0 = *(const u32x4*)(vbase + (size_t)((j + 1) * 64 + v0key) * 1024); pv1 = *(const u32x4*)(vbase + (size_t)((j + 1) * 64 + v0key + 32) * 1024); }
        if (j <= jmax) {
#pragma unroll 1
            for (int kk = 0; kk < 2; ++kk) {
                f32x16 sv;
                { const bf16x8 ka = *(const LAS bf16x8*)(st + koff[0] + kk * 4096); sv = __builtin_amdgcn_mfma_f32_32x32x16_bf16(ka, qf[0], negm, 0, 0, 0); }
#pragma unroll
                for (int ks = 1; ks < 4; ++ks) { const bf16x8 ka = *(const LAS bf16x8*)(st + koff[ks] + kk * 4096); sv = __builtin_amdgcn_mfma_f32_32x32x16_bf16(ka, qf[ks], sv, 0, 0, 0); }
                s16x4 vlo[2][2], vhi[2][2];
#pragma unroll
                for (int dt = 0; dt < 2; ++dt)
#pragma unroll
                    for (int s2 = 0; s2 < 2; ++s2) { const int ks = 2 * kk + s2; vlo[dt][s2] = vtr(st + voff[dt] + ks * 16 * 256); vhi[dt][s2] = vtr(st + voff[dt] + ks * 16 * 256 + 8 * 256); }
                if (j * 64 + 63 > qs) {
                    const int qrel = qs + r - j * 64 - kk * 32;
#pragma unroll
                    for (int i = 0; i < 16; ++i) if (crow(i, hh) > qrel) sv[i] = -INFINITY;
                }
                float m4[4];
#pragma unroll
                for (int i = 0; i < 4; ++i) m4[i] = fmaxf(fmaxf(sv[i], sv[4 + i]), fmaxf(sv[8 + i], sv[12 + i]));
                float mx = fmaxf(fmaxf(m4[0], m4[1]), fmaxf(m4[2], m4[3]));
                { const auto sw = __builtin_amdgcn_permlane32_swap(__float_as_uint(mx), __float_as_uint(mx), false, false); mx = fmaxf(__uint_as_float(sw[0]), __uint_as_float(sw[1])); }
                const bool first = (j == 0) && (kk == 0);
                if (first || __any(mx > 8.0f)) {
                    const float delta = first ? mx : fmaxf(mx, 0.f);
                    const float al = first ? 0.f : __builtin_amdgcn_exp2f(-delta);
                    mrun += delta; lrun *= al;
#pragma unroll
                    for (int i = 0; i < 16; ++i) { negm[i] = -mrun; sv[i] -= delta; }
#pragma unroll
                    for (int dt = 0; dt < 4; ++dt)
#pragma unroll
                        for (int i = 0; i < 16; ++i) o[dt][i] *= al;
                }
#pragma unroll
                for (int i = 0; i < 16; ++i) sv[i] = __builtin_amdgcn_exp2f(sv[i]);
                { float p4[4];
#pragma unroll
                  for (int i = 0; i < 4; ++i) p4[i] = (sv[i] + sv[4 + i]) + (sv[8 + i] + sv[12 + i]);
                  lrun += (p4[0] + p4[1]) + (p4[2] + p4[3]); }
                bf16x8 pf[2];
#pragma unroll
                for (int s2 = 0; s2 < 2; ++s2) { u32x4 w;
                    w.x = pg8::cvt_pk_bf16(sv[8 * s2 + 0], sv[8 * s2 + 1]); w.y = pg8::cvt_pk_bf16(sv[8 * s2 + 2], sv[8 * s2 + 3]); w.z = pg8::cvt_pk_bf16(sv[8 * s2 + 4], sv[8 * s2 + 5]); w.w = pg8::cvt_pk_bf16(sv[8 * s2 + 6], sv[8 * s2 + 7]);
                    pf[s2] = __builtin_bit_cast(bf16x8, w); }
#pragma unroll
                for (int dt = 0; dt < 2; ++dt)
#pragma unroll
                    for (int s2 = 0; s2 < 2; ++s2) {
                        const bf16x8 va = (bf16x8){vlo[dt][s2][0], vlo[dt][s2][1], vlo[dt][s2][2], vlo[dt][s2][3], vhi[dt][s2][0], vhi[dt][s2][1], vhi[dt][s2][2], vhi[dt][s2][3]};
                        o[dt] = __builtin_amdgcn_mfma_f32_32x32x16_bf16(va, pf[s2], o[dt], 0, 0, 0); }
#pragma unroll
                for (int dt = 2; dt < 4; ++dt)
#pragma unroll
                    for (int s2 = 0; s2 < 2; ++s2) { const int ks = 2 * kk + s2;
                        const s16x4 lo = vtr(st + voff[dt] + ks * 16 * 256), hi = vtr(st + voff[dt] + ks * 16 * 256 + 8 * 256);
                        const bf16x8 va = (bf16x8){lo[0], lo[1], lo[2], lo[3], hi[0], hi[1], hi[2], hi[3]};
                        o[dt] = __builtin_amdgcn_mfma_f32_32x32x16_bf16(va, pf[s2], o[dt], 0, 0, 0); }
            }
        }
        if (j + 1 < nt) { LAS unsigned char* sn = lds + ((j + 1) & 1) * STAGE;
            *(LAS u32x4*)(sn + kdst) = pk0; *(LAS u32x4*)(sn + 8192 + kdst) = pk1; *(LAS u32x4*)(sn + 16384 + vdst0) = pv0; *(LAS u32x4*)(sn + 16384 + vdst1) = pv1; }
        __syncthreads();
    }
    const float ltot = lrun + __shfl_xor(lrun, 32);
    const float inv = (c == 0 ? 1.0f : lam) / ltot;
    LAS float* xch = (LAS float*)(lds + XCH_OFF) + rg * 4096 + lane;
    if (c == 1) {
#pragma unroll
        for (int dt = 0; dt < 4; ++dt)
#pragma unroll
            for (int i = 0; i < 16; ++i) xch[(dt * 16 + i) * 64] = o[dt][i] * inv;
    }
    __syncthreads();
    if (c == 0) {
        float ss = 0.f;
#pragma unroll
        for (int dt = 0; dt < 4; ++dt)
#pragma unroll
            for (int i = 0; i < 16; ++i) { const float v = o[dt][i] * inv - xch[(dt * 16 + i) * 64]; o[dt][i] = v; ss += v * v; }
        ss += __shfl_xor(ss, 32);
        const float rs = (1.0f - LAM_INIT) / sqrtf(ss * (1.0f / 128.0f) + LN_EPS);
        bf16_t* op = O + (seq0 + qs + r) * 1024 + h * 128 + 4 * hh;
#pragma unroll
        for (int dt = 0; dt < 4; ++dt)
#pragma unroll
            for (int g = 0; g < 4; ++g) { const int e = dt * 32 + 8 * g;
                const f32x4 gv = *(const f32x4*)(subln_g + e + 4 * hh);
                u32x2 w; w.x = pg8::cvt_pk_bf16(o[dt][4 * g] * rs * gv[0], o[dt][4 * g + 1] * rs * gv[1]); w.y = pg8::cvt_pk_bf16(o[dt][4 * g + 2] * rs * gv[2], o[dt][4 * g + 3] * rs * gv[3]);
                *(u32x2*)(op + e) = w; }
    }
    __syncthreads();
}
}

__device__ __forceinline__ void ln1_phase(const float* X, float* XO, bf16_t* XB, const float* g, const float* bta, int gw, int ngw, int lane) {
    f32x4 gv[4], bv[4];
#pragma unroll
    for (int j = 0; j < 4; ++j) { gv[j] = *(const f32x4*)(g + 4 * lane + 256 * j); bv[j] = *(const f32x4*)(bta + 4 * lane + 256 * j); }
    for (int m = gw; m < T; m += ngw) {
        const f32x4* xr = (const f32x4*)(X + (size_t)m * D) + lane; f32x4* xo = (f32x4*)(XO + (size_t)m * D) + lane;
        f32x4 v[4]; float s = 0.f;
#pragma unroll
        for (int j = 0; j < 4; ++j) { v[j] = xr[64 * j]; s += (v[j][0] + v[j][1]) + (v[j][2] + v[j][3]); }
        const float mean = wave_sum(s) * (1.f / D); float s2 = 0.f;
#pragma unroll
        for (int j = 0; j < 4; ++j) { v[j] = v[j] - mean; s2 += (v[j][0] * v[j][0] + v[j][1] * v[j][1]) + (v[j][2] * v[j][2] + v[j][3] * v[j][3]); }
        const float rstd = 1.f / sqrtf(wave_sum(s2) * (1.f / D) + LN_EPS);
        u32x2* o8 = (u32x2*)(XB + (size_t)m * D) + lane;
#pragma unroll
        for (int j = 0; j < 4; ++j) { const f32x4 y = v[j] * rstd * gv[j] + bv[j]; xo[64 * j] = y; u32x2 w; w.x = pk2(y[0], y[1]); w.y = pk2(y[2], y[3]); o8[64 * j] = w; }
    }
}

namespace peer {
template <int NV>
__device__ __forceinline__ void top16(const float (&v)[NV], LAS float* oval, LAS int* oidx, int lane) {
    float lmx = v[0], lmn = v[0];
#pragma unroll
    for (int q = 1; q < NV; ++q) { lmx = fmaxf(lmx, v[q]); lmn = fminf(lmn, v[q]); }
    float hi = wave_max(lmx), lo = wave_min(lmn);
    lo = lo - fabsf(lo) * 1e-6f - 1e-30f;
    float thr = hi; int need_ties = 1;
    for (int it = 0; it < 64; ++it) {
        const float mid = 0.5f * (lo + hi);
        if (!(mid > lo && mid < hi)) break;
        int cnt = 0;
#pragma unroll
        for (int q = 0; q < NV; ++q) cnt += __popcll(__ballot(v[q] > mid));
        if (cnt == 16) { thr = mid; need_ties = 0; break; }
        if (cnt > 16) lo = mid; else hi = mid;
    }
    const float tie_hi = hi;
    int base = 0;
    if (!need_ties) {
#pragma unroll
        for (int q = 0; q < NV; ++q) { const bool sel = v[q] > thr; const unsigned long long bm = __ballot(sel);
            const int pos = base + (int)__builtin_amdgcn_mbcnt_hi((unsigned)(bm >> 32), __builtin_amdgcn_mbcnt_lo((unsigned)bm, 0u));
            if (sel) { oval[pos] = v[q]; oidx[pos] = lane + 64 * q; }
            base += __popcll(bm); }
    } else {
#pragma unroll
        for (int q = 0; q < NV; ++q) { const bool sel = v[q] > tie_hi; const unsigned long long bm = __ballot(sel);
            const int pos = base + (int)__builtin_amdgcn_mbcnt_hi((unsigned)(bm >> 32), __builtin_amdgcn_mbcnt_lo((unsigned)bm, 0u));
            if (sel && pos < 16) { oval[pos] = v[q]; oidx[pos] = lane + 64 * q; }
            base += __popcll(bm); }
#pragma unroll
        for (int q = 0; q < NV; ++q) { const bool sel = (v[q] <= tie_hi) && (v[q] > lo); const unsigned long long bm = __ballot(sel);
            const int pos = base + (int)__builtin_amdgcn_mbcnt_hi((unsigned)(bm >> 32), __builtin_amdgcn_mbcnt_lo((unsigned)bm, 0u));
            if (sel && pos < 16) { oval[pos] = v[q]; oidx[pos] = lane + 64 * q; }
            base += __popcll(bm); }
    }
    LDS_WAIT();
}

__device__ __forceinline__ void retrieve(int t, const float* SC, LAS unsigned char* scr, LAS int* EI, LAS float* GW, int lane) {
    LAS float* s1v = (LAS float*)scr; LAS int* s1i = (LAS int*)(scr + 64); LAS float* s2v = (LAS float*)(scr + 128); LAS int* s2i = (LAS int*)(scr + 192);
    LAS float* cv = (LAS float*)(scr + 256); LAS int* ci = (LAS int*)(scr + 320);
    const float* sc = SC + (size_t)t * 2048;
#pragma unroll 1
    for (int h = 0; h < NHEAD; ++h) {
        float a[2], bq[2];
        a[0] = sc[h * 256 + lane]; a[1] = sc[h * 256 + 64 + lane]; bq[0] = sc[h * 256 + 128 + lane]; bq[1] = sc[h * 256 + 192 + lane];
        top16<2>(a, s1v, s1i, lane);
        top16<2>(bq, s2v, s2i, lane);
        float cand[4];
#pragma unroll
        for (int q = 0; q < 4; ++q) { const int idx = lane + 64 * q; cand[q] = s1v[idx >> 4] + s2v[idx & 15]; }
        top16<4>(cand, cv, ci, lane);
        {
            const float v = cv[lane & 15]; const int code = ci[lane & 15];
            float mx = v;
#pragma unroll
            for (int o = 1; o < 16; o <<= 1) mx = fmaxf(mx, __shfl_xor(mx, o));
            const float ex = __expf(v - mx); float sm = ex;
#pragma unroll
            for (int o = 1; o < 16; o <<= 1) sm += __shfl_xor(sm, o);
            const int k = h * 16 + lane, p = (k & 7) * 16 + (k >> 3);
            if (lane < 16) { GW[p] = ex / sm; EI[p] = s1i[code >> 4] * 128 + s2i[code & 15]; }
        }
        LDS_WAIT();
    }
}

__device__ __forceinline__ int okey(float f) { const int b = __float_as_int(f); return b ^ ((b >> 31) & 0x7fffffff); }
__device__ __forceinline__ float okey_inv(int k) { return __int_as_float(k ^ ((k >> 31) & 0x7fffffff)); }
__device__ __forceinline__ int med3i(int a, int b, int c) { int r; asm("v_med3_i32 %0, %1, %2, %3" : "=v"(r) : "v"(a), "v"(b), "v"(c)); return r; }
__device__ __forceinline__ void ins16(int (&t)[16], int x) {
#pragma unroll
    for (int i = 15; i >= 1; --i) t[i] = med3i(t[i], t[i - 1], x);
    t[0] = max(t[0], x);
}
__device__ __forceinline__ void retrieve4(int t0, int jb, const float* SC, LAS int* IDX, LAS int* EI, LAS float* GW, int lane) {
    const int tl = lane >> 4, h = (lane >> 1) & 7, cc = lane & 1;
    const f32x4* lp = (const f32x4*)(SC + (size_t)(t0 + tl) * 2048 + (h * 2 + cc) * 128);
    int t[16];
#pragma unroll
    for (int i = 0; i < 16; ++i) t[i] = (int)0x80000000;
#pragma unroll 2
    for (int q4 = 0; q4 < 32; q4 += 4) {
        f32x4 v[4];
#pragma unroll
        for (int q = 0; q < 4; ++q) v[q] = lp[q4 + q];
#pragma unroll
        for (int q = 0; q < 4; ++q)
#pragma unroll
            for (int e = 0; e < 4; ++e) ins16(t, (okey(v[q][e]) & ~127) | (127 - (4 * (q4 + q) + e)));
    }
    float val[16], pv[16];
    { u32x4 w;
#pragma unroll
      for (int q = 0; q < 4; ++q) {
#pragma unroll
          for (int e = 0; e < 4; ++e) { val[4 * q + e] = okey_inv(t[4 * q + e] & ~127); w[e] = (unsigned)(127 - (t[4 * q + e] & 127)); }
          *(LAS u32x4*)(IDX + lane * 16 + 4 * q) = w; } }
#pragma unroll
    for (int i = 0; i < 16; ++i) pv[i] = __shfl_xor(val[i], 1);
    float s1v[16], s2v[16];
#pragma unroll
    for (int i = 0; i < 16; ++i) { s1v[i] = cc ? pv[i] : val[i]; s2v[i] = cc ? val[i] : pv[i]; }
    int ct[16];
#pragma unroll
    for (int i = 0; i < 16; ++i) ct[i] = (int)0x80000000;
#pragma unroll
    for (int i = 0; i < 16; ++i)
#pragma unroll
        for (int j = 0; j < 16; ++j)
            if ((i + 1) * (j + 1) <= 16) ins16(ct, (okey(s1v[i] + s2v[j]) & ~255) | (255 - (i * 16 + j)));
    float ev[16]; float sm = 0.f; const float v0 = okey_inv(ct[0] & ~255);
#pragma unroll
    for (int r = 0; r < 16; ++r) { ev[r] = __expf(okey_inv(ct[r] & ~255) - v0); sm += ev[r]; }
    const float inv = 1.0f / sm;
    LDS_WAIT();
#pragma unroll
    for (int rr = 0; rr < 8; ++rr) {
        int ka = ct[rr], kb = ct[8 + rr]; float ga = ev[rr], gb = ev[8 + rr];
        asm volatile("" : "+v"(ka), "+v"(kb), "+v"(ga), "+v"(gb));
        const int key = cc ? kb : ka; const float gg = (cc ? gb : ga) * inv;
        const int code = 255 - (key & 255), i1 = IDX[(lane & ~1) * 16 + (code >> 4)], i2 = IDX[(lane | 1) * 16 + (code & 15)];
        const int k = h * 16 + 8 * cc + rr, p = (k & 7) * 16 + (k >> 3);
        EI[(jb + tl) * 128 + p] = i1 * 128 + i2; GW[(jb + tl) * 128 + p] = gg;
    }
    LDS_WAIT();
}

constexpr int TOK = 8;
constexpr int WAVE_LDS = 12288;
__device__ __forceinline__ void wave_tokens(int t0, const float* SC, float* X  , const unsigned char* UB, const unsigned char* VB, const float* USC, const float* VSC,
                                            const float* ln_g, const float* ln_b, LAS unsigned char* wl, int lane) {
    LAS int* EI = (LAS int*)wl; LAS float* GW = (LAS float*)(wl + 4096); LAS float* PD = (LAS float*)(wl + 8192);
    for (int rp = (PROBE_SUB == 1 ? 0 : 1); rp < 2; ++rp)
#pragma unroll 1
    for (int jb = 0; jb < TOK; jb += 4) retrieve4(t0 + jb, jb, SC, (LAS int*)(wl + 8192), EI, GW, lane);
    const int g = lane >> 3, c = lane & 7;
    const int b0 = lane & 1, b1 = (lane >> 1) & 1, b2 = (lane >> 2) & 1, b3 = (lane >> 3) & 1, b4 = (lane >> 4) & 1, b5 = (lane >> 5) & 1;
    for (int rp = (PROBE_SUB == 2 ? 0 : 1); rp < 2; ++rp) {
    LDS_WAIT();
    for (int i = lane; i < TOK * 128; i += 64) PD[i] = 0.f;
    LDS_WAIT();
#pragma unroll 1
    for (int s = 0; s < 8; ++s) {
#pragma unroll 1
        for (int j = 0; j < TOK; ++j) {
            f32x2 xs2[8];
            { const f32x4* xp = (const f32x4*)(X + (size_t)(t0 + j) * D + 128 * s + 16 * c);
#pragma unroll
              for (int q = 0; q < 4; ++q) { const f32x4 v = xp[q]; xs2[2 * q] = (f32x2){v[0], v[1]}; xs2[2 * q + 1] = (f32x2){v[2], v[3]}; } }
            int ex[16];
#pragma unroll
            for (int q = 0; q < 4; ++q) { const u32x4 v = *(const LAS u32x4*)(EI + j * 128 + g * 16 + 4 * q); ex[4 * q] = (int)v[0]; ex[4 * q + 1] = (int)v[1]; ex[4 * q + 2] = (int)v[2]; ex[4 * q + 3] = (int)v[3]; }
            float sm[16];
#pragma unroll
            for (int hb = 0; hb < 2; ++hb) {
                u32x4 ra[8];
#pragma unroll
                for (int i = 0; i < 8; ++i) ra[i] = *(const u32x4*)(UB + (((unsigned)s * NEXP + (unsigned)ex[8 * hb + i]) * 128u + 16u * (unsigned)c));
#pragma unroll
                for (int i = 0; i < 8; ++i) {
                    f32x2 da = {0.f, 0.f}, db = {0.f, 0.f};
#pragma unroll
                    for (int q = 0; q < 4; ++q) { const f32x2 lo = __builtin_amdgcn_cvt_pk_f32_fp8((int)ra[i][q], false), hi = __builtin_amdgcn_cvt_pk_f32_fp8((int)ra[i][q], true);
                        da += xs2[2 * q] * lo; db += xs2[2 * q + 1] * hi; }
                    da += db; sm[8 * hb + i] = da[0] + da[1]; }
                __builtin_amdgcn_sched_barrier(0);
            }
            float r8[8], r4[4], r2[2];
#pragma unroll
            for (int i = 0; i < 8; ++i) { const float mine = b2 ? sm[8 + i] : sm[i], oth = b2 ? sm[i] : sm[8 + i]; r8[i] = mine + __shfl_xor(oth, 4); }
#pragma unroll
            for (int i = 0; i < 4; ++i) { const float mine = b1 ? r8[4 + i] : r8[i], oth = b1 ? r8[i] : r8[4 + i]; r4[i] = mine + __shfl_xor(oth, 2); }
#pragma unroll
            for (int i = 0; i < 2; ++i) { const float mine = b0 ? r4[2 + i] : r4[i], oth = b0 ? r4[i] : r4[2 + i]; r2[i] = mine + __shfl_xor(oth, 1); }
            LAS float* pd = PD + j * 128 + 16 * c + g;
            pd[0] += r2[0]; pd[8] += r2[1];
        }
    }
    }
    LDS_WAIT();
#pragma unroll 1
    for (int j = 0; j < TOK; ++j) {
#pragma unroll
        for (int q = 0; q < 2; ++q) { const int k = lane + 64 * q, p = (k & 7) * 16 + (k >> 3); const int ei = EI[j * 128 + p];
            const float dot = PD[j * 128 + k] * USC[ei];
            const float act = 0.5f * dot * (1.0f + erff(dot * 0.70710678118654752f));
            GW[j * 128 + p] *= act * VSC[ei]; }
    }
    LDS_WAIT();
#pragma unroll 1
    for (int s = 0; s < 8; ++s) {
#pragma unroll 1
        for (int j = 0; j < TOK; ++j) {
            int ex[16]; float wk[16];
#pragma unroll
            for (int q = 0; q < 4; ++q) { const u32x4 v = *(const LAS u32x4*)(EI + j * 128 + g * 16 + 4 * q); ex[4 * q] = (int)v[0]; ex[4 * q + 1] = (int)v[1]; ex[4 * q + 2] = (int)v[2]; ex[4 * q + 3] = (int)v[3];
                const f32x4 w = *(const LAS f32x4*)(GW + j * 128 + g * 16 + 4 * q); wk[4 * q] = w[0]; wk[4 * q + 1] = w[1]; wk[4 * q + 2] = w[2]; wk[4 * q + 3] = w[3]; }
            float acc[16];
#pragma unroll
            for (int q = 0; q < 16; ++q) acc[q] = 0.f;
#pragma unroll
            for (int hb = 0; hb < 2; ++hb) {
                u32x4 ra[8];
#pragma unroll
                for (int i = 0; i < 8; ++i) ra[i] = *(const u32x4*)(VB + (((unsigned)s * NEXP + (unsigned)ex[8 * hb + i]) * 128u + 16u * (unsigned)c));
#pragma unroll
                for (int i = 0; i < 8; ++i) { float f[16]; unpack16_fp8(ra[i], f);
#pragma unroll
                    for (int q = 0; q < 16; ++q) acc[q] += wk[8 * hb + i] * f[q]; }
                __builtin_amdgcn_sched_barrier(0);
            }
            float r8[8], r4[4], r2[2];
#pragma unroll
            for (int i = 0; i < 8; ++i) { const float mine = b5 ? acc[8 + i] : acc[i], oth = b5 ? acc[i] : acc[8 + i]; r8[i] = mine + __shfl_xor(oth, 32); }
#pragma unroll
            for (int i = 0; i < 4; ++i) { const float mine = b4 ? r8[4 + i] : r8[i], oth = b4 ? r8[i] : r8[4 + i]; r4[i] = mine + __shfl_xor(oth, 16); }
#pragma unroll
            for (int i = 0; i < 2; ++i) { const float mine = b3 ? r4[2 + i] : r4[i], oth = b3 ? r4[i] : r4[2 + i]; r2[i] = mine + __shfl_xor(oth, 8); }
            f32x2* xp = (f32x2*)(X + (size_t)(t0 + j) * D + 128 * s + 16 * c + 2 * g);
            const f32x2 xv = *xp; f32x2 o; o[0] = ALPHA * xv[0] + r2[0]; o[1] = ALPHA * xv[1] + r2[1];
            *xp = o;
        }
    }
    asm volatile("s_waitcnt vmcnt(0)" ::: "memory");
#pragma unroll 1
    for (int j = 0; j < TOK; ++j) {
        f32x4* xp = (f32x4*)(X + (size_t)(t0 + j) * D) + 4 * lane;
        f32x4 v[4]; float sum = 0.f;
#pragma unroll
        for (int q = 0; q < 4; ++q) { v[q] = xp[q]; sum += (v[q][0] + v[q][1]) + (v[q][2] + v[q][3]); }
        const float mean = wave_sum(sum) * (1.f / D); float s2 = 0.f;
#pragma unroll
        for (int q = 0; q < 4; ++q) { v[q] = v[q] - mean; s2 += (v[q][0] * v[q][0] + v[q][1] * v[q][1]) + (v[q][2] * v[q][2] + v[q][3] * v[q][3]); }
        const float rstd = 1.f / sqrtf(wave_sum(s2) * (1.f / D) + LN_EPS);
        const f32x4* gp = (const f32x4*)ln_g + 4 * lane; const f32x4* bp = (const f32x4*)ln_b + 4 * lane;
#pragma unroll
        for (int q = 0; q < 4; ++q) xp[q] = v[q] * rstd * gp[q] + bp[q];
    }
}
}

#define GAS __attribute__((address_space(1)))
typedef GAS unsigned gu32;
#define XB_TMO      128
#define XB_XCNT(j)  (256  + 64 * (j))
#define XB_XSUB(j)  (1280 + 64 * (j))
#define XB_XGEN(j)  (2304 + 64 * (j))
#define XB_TOP      3328
#define XB_TOPGEN   3392
#define XCD_BAR_WORDS 3456
#define XB_SPIN_CAP (1u << 18)

__device__ __forceinline__ unsigned xb_ld(unsigned* p)              { return __hip_atomic_load(p, __ATOMIC_RELAXED, __HIP_MEMORY_SCOPE_AGENT); }
__device__ __forceinline__ unsigned xb_add(unsigned* p, unsigned v) { return __hip_atomic_fetch_add(p, v, __ATOMIC_RELAXED, __HIP_MEMORY_SCOPE_AGENT); }
__device__ __forceinline__ unsigned xb_xcc_id() { return (unsigned)__builtin_amdgcn_s_getreg((3 << 11) | 20) & 0xFu; }
#define XB_SPIN(cond, bar) do { unsigned _sp = 0; while (cond) { __builtin_amdgcn_s_sleep(1); \
    if ((++_sp & 255u) == 0u) { if (xb_ld(&(bar)[XB_TMO])) break; if (_sp > XB_SPIN_CAP) { atomicAdd(&(bar)[XB_TMO], 1u); break; } } } } while (0)

struct XcdBarrier {
    unsigned* bar; unsigned x;
    volatile LAS unsigned* st;
};

__device__ __forceinline__ XcdBarrier xcd_barrier_post(unsigned* bar, volatile LAS unsigned* st) {
    XcdBarrier b; b.bar = bar; b.x = xb_xcc_id(); b.st = st;
    if (threadIdx.x == 0) (void)xb_add(&bar[XB_XCNT(b.x)], 1u);
    return b;
}
__device__ __forceinline__ void xcd_barrier_complete(unsigned* bar, unsigned x, unsigned& nloc, unsigned& nx) {
    const unsigned G = gridDim.x * gridDim.y * gridDim.z;
    unsigned sum, cnt, mine, sp = 0u;
    for (;;) {
        sum = 0u; cnt = 0u; mine = 0u;
#pragma unroll
        for (unsigned j = 0; j < 16; ++j) { const unsigned c = xb_ld(&bar[XB_XCNT(j)]); sum += c; cnt += (c > 0u) ? 1u : 0u; mine = (j == x) ? c : mine; }
        if (sum == G) break;
        __builtin_amdgcn_s_sleep(1);
        if ((++sp & 255u) == 0u) { if (xb_ld(&bar[XB_TMO])) break; if (sp > XB_SPIN_CAP) { atomicAdd(&bar[XB_TMO], 1u); break; } }
    }
    nloc = mine > 0u ? mine : 1u; nx = cnt > 0u ? cnt : 1u;
}

__device__ __forceinline__ void xcd_barrier(const XcdBarrier& b) {
    asm volatile("s_waitcnt vmcnt(0)" ::: "memory");
    __syncthreads();
    if (threadIdx.x == 0) {
        unsigned* bar = b.bar;
        __builtin_amdgcn_s_waitcnt(0);
        unsigned nloc = b.st[0], nx = b.st[1];
        if (nloc == 0u) { xcd_barrier_complete(bar, b.x, nloc, nx); b.st[0] = nloc; b.st[1] = nx; }
        const unsigned old = xb_add(&bar[XB_XSUB(b.x)], 1u);
        const unsigned gen = old / nloc;
        if (old + 1u == (gen + 1u) * nloc) {
            __builtin_amdgcn_fence(__ATOMIC_RELEASE, "agent");
            asm volatile("s_waitcnt vmcnt(0)" ::: "memory");
            const unsigned og = xb_add(&bar[XB_TOP], 1u);
            const unsigned tg = og / nx;
            if (og + 1u == (tg + 1u) * nx) xb_add(&bar[XB_TOPGEN], 1u);
            else XB_SPIN(xb_ld(&bar[XB_TOPGEN]) == tg, bar);
            __builtin_amdgcn_fence(__ATOMIC_ACQUIRE, "agent");
            xb_add(&bar[XB_XGEN(b.x)], 1u);
            asm volatile("s_waitcnt vmcnt(0)" ::: "memory");
        } else {
            XB_SPIN(xb_ld(&bar[XB_XGEN(b.x)]) == gen, bar);
            __builtin_amdgcn_fence(__ATOMIC_ACQUIRE, "agent");
            asm volatile("s_waitcnt vmcnt(0)" ::: "memory");
        }
    }
    __syncthreads();
}

struct Args {
    const float *x; const int* positions; const float *w_in, *conv_w, *conv_b, *gate_b, *lq1, *lk1, *lq2, *lk2, *subln_g, *w_conv_out, *w_attn_out, *w_o, *ln1_g, *ln1_b, *w_pq, *sub_keys, *u_tab, *v_tab, *ln2_g, *ln2_b;
    float* out; unsigned char* ws; int ph_lo, ph_hi;
};

__global__ void __launch_bounds__(NTHREADS, 2) fwd_kernel(Args a) {
    extern __shared__ __attribute__((aligned(16))) unsigned char lds_raw[];
    LAS unsigned char* lds = (LAS unsigned char*)lds_raw;
    const int tid = threadIdx.x, lane = tid & 63, wave = __builtin_amdgcn_readfirstlane(tid >> 6);
    const int G = gridDim.x, bx = blockIdx.x;
    const int gw = bx * NWAVES + wave, ngw = G * NWAVES, gtid = bx * NTHREADS + tid, gthreads = G * NTHREADS;
    unsigned char* ws = a.ws;
    bf16_t* Wt_in = (bf16_t*)(ws + WS_WIN); bf16_t* Wt_co = (bf16_t*)(ws + WS_WCO); bf16_t* Wt_ao = (bf16_t*)(ws + WS_WAO); bf16_t* Wt_o = (bf16_t*)(ws + WS_WO); bf16_t* Wt_sc = (bf16_t*)(ws + WS_WSC);
    float* CS = (float*)(ws + WS_CS);
    bf16_t* XB = (bf16_t*)(ws + WS_XB); bf16_t* Zb = (bf16_t*)(ws + WS_Z); bf16_t* BG = (bf16_t*)(ws + WS_BG); bf16_t* Qb = (bf16_t*)(ws + WS_Q); bf16_t* Kb = (bf16_t*)(ws + WS_K); bf16_t* Vb = (bf16_t*)(ws + WS_V);
    bf16_t* Gb = (bf16_t*)a.out;
    unsigned char* UB = ws + WS_UB; unsigned char* VB = ws + WS_VB; float* USC = (float*)(ws + WS_USC); float* VSC = (float*)(ws + WS_VSC); bf16_t* T1 = (bf16_t*)(ws + WS_T1); bf16_t* MG = (bf16_t*)(ws + WS_MG);
    bf16_t* X1B = (bf16_t*)(ws + WS_X1B); float* SC = (float*)(ws + WS_SC);
    const int lo = a.ph_lo, hi = a.ph_hi;
    for (int u = tid; u < (LDS_BYTES - LDSCTL_OFF) / 4; u += NTHREADS) ((LAS unsigned*)(lds + LDSCTL_OFF))[u] = 0u;
    __syncthreads();
    XcdBarrier bar; bar.bar = (unsigned*)(ws + WS_CTL) + CW_BAR; bar.x = 0; bar.st = nullptr;
    if (MK_N_LAUNCHES == 1) bar = xcd_barrier_post((unsigned*)(ws + WS_CTL) + CW_BAR, (volatile LAS unsigned*)(lds + MISC_OFF) + 8);
#define IN(k) (lo <= (k) && (k) < hi)
#define REPS(k) for (int rep = (PROBE_REP == (k) ? 0 : 1); rep < 2; ++rep)
#define SEAM(k) do { if (IN(k) && IN((k) + 1)) xcd_barrier(bar); } while (0)

    if (IN(0)) REPS(0) {
        for (int it = bx; it < 256; it += G) wsc_item(a.w_pq, a.sub_keys, Wt_sc, lds, it, tid);
        LAS float* scr = (LAS float*)(lds + wave * 16384);
        constexpr int I_IN = (D / 64) * (NIN / 32), I_SQ = (D / 64) * (D / 32);
        for (int it = gw; it < I_IN + 3 * I_SQ; it += ngw) {
            int r = it;
            if (r < I_IN) { transpose_item<true>(a.w_in, D, NIN, Wt_in, scr, r, lane); continue; } r -= I_IN;
            if (r < I_SQ) { transpose_item<false>(a.w_conv_out, D, D, Wt_co, scr, r, lane); continue; } r -= I_SQ;
            if (r < I_SQ) { transpose_item<false>(a.w_attn_out, D, D, Wt_ao, scr, r, lane); continue; } r -= I_SQ;
            transpose_item<false>(a.w_o, D, D, Wt_o, scr, r, lane);
        }
        cvt_bf16(a.x, XB, (size_t)T * D, gtid, gthreads);
        for (int i = gtid; i < T * 8; i += gthreads) { const int t = i >> 3, f = i & 7;
            const float inv_freq = powf(500000.0f, -(float)f * 0.125f); const float ang = (float)a.positions[t] * inv_freq;
            CS[t * 16 + f] = cosf(ang); CS[t * 16 + 8 + f] = sinf(ang); }
    }
    SEAM(0);
    if (IN(1)) REPS(1) {
        pg8::Gemm g{XB, Wt_in, T, NIN, D}; pg8::StaticOrder S; S.init(T, NIN, G, bx);
        pg8::EpiProj E{Zb, BG, Qb, Kb, Vb, Gb, a.gate_b, CS};
        pg8::gemm_phase<pg8::EpiProj, pg8::StaticOrder, true, true>(lds, g, S, E);
    }
    SEAM(1);
    if (IN(2)) REPS(2) {
        bf16_t* Oatt = rep ? Qb : (bf16_t*)(ws + 12 * MiB);
        if (PROBE_SUB == 4) conv_phase(Zb, BG, (bf16_t*)(ws + 28 * MiB), a.conv_w, a.conv_b, gtid, gthreads);
        conv_phase(Zb, BG, rep ? BG : (bf16_t*)(ws + 28 * MiB), a.conv_w, a.conv_b, gtid, gthreads);
        float lam;
        { const float p1 = wave_sum(a.lq1[lane] * a.lk1[lane]), p2 = wave_sum(a.lq2[lane] * a.lk2[lane]); lam = __expf(p1) - __expf(p2) + LAM_INIT; }
        const int vcu = (G % 8 == 0) ? (bx & 7) * (G >> 3) + (bx >> 3) : bx;
        for (int ra = ((PROBE_SUB == 3 || PROBE_SUB == 5) ? 0 : 1); ra < 2; ++ra)
        for (int it = vcu; it < 512; it += G) {
            const int bh = it >> 3, pq = it & 7, b = bh >> 3, h = bh & 7;
            if (PROBE_SUB == 3 || PROBE_SUB == 5) Oatt = ra ? Qb : (bf16_t*)(ws + 12 * MiB);
            att::attn_unit(b, h, 15 - pq, Qb, Kb, Vb, Oatt, a.subln_g, lam, lds, tid);
            att::attn_unit(b, h, pq, Qb, Kb, Vb, Oatt, a.subln_g, lam, lds, tid);
        }
    }
    SEAM(2);
    if (IN(3)) REPS(3) {
        cvt_fp8_rows(a.u_tab, UB, USC, NEXP, gw, ngw, lane);
        cvt_fp8_rows(a.v_tab, VB, VSC, NEXP, gw, ngw, lane);
        pg8::Gemm g{BG, Wt_co, T, D, D}; pg8::StaticOrder S; S.init(T, D, G, bx);
        pg8::EpiGate1 E{Gb, T1};
        pg8::gemm_phase<pg8::EpiGate1, pg8::StaticOrder, true, true>(lds, g, S, E);
    }
    SEAM(3);
    if (IN(4)) REPS(4) {
        pg8::Gemm g{Qb, Wt_ao, T, D, D}; pg8::StaticOrder S; S.init(T, D, G, bx);
        pg8::EpiGate2 E{Gb, T1, MG};
        pg8::gemm_phase<pg8::EpiGate2, pg8::StaticOrder, true, true>(lds, g, S, E);
    }
    SEAM(4);
    if (IN(5)) REPS(5) {
        pg8::Gemm g{MG, Wt_o, T, D, D}; pg8::StaticOrder S; S.init(T, D, G, bx);
        pg8::EpiF32<true, 1024> E{a.x, a.out};
        pg8::gemm_phase<pg8::EpiF32<true, 1024>, pg8::StaticOrder, true, true>(lds, g, S, E);
    }
    SEAM(5);
    if (IN(6)) REPS(6) ln1_phase(a.out, rep ? a.out : (float*)(ws + 124 * MiB), X1B, a.ln1_g, a.ln1_b, gw, ngw, lane);
    SEAM(6);
    if (IN(7)) REPS(7) {
        pg8::Gemm g{X1B, Wt_sc, T, 2048, D}; pg8::StaticOrder S; S.init(T, 2048, G, bx);
        pg8::EpiF32<false, 2048> E{nullptr, SC};
        pg8::gemm_phase<pg8::EpiF32<false, 2048>, pg8::StaticOrder, true, true>(lds, g, S, E);
    }
    SEAM(7);
    if (IN(8)) REPS(8) {
        LAS unsigned char* wl = lds + wave * peer::WAVE_LDS;
        for (int t0 = gw * peer::TOK; t0 < T; t0 += ngw * peer::TOK) peer::wave_tokens(t0, SC, a.out, UB, VB, USC, VSC, a.ln2_g, a.ln2_b, wl, lane);
    }
#undef IN
#undef SEAM
}

extern "C" void kernel_launch(void* const* d_in, const int* in_sizes, int n_in, void* d_out, int out_size, void* d_ws, size_t ws_size, hipStream_t stream) {
    static int grid = 0;
    if (grid == 0) {
        if (n_in != 22 || out_size != T * D || ws_size < WS_END) { fprintf(stderr, "kernel_launch: unexpected shapes (n_in %d, out %d, ws %zu); nothing launched\n", n_in, out_size, ws_size); grid = -1; return; }
        int dev = 0, cus = 0, per_cu = 0;
        if (hipGetDevice(&dev) != hipSuccess || hipDeviceGetAttribute(&cus, hipDeviceAttributeMultiprocessorCount, dev) != hipSuccess) { grid = -1; return; }
        if (hipFuncSetAttribute((const void*)fwd_kernel, hipFuncAttributeMaxDynamicSharedMemorySize, LDS_BYTES) != hipSuccess) { fprintf(stderr, "kernel_launch: hipFuncSetAttribute failed\n"); grid = -1; return; }
        if (hipOccupancyMaxActiveBlocksPerMultiprocessor(&per_cu, (const void*)fwd_kernel, NTHREADS, LDS_BYTES) != hipSuccess || per_cu < 1) { fprintf(stderr, "kernel_launch: occupancy query failed (%d)\n", per_cu); (void)hipGetLastError(); per_cu = 1; }
        grid = cus * per_cu;
    }
    if (grid < 0) return;
    if (hipMemsetAsync((char*)d_ws + WS_CTL, 0, CTL_ZERO_BYTES, stream) != hipSuccess) { fprintf(stderr, "kernel_launch: hipMemsetAsync failed\n"); return; }
    Args a{};
    a.x = (const float*)d_in[0]; a.positions = (const int*)d_in[1]; a.w_in = (const float*)d_in[2]; a.conv_w = (const float*)d_in[3]; a.conv_b = (const float*)d_in[4]; a.gate_b = (const float*)d_in[5];
    a.lq1 = (const float*)d_in[6]; a.lk1 = (const float*)d_in[7]; a.lq2 = (const float*)d_in[8]; a.lk2 = (const float*)d_in[9]; a.subln_g = (const float*)d_in[10];
    a.w_conv_out = (const float*)d_in[11]; a.w_attn_out = (const float*)d_in[12]; a.w_o = (const float*)d_in[13]; a.ln1_g = (const float*)d_in[14]; a.ln1_b = (const float*)d_in[15];
    a.w_pq = (const float*)d_in[16]; a.sub_keys = (const float*)d_in[17]; a.u_tab = (const float*)d_in[18]; a.v_tab = (const float*)d_in[19]; a.ln2_g = (const float*)d_in[20]; a.ln2_b = (const float*)d_in[21];
    a.out = (float*)d_out; a.ws = (unsigned char*)d_ws;
#if MK_N_LAUNCHES == 1
    a.ph_lo = 0; a.ph_hi = NPHASES;
    void* args[] = {&a};
    hipError_t e = hipLaunchCooperativeKernel((const void*)fwd_kernel, dim3(grid), dim3(NTHREADS), args, LDS_BYTES, stream);
    if (e != hipSuccess) fprintf(stderr, "kernel_launch: cooperative launch failed: %s (grid %d)\n", hipGetErrorString(e), grid);
#else
    for (int p = 0; p < NPHASES; ++p) { a.ph_lo = p; a.ph_hi = p + 1; hipLaunchKernelGGL(fwd_kernel, dim3(grid), dim3(NTHREADS), LDS_BYTES, stream, a); }
#endif
}
```

```cpp
#include <hip/hip_runtime.h>
#include <hip/hip_cooperative_groups.h>
#include <cstdio>
#include <cstdint>
namespace cg = cooperative_groups;
namespace pg8 {
#define PG8_LAS __attribute__((address_space(3)))
typedef unsigned short bf16_t;
typedef short bf16x8 __attribute__((ext_vector_type(8)));
typedef float f32x4 __attribute__((ext_vector_type(4)));
typedef unsigned u32x4 __attribute__((ext_vector_type(4)));
constexpr int BM = 256, BK = 64, HALF = 128, HTB = HALF * BK * 2  , STAGE_BYTES = 8 * HTB, NXCD = 8, WGM = 8;

__host__ __device__ __forceinline__ int lds_byte(int r, int c) { const int st = (r >> 4) * 2 + (c >> 5), rr = r & 15, cc = c & 31, ob = rr * 64 + cc * 2; return st * 1024 + (ob ^ (((ob >> 9) & 1) << 5)); }
__host__ __device__ __forceinline__ void stage_rc(int b, int& R, int& C) { const int st = b / 1024, sb = b % 1024, swz = sb ^ (((sb >> 9) & 1) << 5); R = (st >> 1) * 16 + swz / 64; C = (st & 1) * 32 + (swz % 64) / 2; }
__host__ __device__ __forceinline__ int perm32(int rho) { const int n = rho >> 4, i = rho & 15; return 8 * (i >> 2) + 4 * n + (i & 3); }

struct Unit { int pm, pn; };
struct Gemm { const bf16_t* A; const bf16_t* Bt; int M, N, K; };

struct StaticOrder {
    int nM, nN, nwg, G, c;
    __host__ __device__ void init(int M, int N, int G_, int c_) { nM = M / BM; nN = N / BM; nwg = nM * nN; G = G_; c = c_; }
    __host__ __device__ bool next(int i, Unit& u) const {
        const long L = (long)i * G + c; if (L >= nwg) return false;
        int wgid = (int)L; { const int q = nwg / NXCD, r = nwg % NXCD, xcd = wgid % NXCD, off = wgid / NXCD; wgid = (xcd < r ? xcd * (q + 1) : r * (q + 1) + (xcd - r) * q) + off; }
        const int nig = WGM * nN, gid = wgid / nig, fm = gid * WGM, gsz = (nM - fm) < WGM ? (nM - fm) : WGM;
        u.pm = fm + ((wgid % nig) % gsz); u.pn = (wgid % nig) / gsz; return true;
    }
    __device__ __forceinline__ void a_ready(const Unit&) const {}
    __device__ __forceinline__ void done(const Unit&) const {}
};


__device__ __forceinline__ unsigned cvt_pk_bf16(float lo, float hi) { unsigned r; asm volatile("v_cvt_pk_bf16_f32 %0, %1, %2" : "=v"(r) : "v"(lo), "v"(hi)); return r; }
__device__ __forceinline__ void store8(bf16_t* p, f32x4 v0, f32x4 v1) {
    u32x4 w; w.x = cvt_pk_bf16(v0[0], v0[1]); w.y = cvt_pk_bf16(v0[2], v0[3]); w.z = cvt_pk_bf16(v1[0], v1[1]); w.w = cvt_pk_bf16(v1[2], v1[3]);
    *(u32x4*)p = w;
}
__device__ __forceinline__ void load8(const bf16_t* p, f32x4& v0, f32x4& v1) {
    const u32x4 w = *(const u32x4*)p;
    v0[0] = __uint_as_float(w.x << 16); v0[1] = __uint_as_float(w.x & 0xffff0000u); v0[2] = __uint_as_float(w.y << 16); v0[3] = __uint_as_float(w.y & 0xffff0000u);
    v1[0] = __uint_as_float(w.z << 16); v1[1] = __uint_as_float(w.z & 0xffff0000u); v1[2] = __uint_as_float(w.w << 16); v1[3] = __uint_as_float(w.w & 0xffff0000u);
}
constexpr float QSCALE = 0.125f * 1.4426950408889634f;

struct EpiProj {
    static constexpr bool PERM = true, AFTER_DRAIN = false;
    bf16_t *Z, *BG, *Q, *Kk, *V, *G; const float* gate_b; const float* CS; const float* RS;
    __device__ __forceinline__ void operator()(const f32x4 (&acc)[2][2][4][2], const Unit& u, int wr, int wc, int fr, int fq) const {
        asm volatile("" : "+v"(fr), "+v"(fq));
        const int row0 = u.pm * BM + wr * 64 + fr, pn = u.pn, cw = wc * 32 + 8 * fq;
        if (pn < 8) {
#pragma unroll
            for (int ai = 0; ai < 2; ++ai)
#pragma unroll
                for (int m = 0; m < 4; ++m) { const size_t row = row0 + ai * HALF + m * 16; const float rs = RS[row], rs2 = rs * rs;
                    store8(Z + row * 1024 + pn * 128 + cw, acc[ai][0][m][0] * acc[ai][1][m][0] * rs2, acc[ai][0][m][1] * acc[ai][1][m][1] * rs2); }
        } else if (pn < 12) {
#pragma unroll
            for (int ai = 0; ai < 2; ++ai)
#pragma unroll
                for (int m = 0; m < 4; ++m) { const size_t row = row0 + ai * HALF + m * 16; const float rs = RS[row];
#pragma unroll
                    for (int bj = 0; bj < 2; ++bj) store8(BG + row * 1024 + (pn - 8) * 256 + bj * HALF + cw, acc[ai][bj][m][0] * rs, acc[ai][bj][m][1] * rs); }
        } else if (pn < 20) {
            const bool isq = pn < 16; bf16_t* dst = isq ? Q : Kk; const int cb = ((pn - 12) & 3) * 256; const float sc = isq ? QSCALE : 1.0f;
            const bool rot = ((wc & 1) == 0) && (fq < 2);
#pragma unroll
            for (int ai = 0; ai < 2; ++ai)
#pragma unroll
                for (int m = 0; m < 4; ++m) { const size_t row = row0 + ai * HALF + m * 16; const float rs = RS[row] * sc;
                    f32x4 c4 = *(const f32x4*)(CS + row * 16 + 4 * (fq & 1)), s4 = *(const f32x4*)(CS + row * 16 + 8 + 4 * (fq & 1));
                    if (!rot) { c4 = (f32x4){1.f, 1.f, 1.f, 1.f}; s4 = (f32x4){0.f, 0.f, 0.f, 0.f}; }
                    c4 = c4 * rs; s4 = s4 * rs;
#pragma unroll
                    for (int bj = 0; bj < 2; ++bj) { const f32x4 v0 = acc[ai][bj][m][0], v1 = acc[ai][bj][m][1]; f32x4 o0, o1;
                        o0[0] = v0[0] * c4[0] - v0[1] * s4[0]; o0[1] = v0[1] * c4[0] + v0[0] * s4[0];
                        o0[2] = v0[2] * c4[1] - v0[3] * s4[1]; o0[3] = v0[3] * c4[1] + v0[2] * s4[1];
                        o1[0] = v1[0] * c4[2] - v1[1] * s4[2]; o1[1] = v1[1] * c4[2] + v1[0] * s4[2];
                        o1[2] = v1[2] * c4[3] - v1[3] * s4[3]; o1[3] = v1[3] * c4[3] + v1[2] * s4[3];
                        store8(dst + row * 1024 + cb + bj * HALF + cw, o0, o1); } }
        } else if (pn < 24) {
#pragma unroll
            for (int ai = 0; ai < 2; ++ai)
#pragma unroll
                for (int m = 0; m < 4; ++m) { const size_t row = row0 + ai * HALF + m * 16; const float rs = RS[row];
#pragma unroll
                    for (int bj = 0; bj < 2; ++bj) store8(V + row * 1024 + (pn - 20) * 256 + bj * HALF + cw, acc[ai][bj][m][0] * rs, acc[ai][bj][m][1] * rs); }
        } else {
            f32x4 bv[2][2];
#pragma unroll
            for (int bj = 0; bj < 2; ++bj)
#pragma unroll
                for (int n = 0; n < 2; ++n) bv[bj][n] = *(const f32x4*)(gate_b + (pn - 24) * 256 + bj * HALF + cw + 4 * n);
#pragma unroll
            for (int ai = 0; ai < 2; ++ai)
#pragma unroll
                for (int m = 0; m < 4; ++m) { const size_t row = row0 + ai * HALF + m * 16; const float rs = RS[row];
#pragma unroll
                    for (int bj = 0; bj < 2; ++bj) { f32x4 g0 = acc[ai][bj][m][0] * rs + bv[bj][0], g1 = acc[ai][bj][m][1] * rs + bv[bj][1];
#pragma unroll
                        for (int i = 0; i < 4; ++i) { g0[i] = 1.0f / (1.0f + __expf(-g0[i])); g1[i] = 1.0f / (1.0f + __expf(-g1[i])); }
                        store8(G + row * 2048 + (pn - 24) * 256 + bj * HALF + cw, g0, g1); } }
        }
    }
};
struct EpiGate1 {
    static constexpr bool PERM = true, AFTER_DRAIN = false;
    const bf16_t* G; bf16_t* T1;
    __device__ __forceinline__ void operator()(const f32x4 (&acc)[2][2][4][2], const Unit& u, int wr, int wc, int fr, int fq) const {
        const int row0 = u.pm * BM + wr * 64 + fr, col0 = u.pn * BM + wc * 32 + 8 * fq;
#pragma unroll
        for (int ai = 0; ai < 2; ++ai)
#pragma unroll
            for (int m = 0; m < 4; ++m) { const size_t row = row0 + ai * HALF + m * 16;
#pragma unroll
                for (int bj = 0; bj < 2; ++bj) { f32x4 g0, g1; load8(G + row * 2048 + col0 + bj * HALF, g0, g1);
                    store8(T1 + row * 1024 + col0 + bj * HALF, acc[ai][bj][m][0] * g0, acc[ai][bj][m][1] * g1); } }
    }
};
struct EpiGate2 {
    static constexpr bool PERM = true, AFTER_DRAIN = false;
    const bf16_t* G; const bf16_t* T1; bf16_t* MG;
    __device__ __forceinline__ void operator()(const f32x4 (&acc)[2][2][4][2], const Unit& u, int wr, int wc, int fr, int fq) const {
        const int row0 = u.pm * BM + wr * 64 + fr, col0 = u.pn * BM + wc * 32 + 8 * fq;
#pragma unroll
        for (int ai = 0; ai < 2; ++ai)
#pragma unroll
            for (int m = 0; m < 4; ++m) { const size_t row = row0 + ai * HALF + m * 16;
#pragma unroll
                for (int bj = 0; bj < 2; ++bj) { f32x4 g0, g1, t0, t1; load8(G + row * 2048 + 1024 + col0 + bj * HALF, g0, g1); load8(T1 + row * 1024 + col0 + bj * HALF, t0, t1);
                    store8(MG + row * 1024 + col0 + bj * HALF, t0 + acc[ai][bj][m][0] * g0, t1 + acc[ai][bj][m][1] * g1); } }
    }
};
template <bool HAS_BASE, int ldc> struct EpiF32 {
    static constexpr bool PERM = false, AFTER_DRAIN = false;
    static constexpr float alpha = 1.189207115002721f;
    const float* base; float* O;
    __device__ __forceinline__ void operator()(const f32x4 (&acc)[2][2][4][2], const Unit& u, int wr, int wc, int fr, int fq) const {
        const int row0 = u.pm * BM + wr * 64 + fr, col0 = u.pn * BM + wc * 32 + 4 * fq;
#pragma unroll
        for (int ai = 0; ai < 2; ++ai)
#pragma unroll
            for (int m = 0; m < 4; ++m) { const size_t row = row0 + ai * HALF + m * 16;
#pragma unroll
                for (int bj = 0; bj < 2; ++bj)
#pragma unroll
                    for (int n = 0; n < 2; ++n) { const size_t o = row * ldc + col0 + bj * HALF + n * 16; f32x4 v = acc[ai][bj][m][n];
                        if constexpr (HAS_BASE) v = v + alpha * *(const f32x4*)(base + o);
                        *(f32x4*)(O + o) = v; } }
    }
};

template <class Epi, class Sched, bool ALIGN_EPI = false, bool SP2 = false>
__device__ __forceinline__ void gemm_phase(PG8_LAS unsigned char* lds, const Gemm g, const Sched& S, const Epi& E) {
    int tid_ = threadIdx.x; asm volatile("" : "+v"(tid_));
    const int tid = tid_, wid = __builtin_amdgcn_readfirstlane(tid >> 6), lane = tid & 63, wr = wid >> 2, wc = wid & 3, fr = lane & 15, fq = lane >> 4;
    const int K = g.K, nt = K / BK;
    unsigned voffA[2], voffB[2];
#pragma unroll
    for (int i = 0; i < 2; ++i) { int R, C; stage_rc(tid * 16 + i * 8192, R, C); const int Rb = Epi::PERM ? ((R & ~31) + perm32(R & 31)) : R;
        voffA[i] = (unsigned)(R * K + C) * 2u; voffB[i] = (unsigned)(Rb * K + C) * 2u; }
    const size_t kstep = (size_t)(BK * 2);
    const size_t hstep = (size_t)HALF * K * 2;
    const size_t tstep = 2 * hstep;
    const unsigned ldsw = (unsigned)wid * 1024u;
    const int aoff = lds_byte(wr * 64 + fr, fq * 8), boff = lds_byte(wc * 32 + fr, fq * 8);
#define PG8_SA(b, h) (((b) * 2 + (h)) * HTB)
#define PG8_SB(b, h) ((4 + (b) * 2 + (h)) * HTB)
#define PG8_STAGE(bufoff, gbase, voff) do { _Pragma("unroll") for (int _i = 0; _i < 2; ++_i) \
        __builtin_amdgcn_global_load_lds((const unsigned*)((const char*)(gbase) + (voff)[_i]), (PG8_LAS unsigned*)(lds + (bufoff) + ldsw + _i * 8192), 16, 0, 0); } while (0)
#define PG8_LDA(dst, b, h) do { _Pragma("unroll") for (int m = 0; m < 4; ++m) _Pragma("unroll") for (int k = 0; k < 2; ++k) dst[m][k] = *(const PG8_LAS bf16x8*)(lds + PG8_SA(b, h) + aoff + m * 2048 + k * 1024); } while (0)
#define PG8_LDB(dst, b, h) do { _Pragma("unroll") for (int n = 0; n < 2; ++n) _Pragma("unroll") for (int k = 0; k < 2; ++k) dst[n][k] = *(const PG8_LAS bf16x8*)(lds + PG8_SB(b, h) + boff + n * 2048 + k * 1024); } while (0)
#define PG8_MMA(ai, bj, At, Bt) do { __builtin_amdgcn_s_setprio(1); _Pragma("unroll") for (int m = 0; m < 4; ++m) _Pragma("unroll") for (int n = 0; n < 2; ++n) _Pragma("unroll") for (int k = 0; k < 2; ++k) \
        acc[ai][bj][m][n] = __builtin_amdgcn_mfma_f32_16x16x32_bf16(Bt[n][k], At[m][k], acc[ai][bj][m][n], 0, 0, 0); __builtin_amdgcn_s_setprio(0); } while (0)
#define PG8_WAIT_V(n) asm volatile("s_waitcnt vmcnt(" #n ")" ::: "memory")
#define PG8_WAIT_L(n) asm volatile("s_waitcnt lgkmcnt(" #n ")" ::: "memory")
#define PG8_BAR __builtin_amdgcn_s_barrier()
#define PG8_SCHED __builtin_amdgcn_sched_barrier(0)
    Unit cur, nxt; int ui = 0;
    if (!S.next(0, cur)) return;
    f32x4 acc[2][2][4][2];
#pragma unroll
    for (int a = 0; a < 2; ++a)
#pragma unroll
        for (int b = 0; b < 2; ++b)
#pragma unroll
            for (int m = 0; m < 4; ++m)
#pragma unroll
                for (int n = 0; n < 2; ++n) acc[a][b][m][n] = (f32x4){0.f, 0.f, 0.f, 0.f};
    bf16x8 At[4][2], B0[2][2], B1[2][2];
    const char* cA = (const char*)g.A + (size_t)cur.pm * tstep; const char* cB = (const char*)g.Bt + (size_t)cur.pn * tstep;
    S.a_ready(cur);
    if constexpr (SP2) {
        PG8_STAGE(PG8_SB(0, 0), cB, voffB); PG8_STAGE(PG8_SB(0, 1), cB + hstep, voffB); PG8_STAGE(PG8_SA(0, 0), cA, voffA); PG8_STAGE(PG8_SA(0, 1), cA + hstep, voffA);
        if (wr == 1) PG8_BAR;
        PG8_WAIT_V(2); PG8_BAR;
        PG8_STAGE(PG8_SB(1, 0), cB + kstep, voffB); PG8_STAGE(PG8_SA(1, 0), cA + kstep, voffA); PG8_STAGE(PG8_SB(1, 1), cB + hstep + kstep, voffB);
        PG8_WAIT_V(6); PG8_BAR;
    } else {
        PG8_STAGE(PG8_SB(0, 0), cB, voffB); PG8_STAGE(PG8_SA(0, 0), cA, voffA); PG8_STAGE(PG8_SB(0, 1), cB + hstep, voffB); PG8_STAGE(PG8_SA(0, 1), cA + hstep, voffA);
        if (wr == 1) PG8_BAR;
        PG8_WAIT_V(4); PG8_BAR;
        PG8_STAGE(PG8_SB(1, 0), cB + kstep, voffB); PG8_STAGE(PG8_SA(1, 0), cA + kstep, voffA); PG8_STAGE(PG8_SB(1, 1), cB + hstep + kstep, voffB);
        PG8_WAIT_V(6); PG8_BAR;
    }
    for (;;) {
        const bool has_next = S.next(ui + 1, nxt);
        const char* nA = has_next ? (const char*)g.A + (size_t)nxt.pm * tstep : cA; const char* nB = has_next ? (const char*)g.Bt + (size_t)nxt.pn * tstep : cB;
        for (int t = 0; t < nt; t += 2) {
            const bool last = (t == nt - 2);
            const char* a1 = cA + (size_t)(t + 1) * kstep;
            const char* a2 = last ? nA : cA + (size_t)(t + 2) * kstep; const char* b2 = last ? nB : cB + (size_t)(t + 2) * kstep;
            const char* a3 = a2 + kstep; const char* b3 = b2 + kstep;
            if (last && has_next) S.a_ready(nxt);
            if constexpr (SP2) {
            PG8_LDB(B0, 0, 0); PG8_LDB(B1, 0, 1); PG8_SCHED; PG8_LDA(At, 0, 0); PG8_STAGE(PG8_SA(1, 1), a1 + hstep, voffA);
            PG8_WAIT_V(8); PG8_WAIT_L(0); PG8_BAR; PG8_MMA(0, 0, At, B0); PG8_MMA(0, 1, At, B1); PG8_BAR; PG8_SCHED;
            PG8_LDA(At, 0, 1); PG8_STAGE(PG8_SB(0, 0), b2, voffB); PG8_STAGE(PG8_SB(0, 1), b2 + hstep, voffB); PG8_STAGE(PG8_SA(0, 0), a2, voffA);
            PG8_WAIT_V(8); PG8_WAIT_L(0); PG8_BAR; PG8_MMA(1, 0, At, B0); PG8_MMA(1, 1, At, B1); PG8_BAR; PG8_SCHED;
            PG8_LDB(B0, 1, 0); PG8_LDB(B1, 1, 1); PG8_SCHED; PG8_LDA(At, 1, 0); PG8_STAGE(PG8_SA(0, 1), a2 + hstep, voffA);
            PG8_WAIT_V(8); PG8_WAIT_L(0); PG8_BAR; PG8_MMA(0, 0, At, B0); PG8_MMA(0, 1, At, B1); PG8_BAR; PG8_SCHED;
            PG8_LDA(At, 1, 1); PG8_STAGE(PG8_SB(1, 0), b3, voffB); PG8_STAGE(PG8_SB(1, 1), b3 + hstep, voffB); PG8_STAGE(PG8_SA(1, 0), a3, voffA);
            PG8_WAIT_V(8); PG8_WAIT_L(0); PG8_BAR; PG8_MMA(1, 0, At, B0); PG8_MMA(1, 1, At, B1); PG8_BAR; PG8_SCHED;
            } else {
            PG8_LDB(B0, 0, 0); PG8_SCHED; PG8_LDA(At, 0, 0); PG8_STAGE(PG8_SA(1, 1), a1 + hstep, voffA);
            PG8_WAIT_L(8); PG8_BAR; PG8_WAIT_L(0); PG8_MMA(0, 0, At, B0); PG8_BAR; PG8_SCHED;
            PG8_LDB(B1, 0, 1); PG8_STAGE(PG8_SB(0, 0), b2, voffB);
            PG8_BAR; PG8_WAIT_L(0); PG8_MMA(0, 1, At, B1); PG8_BAR;
            PG8_LDA(At, 0, 1); PG8_STAGE(PG8_SA(0, 0), a2, voffA);
            PG8_BAR; PG8_WAIT_L(0); PG8_MMA(1, 0, At, B0); PG8_BAR; PG8_SCHED;
            PG8_STAGE(PG8_SB(0, 1), b2 + hstep, voffB);
            PG8_WAIT_V(6); PG8_BAR; PG8_MMA(1, 1, At, B1); PG8_BAR;
            PG8_LDB(B0, 1, 0); PG8_SCHED; PG8_LDA(At, 1, 0); PG8_STAGE(PG8_SA(0, 1), a2 + hstep, voffA);
            PG8_WAIT_L(8); PG8_BAR; PG8_WAIT_L(0); PG8_MMA(0, 0, At, B0); PG8_BAR; PG8_SCHED;
            PG8_LDB(B1, 1, 1); PG8_STAGE(PG8_SB(1, 0), b3, voffB);
            PG8_BAR; PG8_WAIT_L(0); PG8_MMA(0, 1, At, B1); PG8_BAR;
            PG8_LDA(At, 1, 1); PG8_STAGE(PG8_SA(1, 0), a3, voffA);
            PG8_BAR; PG8_WAIT_L(0); PG8_MMA(1, 0, At, B0); PG8_BAR; PG8_SCHED;
            PG8_STAGE(PG8_SB(1, 1), b3 + hstep, voffB);
            PG8_WAIT_V(6); PG8_BAR; PG8_MMA(1, 1, At, B1); PG8_BAR;
            }
        }
        if constexpr (ALIGN_EPI) { if (wr == 0) PG8_BAR; }
        if constexpr (!Epi::AFTER_DRAIN) { E(acc, cur, wr, wc, fr, fq); S.done(cur); }
        if (!has_next) break;
#pragma unroll
        for (int a = 0; a < 2; ++a)
#pragma unroll
            for (int b = 0; b < 2; ++b)
#pragma unroll
                for (int m = 0; m < 4; ++m)
#pragma unroll
                    for (int n = 0; n < 2; ++n) acc[a][b][m][n] = (f32x4){0.f, 0.f, 0.f, 0.f};
        cur = nxt; cA = nA; cB = nB; ++ui;
        if constexpr (ALIGN_EPI) { if (wr == 1) PG8_BAR; }
    }
    PG8_WAIT_V(0);
    if constexpr (!ALIGN_EPI) { if (wr == 0) PG8_BAR; }
    PG8_BAR;
    if constexpr (Epi::AFTER_DRAIN) { E.fused(acc, cur, wr, wc, fr, fq, lds, wid, lane); S.done(cur); }
#undef PG8_SA
#undef PG8_SB
#undef PG8_STAGE
#undef PG8_LDA
#undef PG8_LDB
#undef PG8_MMA
#undef PG8_WAIT_V
#undef PG8_WAIT_L
#undef PG8_BAR
#undef PG8_SCHED
}

typedef int i32x8 __attribute__((ext_vector_type(8)));
typedef int i32x4 __attribute__((ext_vector_type(4)));
template <class Epi, class Sched, bool ALIGN_EPI = false, bool SP2 = false>
__device__ __forceinline__ void gemm_phase_f8(PG8_LAS unsigned char* lds, const Gemm g, const Sched& S, const Epi& E) {
    int tid_ = threadIdx.x; asm volatile("" : "+v"(tid_));
    const int tid = tid_, wid = __builtin_amdgcn_readfirstlane(tid >> 6), lane = tid & 63, wr = wid >> 2, wc = wid & 3, fr = lane & 15, fq = lane >> 4;
    const int K = g.K  , nt = K / 128;
    unsigned voffA[2], voffB[2];
#pragma unroll
    for (int i = 0; i < 2; ++i) { int R, C; stage_rc(tid * 16 + i * 8192, R, C); const int Rb = Epi::PERM ? ((R & ~31) + perm32(R & 31)) : R;
        voffA[i] = (unsigned)(R * K + C * 2); voffB[i] = (unsigned)(Rb * K + C * 2); }
    const size_t kstep = (size_t)(BK * 2);
    const size_t hstep = (size_t)HALF * K;
    const size_t tstep = 2 * hstep;
    const unsigned ldsw = (unsigned)wid * 1024u;
    const int aoff = lds_byte(wr * 64 + fr, fq * 16), boff = lds_byte(wc * 32 + fr, fq * 16);
#define PG8_SA(b, h) (((b) * 2 + (h)) * HTB)
#define PG8_SB(b, h) ((4 + (b) * 2 + (h)) * HTB)
#define PG8_STAGE(bufoff, gbase, voff) do { _Pragma("unroll") for (int _i = 0; _i < 2; ++_i) \
        __builtin_amdgcn_global_load_lds((const unsigned*)((const char*)(gbase) + (voff)[_i]), (PG8_LAS unsigned*)(lds + (bufoff) + ldsw + _i * 8192), 16, 0, 0); } while (0)
#define PG8_LDA(dst, b, h) do { _Pragma("unroll") for (int m = 0; m < 4; ++m) dst[m] = __builtin_shufflevector(*(const PG8_LAS i32x4*)(lds + PG8_SA(b, h) + aoff + m * 2048), *(const PG8_LAS i32x4*)(lds + PG8_SA(b, h) + aoff + m * 2048 + 16), 0, 1, 2, 3, 4, 5, 6, 7); } while (0)
#define PG8_LDB(dst, b, h) do { _Pragma("unroll") for (int n = 0; n < 2; ++n) dst[n] = __builtin_shufflevector(*(const PG8_LAS i32x4*)(lds + PG8_SB(b, h) + boff + n * 2048), *(const PG8_LAS i32x4*)(lds + PG8_SB(b, h) + boff + n * 2048 + 16), 0, 1, 2, 3, 4, 5, 6, 7); } while (0)
#define PG8_MMA(ai, bj, At, Bt) do { __builtin_amdgcn_s_setprio(1); _Pragma("unroll") for (int m = 0; m < 4; ++m) _Pragma("unroll") for (int n = 0; n < 2; ++n) \
        asm volatile("v_mfma_f32_16x16x128_f8f6f4 %0, %1, %2, %0" : "+v"(acc[ai][bj][m][n]) : "v"(Bt[n]), "v"(At[m])); __builtin_amdgcn_s_setprio(0); } while (0)
#define PG8_WAIT_V(n) asm volatile("s_waitcnt vmcnt(" #n ")" ::: "memory")
#define PG8_WAIT_L(n) asm volatile("s_waitcnt lgkmcnt(" #n ")" ::: "memory")
#define PG8_BAR __builtin_amdgcn_s_barrier()
#define PG8_SCHED __builtin_amdgcn_sched_barrier(0)
    Unit cur, nxt; int ui = 0;
    if (!S.next(0, cur)) return;
    f32x4 acc[2][2][4][2];
#pragma unroll
    for (int a = 0; a < 2; ++a)
#pragma unroll
        for (int b = 0; b < 2; ++b)
#pragma unroll
            for (int m = 0; m < 4; ++m)
#pragma unroll
                for (int n = 0; n < 2; ++n) acc[a][b][m][n] = (f32x4){0.f, 0.f, 0.f, 0.f};
    i32x8 At[4], B0[2], B1[2];
    const char* cA = (const char*)g.A + (size_t)cur.pm * tstep; const char* cB = (const char*)g.Bt + (size_t)cur.pn * tstep;
    S.a_ready(cur);
    if constexpr (SP2) {
        PG8_STAGE(PG8_SB(0, 0), cB, voffB); PG8_STAGE(PG8_SB(0, 1), cB + hstep, voffB); PG8_STAGE(PG8_SA(0, 0), cA, voffA); PG8_STAGE(PG8_SA(0, 1), cA + hstep, voffA);
        if (wr == 1) PG8_BAR;
        PG8_WAIT_V(2); PG8_BAR;
        PG8_STAGE(PG8_SB(1, 0), cB + kstep, voffB); PG8_STAGE(PG8_SA(1, 0), cA + kstep, voffA); PG8_STAGE(PG8_SB(1, 1), cB + hstep + kstep, voffB);
        PG8_WAIT_V(6); PG8_BAR;
    } else {
        PG8_STAGE(PG8_SB(0, 0), cB, voffB); PG8_STAGE(PG8_SA(0, 0), cA, voffA); PG8_STAGE(PG8_SB(0, 1), cB + hstep, voffB); PG8_STAGE(PG8_SA(0, 1), cA + hstep, voffA);
        if (wr == 1) PG8_BAR;
        PG8_WAIT_V(4); PG8_BAR;
        PG8_STAGE(PG8_SB(1, 0), cB + kstep, voffB); PG8_STAGE(PG8_SA(1, 0), cA + kstep, voffA); PG8_STAGE(PG8_SB(1, 1), cB + hstep + kstep, voffB);
        PG8_WAIT_V(6); PG8_BAR;
    }
    for (;;) {
        const bool has_next = S.next(ui + 1, nxt);
        const char* nA = has_next ? (const char*)g.A + (size_t)nxt.pm * tstep : cA; const char* nB = has_next ? (const char*)g.Bt + (size_t)nxt.pn * tstep : cB;
#pragma unroll 1
        for (int t = 0; t < nt; t += 2) {
            const bool last = (t == nt - 2);
            const char* a1 = cA + (size_t)(t + 1) * kstep;
            const char* a2 = last ? nA : cA + (size_t)(t + 2) * kstep; const char* b2 = last ? nB : cB + (size_t)(t + 2) * kstep;
            const char* a3 = a2 + kstep; const char* b3 = b2 + kstep;
            if (last && has_next) S.a_ready(nxt);
            if constexpr (SP2) {
            PG8_LDB(B0, 0, 0); PG8_LDB(B1, 0, 1); PG8_SCHED; PG8_LDA(At, 0, 0); PG8_STAGE(PG8_SA(1, 1), a1 + hstep, voffA);
            PG8_WAIT_V(8); PG8_WAIT_L(0); PG8_BAR; PG8_MMA(0, 0, At, B0); PG8_MMA(0, 1, At, B1); PG8_BAR; PG8_SCHED;
            PG8_LDA(At, 0, 1); PG8_STAGE(PG8_SB(0, 0), b2, voffB); PG8_STAGE(PG8_SB(0, 1), b2 + hstep, voffB); PG8_STAGE(PG8_SA(0, 0), a2, voffA);
            PG8_WAIT_V(8); PG8_WAIT_L(0); PG8_BAR; PG8_MMA(1, 0, At, B0); PG8_MMA(1, 1, At, B1); PG8_BAR; PG8_SCHED;
            PG8_LDB(B0, 1, 0); PG8_LDB(B1, 1, 1); PG8_SCHED; PG8_LDA(At, 1, 0); PG8_STAGE(PG8_SA(0, 1), a2 + hstep, voffA);
            PG8_WAIT_V(8); PG8_WAIT_L(0); PG8_BAR; PG8_MMA(0, 0, At, B0); PG8_MMA(0, 1, At, B1); PG8_BAR; PG8_SCHED;
            PG8_LDA(At, 1, 1); PG8_STAGE(PG8_SB(1, 0), b3, voffB); PG8_STAGE(PG8_SB(1, 1), b3 + hstep, voffB); PG8_STAGE(PG8_SA(1, 0), a3, voffA);
            PG8_WAIT_V(8); PG8_WAIT_L(0); PG8_BAR; PG8_MMA(1, 0, At, B0); PG8_MMA(1, 1, At, B1); PG8_BAR; PG8_SCHED;
            } else {
            PG8_LDB(B0, 0, 0); PG8_SCHED; PG8_LDA(At, 0, 0); PG8_STAGE(PG8_SA(1, 1), a1 + hstep, voffA);
            PG8_WAIT_L(8); PG8_BAR; PG8_WAIT_L(0); PG8_MMA(0, 0, At, B0); PG8_BAR; PG8_SCHED;
            PG8_LDB(B1, 0, 1); PG8_STAGE(PG8_SB(0, 0), b2, voffB);
            PG8_BAR; PG8_WAIT_L(0); PG8_MMA(0, 1, At, B1); PG8_BAR;
            PG8_LDA(At, 0, 1); PG8_STAGE(PG8_SA(0, 0), a2, voffA);
            PG8_BAR; PG8_WAIT_L(0); PG8_MMA(1, 0, At, B0); PG8_BAR; PG8_SCHED;
            PG8_STAGE(PG8_SB(0, 1), b2 + hstep, voffB);
            PG8_WAIT_V(6); PG8_BAR; PG8_MMA(1, 1, At, B1); PG8_BAR;
            PG8_LDB(B0, 1, 0); PG8_SCHED; PG8_LDA(At, 1, 0); PG8_STAGE(PG8_SA(0, 1), a2 + hstep, voffA);
            PG8_WAIT_L(8); PG8_BAR; PG8_WAIT_L(0); PG8_MMA(0, 0, At, B0); PG8_BAR; PG8_SCHED;
            PG8_LDB(B1, 1, 1); PG8_STAGE(PG8_SB(1, 0), b3, voffB);
            PG8_BAR; PG8_WAIT_L(0); PG8_MMA(0, 1, At, B1); PG8_BAR;
            PG8_LDA(At, 1, 1); PG8_STAGE(PG8_SA(1, 0), a3, voffA);
            PG8_BAR; PG8_WAIT_L(0); PG8_MMA(1, 0, At, B0); PG8_BAR; PG8_SCHED;
            PG8_STAGE(PG8_SB(1, 1), b3 + hstep, voffB);
            PG8_WAIT_V(6); PG8_BAR; PG8_MMA(1, 1, At, B1); PG8_BAR;
            }
        }
        if constexpr (ALIGN_EPI) { if (wr == 0) PG8_BAR; }
        asm volatile("s_nop 15\n\ts_nop 15" ::: "memory");
        if constexpr (!Epi::AFTER_DRAIN) { E(acc, cur, wr, wc, fr, fq); S.done(cur); }
        if (!has_next) break;
#pragma unroll
        for (int a = 0; a < 2; ++a)
#pragma unroll
            for (int b = 0; b < 2; ++b)
#pragma unroll
                for (int m = 0; m < 4; ++m)
#pragma unroll
                    for (int n = 0; n < 2; ++n) acc[a][b][m][n] = (f32x4){0.f, 0.f, 0.f, 0.f};
        cur = nxt; cA = nA; cB = nB; ++ui;
        if constexpr (ALIGN_EPI) { if (wr == 1) PG8_BAR; }
    }
    PG8_WAIT_V(0);
    if constexpr (!ALIGN_EPI) { if (wr == 0) PG8_BAR; }
    PG8_BAR;
    if constexpr (Epi::AFTER_DRAIN) { E.fused(acc, cur, wr, wc, fr, fq, lds, wid, lane); S.done(cur); }
#undef PG8_SA
#undef PG8_SB
#undef PG8_STAGE
#undef PG8_LDA
#undef PG8_LDB
#undef PG8_MMA
#undef PG8_WAIT_V
#undef PG8_WAIT_L
#undef PG8_BAR
#undef PG8_SCHED
}
}

constexpr int T = 16384, D = 1024, SEQ = 2048, NBATCH = 8, NIN = 8192;
constexpr int NHEAD = 8, NEXP = 16384;
constexpr float LN_EPS = 1e-5f;
constexpr float ALPHA = 1.189207115002721f;
constexpr float LAM_INIT = 0.2f;
constexpr int NWAVES = 8, NTHREADS = 512;
constexpr int LDS_BYTES = 147456;
constexpr int NPHASES = 9;
constexpr int RING_BYTES = 131072, LDSCTL_OFF = RING_BYTES, MISC_OFF = LDSCTL_OFF + 320;
constexpr int CW_BAR = 4096;
constexpr size_t CTL_ZERO_BYTES = 65536;
#ifndef PROBE_REP
#define PROBE_REP -1
#endif
#ifndef PROBE_SUB
#define PROBE_SUB 0
#endif
#ifndef MK_N_LAUNCHES
#define MK_N_LAUNCHES 1
#endif

typedef unsigned short bf16_t;
typedef short bf16x8 __attribute__((ext_vector_type(8)));
typedef short s16x4 __attribute__((ext_vector_type(4)));
typedef float f32x4 __attribute__((ext_vector_type(4)));
typedef float f32x16 __attribute__((ext_vector_type(16)));
typedef unsigned u32x4 __attribute__((ext_vector_type(4)));
typedef unsigned u32x2 __attribute__((ext_vector_type(2)));
#define LAS __attribute__((address_space(3)))
#define LDS_WAIT() asm volatile("s_waitcnt lgkmcnt(0)" ::: "memory")

constexpr size_t MiB = 1u << 20;
constexpr size_t WS_CTL = 0, WS_CS = 1 * MiB, WS_WCO = 2 * MiB, WS_WAO = 4 * MiB, WS_WO = 6 * MiB, WS_WSC = 8 * MiB;
constexpr size_t WS_WIN = 12 * MiB, WS_XB = 28 * MiB, WS_Z = 60 * MiB, WS_BG = 92 * MiB, WS_Q = 124 * MiB, WS_K = 156 * MiB, WS_V = 188 * MiB;
constexpr size_t WS_UB = 12 * MiB, WS_VB = 28 * MiB, WS_USC = 44 * MiB, WS_VSC = 44 * MiB + 65536;
constexpr size_t WS_T1 = 156 * MiB, WS_MG = 188 * MiB;
constexpr size_t WS_X1B = 76 * MiB;
constexpr size_t WS_SC = 124 * MiB;
constexpr size_t WS_END = 252 * MiB;
constexpr size_t WS_RS = 131072;
constexpr float W_IN_SCALE = 64.0f;

__device__ __forceinline__ unsigned f2bf(float f) { unsigned u = __builtin_bit_cast(unsigned, f); return (u + 0x7fffu + ((u >> 16) & 1u)) >> 16; }
__device__ __forceinline__ unsigned pk2(float lo, float hi) { return f2bf(lo) | (f2bf(hi) << 16); }
__device__ __forceinline__ float bflo(unsigned w) { return __uint_as_float(w << 16); }
__device__ __forceinline__ float bfhi(unsigned w) { return __uint_as_float(w & 0xffff0000u); }
__device__ __forceinline__ float wave_sum(float v) {
#pragma unroll
    for (int o = 1; o < 64; o <<= 1) v += __shfl_xor(v, o);
    return v;
}
__device__ __forceinline__ float wave_max(float v) {
#pragma unroll
    for (int o = 1; o < 64; o <<= 1) v = fmaxf(v, __shfl_xor(v, o));
    return v;
}
__device__ __forceinline__ float wave_min(float v) {
#pragma unroll
    for (int o = 1; o < 64; o <<= 1) v = fminf(v, __shfl_xor(v, o));
    return v;
}

__device__ __forceinline__ int win_src(int n) {
    if (n < 2048) { const int i = n >> 8, r = n & 255; return r < 128 ? 128 * i + r : 2048 + 128 * i + (r - 128); }
    if (n < 3072) return 1024 + (n - 2048);
    if (n < 5120) { const int base = n - 3072, which = base >> 10, within = base & 1023, map = within >> 6, p = within & 63; const int d = p < 16 ? (p >> 1) + 8 * (p & 1) : p; return 3072 + which * 1024 + map * 64 + d; }
    return n;
}
template <bool PERMUTE>
__device__ __forceinline__ void transpose_item(const float* W, int K, int N, bf16_t* WT, LAS float* scr, int item, int lane) {
    const int nblk = N / 32, kb = item / nblk, nb = item % nblk, k0 = 64 * kb, n0 = 32 * nb;
    const int nsrc = PERMUTE ? win_src(n0 + (lane & 31)) : n0 + (lane & 31);
#pragma unroll 8
    for (int i = 0; i < 32; ++i) { const int kk = 2 * i + (lane >> 5); scr[kk * 33 + (lane & 31)] = W[(size_t)(k0 + kk) * N + nsrc]; }
    LDS_WAIT();
    const int c = lane & 7;
#pragma unroll
    for (int j = 0; j < 4; ++j) { const int n = (lane >> 3) + 8 * j; const LAS float* s = scr + (8 * c) * 33 + n;
        u32x4 o; o.x = pk2(s[0 * 33], s[1 * 33]); o.y = pk2(s[2 * 33], s[3 * 33]); o.z = pk2(s[4 * 33], s[5 * 33]); o.w = pk2(s[6 * 33], s[7 * 33]);
        *(u32x4*)(WT + (size_t)(n0 + n) * K + k0 + 8 * c) = o; }
    LDS_WAIT();
}
__device__ __forceinline__ void cvt_bf16(const float* src, bf16_t* dst, size_t n, int gtid, int gthreads) {
    const size_t n8 = n / 8;
    for (size_t i = gtid; i < n8; i += gthreads) {
        const f32x4 a = *(const f32x4*)(src + i * 8), b = *(const f32x4*)(src + i * 8 + 4);
        u32x4 o; o.x = pk2(a[0], a[1]); o.y = pk2(a[2], a[3]); o.z = pk2(b[0], b[1]); o.w = pk2(b[2], b[3]);
        *(u32x4*)(dst + i * 8) = o;
    }
}
typedef float f32x2 __attribute__((ext_vector_type(2)));
__device__ __forceinline__ void cvt_fp8_rows(const float* src, unsigned char* dst, float* scale, int nrows, int gw, int ngw, int lane) {
    for (int r = gw; r < nrows; r += ngw) {
        const f32x4* p = (const f32x4*)(src + (size_t)r * 1024) + 4 * lane;
        f32x4 v[4]; float m = 0.f;
#pragma unroll
        for (int j = 0; j < 4; ++j) { v[j] = p[j]; m = fmaxf(m, fmaxf(fmaxf(fabsf(v[j][0]), fabsf(v[j][1])), fmaxf(fabsf(v[j][2]), fabsf(v[j][3])))); }
        m = wave_max(m);
        const float sc = m > 0.f ? 384.0f / m : 1.0f;
        u32x4 o;
#pragma unroll
        for (int j = 0; j < 4; ++j) { int w = __builtin_amdgcn_cvt_pk_fp8_f32(v[j][0] * sc, v[j][1] * sc, 0, false); w = __builtin_amdgcn_cvt_pk_fp8_f32(v[j][2] * sc, v[j][3] * sc, w, true); o[j] = (unsigned)w; }
        *(u32x4*)(dst + ((size_t)(lane >> 3) * nrows + r) * 128 + 16 * (lane & 7)) = o;
        if (lane == 0) scale[r] = m > 0.f ? m * (1.0f / 384.0f) : 1.0f;
    }
}
__device__ __forceinline__ void cvt_fp8_rows_plain(const float* src, unsigned char* dst, float* rs, float wmul, int nrows, int gw, int ngw, int lane) {
    for (int r = gw; r < nrows; r += ngw) {
        const f32x4* p = (const f32x4*)(src + (size_t)r * 1024) + 4 * lane;
        f32x4 v[4]; float m = 0.f;
#pragma unroll
        for (int j = 0; j < 4; ++j) { v[j] = p[j]; m = fmaxf(m, fmaxf(fmaxf(fabsf(v[j][0]), fabsf(v[j][1])), fmaxf(fabsf(v[j][2]), fabsf(v[j][3])))); }
        m = wave_max(m);
        const float sc = m > 0.f ? 256.0f / m : 1.0f;
        u32x4 o;
#pragma unroll
        for (int j = 0; j < 4; ++j) { int w = __builtin_amdgcn_cvt_pk_fp8_f32(v[j][0] * sc, v[j][1] * sc, 0, false); w = __builtin_amdgcn_cvt_pk_fp8_f32(v[j][2] * sc, v[j][3] * sc, w, true); o[j] = (unsigned)w; }
        *(u32x4*)(dst + (size_t)r * 1024 + 16 * lane) = o;
        if (lane == 0) rs[r] = (m > 0.f ? m * (1.0f / 256.0f) : 1.0f) * wmul;
    }
}
template <bool PERMUTE>
__device__ __forceinline__ void transpose_item_f8(const float* W, int K, int N, unsigned char* WT, LAS float* scr, int item, int lane, float wscale) {
    const int nblk = N / 32, kb = item / nblk, nb = item % nblk, k0 = 64 * kb, n0 = 32 * nb;
    const int nsrc = PERMUTE ? win_src(n0 + (lane & 31)) : n0 + (lane & 31);
#pragma unroll 8
    for (int i = 0; i < 32; ++i) { const int kk = 2 * i + (lane >> 5); scr[kk * 33 + (lane & 31)] = W[(size_t)(k0 + kk) * N + nsrc]; }
    LDS_WAIT();
    const int c = lane & 7;
#pragma unroll
    for (int j = 0; j < 4; ++j) { const int n = (lane >> 3) + 8 * j; const LAS float* s = scr + (8 * c) * 33 + n;
        int w0 = __builtin_amdgcn_cvt_pk_fp8_f32(s[0 * 33] * wscale, s[1 * 33] * wscale, 0, false); w0 = __builtin_amdgcn_cvt_pk_fp8_f32(s[2 * 33] * wscale, s[3 * 33] * wscale, w0, true);
        int w1 = __builtin_amdgcn_cvt_pk_fp8_f32(s[4 * 33] * wscale, s[5 * 33] * wscale, 0, false); w1 = __builtin_amdgcn_cvt_pk_fp8_f32(s[6 * 33] * wscale, s[7 * 33] * wscale, w1, true);
        u32x2 o; o.x = (unsigned)w0; o.y = (unsigned)w1;
        *(u32x2*)(WT + (size_t)(n0 + n) * K + k0 + 8 * c) = o; }
    LDS_WAIT();
}
__device__ __forceinline__ void unpack16_fp8(const u32x4 a, float (&f)[16]) {
#pragma unroll
    for (int j = 0; j < 4; ++j) { const f32x2 lo = __builtin_amdgcn_cvt_pk_f32_fp8((int)a[j], false), hi = __builtin_amdgcn_cvt_pk_f32_fp8((int)a[j], true);
        f[4 * j] = lo[0]; f[4 * j + 1] = lo[1]; f[4 * j + 2] = hi[0]; f[4 * j + 3] = hi[1]; }
}
__device__ __forceinline__ void wsc_item(const float* w_pq, const float* sub_keys, bf16_t* Wsc, LAS unsigned char* lds, int item, int tid) {
    const int hc = item >> 4, d0 = (item & 15) * 64;
    LAS float* kl = (LAS float*)lds; LAS float* wl = (LAS float*)(lds + 67584);
    for (int i = tid; i < 128 * 32; i += NTHREADS) { const int n = i >> 5, j4 = (i & 31) * 4; *(LAS f32x4*)(kl + n * 132 + j4) = *(const f32x4*)(sub_keys + ((size_t)hc * 128 + n) * 128 + j4); }
    for (int i = tid; i < 64 * 32; i += NTHREADS) { const int dd = i >> 5, j4 = (i & 31) * 4; *(LAS f32x4*)(wl + dd * 128 + j4) = *(const f32x4*)(w_pq + (size_t)(d0 + dd) * 2048 + hc * 128 + j4); }
    __syncthreads();
    const int n = tid & 127, dq = tid >> 7;
    float acc[16];
#pragma unroll
    for (int i = 0; i < 16; ++i) acc[i] = 0.f;
    for (int j4 = 0; j4 < 128; j4 += 4) {
        const f32x4 kv = *(const LAS f32x4*)(kl + n * 132 + j4);
#pragma unroll
        for (int i = 0; i < 16; ++i) { const f32x4 wv = *(const LAS f32x4*)(wl + (dq * 16 + i) * 128 + j4); acc[i] += kv[0] * wv[0] + kv[1] * wv[1] + kv[2] * wv[2] + kv[3] * wv[3]; }
    }
    u32x4 o0, o1;
    o0.x = pk2(acc[0], acc[1]); o0.y = pk2(acc[2], acc[3]); o0.z = pk2(acc[4], acc[5]); o0.w = pk2(acc[6], acc[7]);
    o1.x = pk2(acc[8], acc[9]); o1.y = pk2(acc[10], acc[11]); o1.z = pk2(acc[12], acc[13]); o1.w = pk2(acc[14], acc[15]);
    bf16_t* dst = Wsc + (size_t)(hc * 128 + n) * 1024 + d0 + dq * 16;
    *(u32x4*)dst = o0; *(u32x4*)(dst + 8) = o1;
    __syncthreads();
}

__device__ __forceinline__ void conv_phase(const bf16_t* Z, const bf16_t* BG, bf16_t* OUT, const float* conv_w, const float* conv_b, int gtid, int gthreads) {
    for (int it = gtid; it < (T / 16) * 128; it += gthreads) {
        const int rb = it >> 7, cc = it & 127, t0 = rb * 16, c0 = cc * 8;
        float w0[8], w1[8], w2[8], cb[8];
#pragma unroll
        for (int i = 0; i < 8; ++i) { w0[i] = conv_w[c0 + i]; w1[i] = conv_w[1024 + c0 + i]; w2[i] = conv_w[2048 + c0 + i]; cb[i] = conv_b[c0 + i]; }
        float zm2[8], zm1[8];
        if ((t0 & (SEQ - 1)) != 0) {
            const u32x4 a = *(const u32x4*)(Z + (size_t)(t0 - 2) * 1024 + c0), b = *(const u32x4*)(Z + (size_t)(t0 - 1) * 1024 + c0);
            zm2[0] = bflo(a.x); zm2[1] = bfhi(a.x); zm2[2] = bflo(a.y); zm2[3] = bfhi(a.y); zm2[4] = bflo(a.z); zm2[5] = bfhi(a.z); zm2[6] = bflo(a.w); zm2[7] = bfhi(a.w);
            zm1[0] = bflo(b.x); zm1[1] = bfhi(b.x); zm1[2] = bflo(b.y); zm1[3] = bfhi(b.y); zm1[4] = bflo(b.z); zm1[5] = bfhi(b.z); zm1[6] = bflo(b.w); zm1[7] = bfhi(b.w);
        } else {
#pragma unroll
            for (int i = 0; i < 8; ++i) { zm2[i] = 0.f; zm1[i] = 0.f; }
        }
#pragma unroll 4
        for (int r = 0; r < 16; ++r) {
            const size_t o = (size_t)(t0 + r) * 1024 + c0;
            const u32x4 a = *(const u32x4*)(Z + o), g = *(const u32x4*)(BG + o);
            float z[8], bgv[8], y[8];
            z[0] = bflo(a.x); z[1] = bfhi(a.x); z[2] = bflo(a.y); z[3] = bfhi(a.y); z[4] = bflo(a.z); z[5] = bfhi(a.z); z[6] = bflo(a.w); z[7] = bfhi(a.w);
            bgv[0] = bflo(g.x); bgv[1] = bfhi(g.x); bgv[2] = bflo(g.y); bgv[3] = bfhi(g.y); bgv[4] = bflo(g.z); bgv[5] = bfhi(g.z); bgv[6] = bflo(g.w); bgv[7] = bfhi(g.w);
#pragma unroll
            for (int i = 0; i < 8; ++i) { y[i] = bgv[i] * (cb[i] + w0[i] * zm2[i] + w1[i] * zm1[i] + w2[i] * z[i]); zm2[i] = zm1[i]; zm1[i] = z[i]; }
            u32x4 ov; ov.x = pk2(y[0], y[1]); ov.y = pk2(y[2], y[3]); ov.z = pk2(y[4], y[5]); ov.w = pk2(y[6], y[7]);
            *(u32x4*)(OUT + o) = ov;
        }
    }
}

namespace att {
constexpr int STAGE = 32768;
constexpr int XCH_OFF = 65536;
__device__ __forceinline__ int crow(int r, int hi) { return (r & 3) + 8 * (r >> 2) + 4 * hi; }
__device__ __forceinline__ s16x4 vtr(const LAS unsigned char* p) { return __builtin_bit_cast(s16x4, __builtin_amdgcn_ds_read_tr16_b64_v4i16((LAS s16x4*)p)); }

__device__ __forceinline__ void attn_unit(int b, int h, int qblk, const bf16_t* Q, const bf16_t* Kg, const bf16_t* Vg, bf16_t* O, const float* subln_g, float lam,
                                          LAS unsigned char* lds, int tid) {
    const int lane = tid & 63, wid = __builtin_amdgcn_readfirstlane(tid >> 6), rg = wid >> 1, c = wid & 1, r = lane & 31, hh = lane >> 5;
    const size_t seq0 = (size_t)b * SEQ;
    const int qs = qblk * 128 + rg * 32;
    bf16x8 qf[4];
    { const bf16_t* qp = Q + (seq0 + qs + r) * 1024 + h * 128 + c * 64 + 8 * hh;
#pragma unroll
      for (int ks = 0; ks < 4; ++ks) qf[ks] = *(const bf16x8*)(qp + 16 * ks); }
    const int kkey = tid >> 3, kch = tid & 7;
    const unsigned kdst = (unsigned)(kkey * 128 + ((kch ^ ((kkey >> 1) & 7)) * 16));
    const int v0key = tid >> 4, vch = tid & 15;
    const unsigned vdst0 = (unsigned)(v0key * 256 + (((vch >> 2) ^ (v0key & 3)) * 64) + (vch & 3) * 16);
    const unsigned vdst1 = vdst0 + 32 * 256;
    const bf16_t* kbase = Kg + seq0 * 1024 + h * 128 + kch * 8;
    const bf16_t* vbase = Vg + seq0 * 1024 + h * 128 + vch * 8;
    const int kswz = (r >> 1) & 7;
    unsigned koff[4];
#pragma unroll
    for (int ks = 0; ks < 4; ++ks) koff[ks] = (unsigned)(c * 8192 + r * 128 + (((ks * 2 + hh) ^ kswz) * 16));
    const int i16 = lane & 15, vq = i16 >> 2, vp = i16 & 3, g16 = (lane >> 4) & 1;
    unsigned voff[4];
#pragma unroll
    for (int dt = 0; dt < 4; ++dt) voff[dt] = (unsigned)(16384 + (4 * hh + vq) * 256 + ((dt ^ vq) * 64) + (16 * g16 + 4 * vp) * 2);

    f32x16 o[4];
#pragma unroll
    for (int dt = 0; dt < 4; ++dt)
#pragma unroll
        for (int i = 0; i < 16; ++i) o[dt][i] = 0.f;
    float mrun = 0.f, lrun = 0.f;
    f32x16 negm;
#pragma unroll
    for (int i = 0; i < 16; ++i) negm[i] = 0.f;
    const int nt = 2 * qblk + 2;
    const int jmax = (qs + 31) >> 6;

    u32x4 pk0, pk1, pv0, pv1;
    { const size_t ro = (size_t)kkey * 1024; pk0 = *(const u32x4*)(kbase + ro); pk1 = *(const u32x4*)(kbase + ro + 64);
      pv0 = *(const u32x4*)(vbase + (size_t)v0key * 1024); pv1 = *(const u32x4*)(vbase + (size_t)(v0key + 32) * 1024); }
    *(LAS u32x4*)(lds + kdst) = pk0; *(LAS u32x4*)(lds + 8192 + kdst) = pk1; *(LAS u32x4*)(lds + 16384 + vdst0) = pv0; *(LAS u32x4*)(lds + 16384 + vdst1) = pv1;
    __syncthreads();
    __builtin_amdgcn_s_waitcnt(0x0F70);
    for (int j = 0; j < nt; ++j) {
        const LAS unsigned char* st = lds + (j & 1) * STAGE;
        if (j + 1 < nt) { const size_t ro = (size_t)((j + 1) * 64 + kkey) * 1024; pk0 = *(const u32x4*)(kbase + ro); pk1 = *(const u32x4*)(kbase + ro + 64);
            pv0 = *(const u32x4*)(vbase + (size_t)((j + 1) * 64 + v0key) * 1024); pv1 = *(const u32x4*)(vbase + (size_t)((j + 1) * 64 + v0key + 32) * 1024); }
        if (j <= jmax) {
#pragma unroll 1
            for (int kk = 0; kk < 2; ++kk) {
                f32x16 sv;
                { const bf16x8 ka = *(const LAS bf16x8*)(st + koff[0] + kk * 4096); sv = __builtin_amdgcn_mfma_f32_32x32x16_bf16(ka, qf[0], negm, 0, 0, 0); }
#pragma unroll
                for (int ks = 1; ks < 4; ++ks) { const bf16x8 ka = *(const LAS bf16x8*)(st + koff[ks] + kk * 4096); sv = __builtin_amdgcn_mfma_f32_32x32x16_bf16(ka, qf[ks], sv, 0, 0, 0); }
                s16x4 vlo[2][2], vhi[2][2];
#pragma unroll
                for (int dt = 0; dt < 2; ++dt)
#pragma unroll
                    for (int s2 = 0; s2 < 2; ++s2) { const int ks = 2 * kk + s2; vlo[dt][s2] = vtr(st + voff[dt] + ks * 16 * 256); vhi[dt][s2] = vtr(st + voff[dt] + ks * 16 * 256 + 8 * 256); }
                if (j * 64 + 63 > qs) {
                    const int qrel = qs + r - j * 64 - kk * 32;
#pragma unroll
                    for (int i = 0; i < 16; ++i) if (crow(i, hh) > qrel) sv[i] = -INFINITY;
                }
                float m4[4];
#pragma unroll
                for (int i = 0; i < 4; ++i) m4[i] = fmaxf(fmaxf(sv[i], sv[4 + i]), fmaxf(sv[8 + i], sv[12 + i]));
                float mx = fmaxf(fmaxf(m4[0], m4[1]), fmaxf(m4[2], m4[3]));
                { const auto sw = __builtin_amdgcn_permlane32_swap(__float_as_uint(mx), __float_as_uint(mx), false, false); mx = fmaxf(__uint_as_float(sw[0]), __uint_as_float(sw[1])); }
                const bool first = (j == 0) && (kk == 0);
                if (first || __any(mx > 8.0f)) {
                    const float delta = first ? mx : fmaxf(mx, 0.f);
                    const float al = first ? 0.f : __builtin_amdgcn_exp2f(-delta);
                    mrun += delta; lrun *= al;
#pragma unroll
                    for (int i = 0; i < 16; ++i) { negm[i] = -mrun; sv[i] -= delta; }
#pragma unroll
                    for (int dt = 0; dt < 4; ++dt)
#pragma unroll
                        for (int i = 0; i < 16; ++i) o[dt][i] *= al;
                }
#pragma unroll
                for (int i = 0; i < 16; ++i) sv[i] = __builtin_amdgcn_exp2f(sv[i]);
                { float p4[4];
#pragma unroll
                  for (int i = 0; i < 4; ++i) p4[i] = (sv[i] + sv[4 + i]) + (sv[8 + i] + sv[12 + i]);
                  lrun += (p4[0] + p4[1]) + (p4[2] + p4[3]); }
                bf16x8 pf[2];
#pragma unroll
                for (int s2 = 0; s2 < 2; ++s2) { u32x4 w;
                    w.x = pg8::cvt_pk_bf16(sv[8 * s2 + 0], sv[8 * s2 + 1]); w.y = pg8::cvt_pk_bf16(sv[8 * s2 + 2], sv[8 * s2 + 3]); w.z = pg8::cvt_pk_bf16(sv[8 * s2 + 4], sv[8 * s2 + 5]); w.w = pg8::cvt_pk_bf16(sv[8 * s2 + 6], sv[8 * s2 + 7]);
                    pf[s2] = __builtin_bit_cast(bf16x8, w); }
#pragma unroll
                for (int dt = 0; dt < 2; ++dt)
#pragma unroll
                    for (int s2 = 0; s2 < 2; ++s2) {
                        const bf16x8 va = (bf16x8){vlo[dt][s2][0], vlo[dt][s2][1], vlo[dt][s2][2], vlo[dt][s2][3], vhi[dt][s2][0], vhi[dt][s2][1], vhi[dt][s2][2], vhi[dt][s2][3]};
                        o[dt] = __builtin_amdgcn_mfma_f32_32x32x16_bf16(va, pf[s2], o[dt], 0, 0, 0); }
#pragma unroll
                for (int dt = 2; dt < 4; ++dt)
#pragma unroll
                    for (int s2 = 0; s2 < 2; ++s2) { const int ks = 2 * kk + s2;
                        const s16x4 lo = vtr(st + voff[dt] + ks * 16 * 256), hi = vtr(st + voff[dt] + ks * 16 * 256 + 8 * 256);
                        const bf16x8 va = (bf16x8){lo[0], lo[1], lo[2], lo[3], hi[0], hi[1], hi[2], hi[3]};
                        o[dt] = __builtin_amdgcn_mfma_f32_32x32x16_bf16(va, pf[s2], o[dt], 0, 0, 0); }
            }
        }
        if (j + 1 < nt) { LAS unsigned char* sn = lds + ((j + 1) & 1) * STAGE;
            *(LAS u32x4*)(sn + kdst) = pk0; *(LAS u32x4*)(sn + 8192 + kdst) = pk1; *(LAS u32x4*)(sn + 16384 + vdst0) = pv0; *(LAS u32x4*)(sn + 16384 + vdst1) = pv1; }
        __syncthreads();
    }
    const float ltot = lrun + __shfl_xor(lrun, 32);
    const float inv = (c == 0 ? 1.0f : lam) / ltot;
    LAS float* xch = (LAS float*)(lds + XCH_OFF) + rg * 4096 + lane;
    if (c == 1) {
#pragma unroll
        for (int dt = 0; dt < 4; ++dt)
#pragma unroll
            for (int i = 0; i < 16; ++i) xch[(dt * 16 + i) * 64] = o[dt][i] * inv;
    }
    __syncthreads();
    if (c == 0) {
        float ss = 0.f;
#pragma unroll
        for (int dt = 0; dt < 4; ++dt)
#pragma unroll
            for (int i = 0; i < 16; ++i) { const float v = o[dt][i] * inv - xch[(dt * 16 + i) * 64]; o[dt][i] = v; ss += v * v; }
        ss += __shfl_xor(ss, 32);
        const float rs = (1.0f - LAM_INIT) / sqrtf(ss * (1.0f / 128.0f) + LN_EPS);
        bf16_t* op = O + (seq0 + qs + r) * 1024 + h * 128 + 4 * hh;
#pragma unroll
        for (int dt = 0; dt < 4; ++dt)
#pragma unroll
            for (int g = 0; g < 4; ++g) { const int e = dt * 32 + 8 * g;
                const f32x4 gv = *(const f32x4*)(subln_g + e + 4 * hh);
                u32x2 w; w.x = pg8::cvt_pk_bf16(o[dt][4 * g] * rs * gv[0], o[dt][4 * g + 1] * rs * gv[1]); w.y = pg8::cvt_pk_bf16(o[dt][4 * g + 2] * rs * gv[2], o[dt][4 * g + 3] * rs * gv[3]);
                *(u32x2*)(op + e) = w; }
    }
    __syncthreads();
}
}

__device__ __forceinline__ void ln1_phase(const float* X, float* XO, bf16_t* XB, const float* g, const float* bta, int gw, int ngw, int lane) {
    f32x4 gv[4], bv[4];
#pragma unroll
    for (int j = 0; j < 4; ++j) { gv[j] = *(const f32x4*)(g + 4 * lane + 256 * j); bv[j] = *(const f32x4*)(bta + 4 * lane + 256 * j); }
    for (int m = gw; m < T; m += ngw) {
        const f32x4* xr = (const f32x4*)(X + (size_t)m * D) + lane; f32x4* xo = (f32x4*)(XO + (size_t)m * D) + lane;
        f32x4 v[4]; float s = 0.f;
#pragma unroll
        for (int j = 0; j < 4; ++j) { v[j] = xr[64 * j]; s += (v[j][0] + v[j][1]) + (v[j][2] + v[j][3]); }
        const float mean = wave_sum(s) * (1.f / D); float s2 = 0.f;
#pragma unroll
        for (int j = 0; j < 4; ++j) { v[j] = v[j] - mean; s2 += (v[j][0] * v[j][0] + v[j][1] * v[j][1]) + (v[j][2] * v[j][2] + v[j][3] * v[j][3]); }
        const float rstd = 1.f / sqrtf(wave_sum(s2) * (1.f / D) + LN_EPS);
        u32x2* o8 = (u32x2*)(XB + (size_t)m * D) + lane;
#pragma unroll
        for (int j = 0; j < 4; ++j) { const f32x4 y = v[j] * rstd * gv[j] + bv[j]; xo[64 * j] = y; u32x2 w; w.x = pk2(y[0], y[1]); w.y = pk2(y[2], y[3]); o8[64 * j] = w; }
    }
}

namespace peer {
template <int NV>
__device__ __forceinline__ void top16(const float (&v)[NV], LAS float* oval, LAS int* oidx, int lane) {
    float lmx = v[0], lmn = v[0];
#pragma unroll
    for (int q = 1; q < NV; ++q) { lmx = fmaxf(lmx, v[q]); lmn = fminf(lmn, v[q]); }
    float hi = wave_max(lmx), lo = wave_min(lmn);
    lo = lo - fabsf(lo) * 1e-6f - 1e-30f;
    float thr = hi; int need_ties = 1;
    for (int it = 0; it < 64; ++it) {
        const float mid = 0.5f * (lo + hi);
        if (!(mid > lo && mid < hi)) break;
        int cnt = 0;
#pragma unroll
        for (int q = 0; q < NV; ++q) cnt += __popcll(__ballot(v[q] > mid));
        if (cnt == 16) { thr = mid; need_ties = 0; break; }
        if (cnt > 16) lo = mid; else hi = mid;
    }
    const float tie_hi = hi;
    int base = 0;
    if (!need_ties) {
#pragma unroll
        for (int q = 0; q < NV; ++q) { const bool sel = v[q] > thr; const unsigned long long bm = __ballot(sel);
            const int pos = base + (int)__builtin_amdgcn_mbcnt_hi((unsigned)(bm >> 32), __builtin_amdgcn_mbcnt_lo((unsigned)bm, 0u));
            if (sel) { oval[pos] = v[q]; oidx[pos] = lane + 64 * q; }
            base += __popcll(bm); }
    } else {
#pragma unroll
        for (int q = 0; q < NV; ++q) { const bool sel = v[q] > tie_hi; const unsigned long long bm = __ballot(sel);
            const int pos = base + (int)__builtin_amdgcn_mbcnt_hi((unsigned)(bm >> 32), __builtin_amdgcn_mbcnt_lo((unsigned)bm, 0u));
            if (sel && pos < 16) { oval[pos] = v[q]; oidx[pos] = lane + 64 * q; }
            base += __popcll(bm); }
#pragma unroll
        for (int q = 0; q < NV; ++q) { const bool sel = (v[q] <= tie_hi) && (v[q] > lo); const unsigned long long bm = __ballot(sel);
            const int pos = base + (int)__builtin_amdgcn_mbcnt_hi((unsigned)(bm >> 32), __builtin_amdgcn_mbcnt_lo((unsigned)bm, 0u));
            if (sel && pos < 16) { oval[pos] = v[q]; oidx[pos] = lane + 64 * q; }
            base += __popcll(bm); }
    }
    LDS_WAIT();
}

__device__ __forceinline__ void retrieve(int t, const float* SC, LAS unsigned char* scr, LAS int* EI, LAS float* GW, int lane) {
    LAS float* s1v = (LAS float*)scr; LAS int* s1i = (LAS int*)(scr + 64); LAS float* s2v = (LAS float*)(scr + 128); LAS int* s2i = (LAS int*)(scr + 192);
    LAS float* cv = (LAS float*)(scr + 256); LAS int* ci = (LAS int*)(scr + 320);
    const float* sc = SC + (size_t)t * 2048;
#pragma unroll 1
    for (int h = 0; h < NHEAD; ++h) {
        float a[2], bq[2];
        a[0] = sc[h * 256 + lane]; a[1] = sc[h * 256 + 64 + lane]; bq[0] = sc[h * 256 + 128 + lane]; bq[1] = sc[h * 256 + 192 + lane];
        top16<2>(a, s1v, s1i, lane);
        top16<2>(bq, s2v, s2i, lane);
        float cand[4];
#pragma unroll
        for (int q = 0; q < 4; ++q) { const int idx = lane + 64 * q; cand[q] = s1v[idx >> 4] + s2v[idx & 15]; }
        top16<4>(cand, cv, ci, lane);
        {
            const float v = cv[lane & 15]; const int code = ci[lane & 15];
            float mx = v;
#pragma unroll
            for (int o = 1; o < 16; o <<= 1) mx = fmaxf(mx, __shfl_xor(mx, o));
            const float ex = __expf(v - mx); float sm = ex;
#pragma unroll
            for (int o = 1; o < 16; o <<= 1) sm += __shfl_xor(sm, o);
            const int k = h * 16 + lane, p = (k & 7) * 16 + (k >> 3);
            if (lane < 16) { GW[p] = ex / sm; EI[p] = s1i[code >> 4] * 128 + s2i[code & 15]; }
        }
        LDS_WAIT();
    }
}

__device__ __forceinline__ int okey(float f) { const int b = __float_as_int(f); return b ^ ((b >> 31) & 0x7fffffff); }
__device__ __forceinline__ float okey_inv(int k) { return __int_as_float(k ^ ((k >> 31) & 0x7fffffff)); }
__device__ __forceinline__ int med3i(int a, int b, int c) { int r; asm("v_med3_i32 %0, %1, %2, %3" : "=v"(r) : "v"(a), "v"(b), "v"(c)); return r; }
__device__ __forceinline__ void ins16(int (&t)[16], int x) {
#pragma unroll
    for (int i = 15; i >= 1; --i) t[i] = med3i(t[i], t[i - 1], x);
    t[0] = max(t[0], x);
}
__device__ __forceinline__ void retrieve4(int t0, int jb, const float* SC, LAS int* IDX, LAS int* EI, LAS float* GW, int lane) {
    const int tl = lane >> 4, h = (lane >> 1) & 7, cc = lane & 1;
    const f32x4* lp = (const f32x4*)(SC + (size_t)(t0 + tl) * 2048 + (h * 2 + cc) * 128);
    int t[16];
#pragma unroll
    for (int i = 0; i < 16; ++i) t[i] = (int)0x80000000;
#pragma unroll 2
    for (int q4 = 0; q4 < 32; q4 += 4) {
        f32x4 v[4];
#pragma unroll
        for (int q = 0; q < 4; ++q) v[q] = lp[q4 + q];
#pragma unroll
        for (int q = 0; q < 4; ++q)
#pragma unroll
            for (int e = 0; e < 4; ++e) ins16(t, (okey(v[q][e]) & ~127) | (127 - (4 * (q4 + q) + e)));
    }
    float val[16], pv[16];
    { u32x4 w;
#pragma unroll
      for (int q = 0; q < 4; ++q) {
#pragma unroll
          for (int e = 0; e < 4; ++e) { val[4 * q + e] = okey_inv(t[4 * q + e] & ~127); w[e] = (unsigned)(127 - (t[4 * q + e] & 127)); }
          *(LAS u32x4*)(IDX + lane * 16 + 4 * q) = w; } }
#pragma unroll
    for (int i = 0; i < 16; ++i) pv[i] = __shfl_xor(val[i], 1);
    float s1v[16], s2v[16];
#pragma unroll
    for (int i = 0; i < 16; ++i) { s1v[i] = cc ? pv[i] : val[i]; s2v[i] = cc ? val[i] : pv[i]; }
    int ct[16];
#pragma unroll
    for (int i = 0; i < 16; ++i) ct[i] = (int)0x80000000;
#pragma unroll
    for (int i = 0; i < 16; ++i)
#pragma unroll
        for (int j = 0; j < 16; ++j)
            if ((i + 1) * (j + 1) <= 16) ins16(ct, (okey(s1v[i] + s2v[j]) & ~255) | (255 - (i * 16 + j)));
    float ev[16]; float sm = 0.f; const float v0 = okey_inv(ct[0] & ~255);
#pragma unroll
    for (int r = 0; r < 16; ++r) { ev[r] = __expf(okey_inv(ct[r] & ~255) - v0); sm += ev[r]; }
    const float inv = 1.0f / sm;
    LDS_WAIT();
#pragma unroll
    for (int rr = 0; rr < 8; ++rr) {
        int ka = ct[rr], kb = ct[8 + rr]; float ga = ev[rr], gb = ev[8 + rr];
        asm volatile("" : "+v"(ka), "+v"(kb), "+v"(ga), "+v"(gb));
        const int key = cc ? kb : ka; const float gg = (cc ? gb : ga) * inv;
        const int code = 255 - (key & 255), i1 = IDX[(lane & ~1) * 16 + (code >> 4)], i2 = IDX[(lane | 1) * 16 + (code & 15)];
        const int k = h * 16 + 8 * cc + rr, p = (k & 7) * 16 + (k >> 3);
        EI[(jb + tl) * 128 + p] = i1 * 128 + i2; GW[(jb + tl) * 128 + p] = gg;
    }
    LDS_WAIT();
}

constexpr int TOK = 8;
constexpr int WAVE_LDS = 12288;
__device__ __forceinline__ void wave_tokens(int t0, const float* SC, float* X  , const unsigned char* UB, const unsigned char* VB, const float* USC, const float* VSC,
                                            const float* ln_g, const float* ln_b, LAS unsigned char* wl, int lane) {
    LAS int* EI = (LAS int*)wl; LAS float* GW = (LAS float*)(wl + 4096); LAS float* PD = (LAS float*)(wl + 8192);
    for (int rp = (PROBE_SUB == 1 ? 0 : 1); rp < 2; ++rp)
#pragma unroll 1
    for (int jb = 0; jb < TOK; jb += 4) retrieve4(t0 + jb, jb, SC, (LAS int*)(wl + 8192), EI, GW, lane);
    const int g = lane >> 3, c = lane & 7;
    const int b0 = lane & 1, b1 = (lane >> 1) & 1, b2 = (lane >> 2) & 1, b3 = (lane >> 3) & 1, b4 = (lane >> 4) & 1, b5 = (lane >> 5) & 1;
    for (int rp = (PROBE_SUB == 2 ? 0 : 1); rp < 2; ++rp) {
    LDS_WAIT();
    for (int i = lane; i < TOK * 128; i += 64) PD[i] = 0.f;
    LDS_WAIT();
#pragma unroll 1
    for (int s = 0; s < 8; ++s) {
#pragma unroll 1
        for (int j = 0; j < TOK; ++j) {
            f32x2 xs2[8];
            { const f32x4* xp = (const f32x4*)(X + (size_t)(t0 + j) * D + 128 * s + 16 * c);
#pragma unroll
              for (int q = 0; q < 4; ++q) { const f32x4 v = xp[q]; xs2[2 * q] = (f32x2){v[0], v[1]}; xs2[2 * q + 1] = (f32x2){v[2], v[3]}; } }
            int ex[16];
#pragma unroll
            for (int q = 0; q < 4; ++q) { const u32x4 v = *(const LAS u32x4*)(EI + j * 128 + g * 16 + 4 * q); ex[4 * q] = (int)v[0]; ex[4 * q + 1] = (int)v[1]; ex[4 * q + 2] = (int)v[2]; ex[4 * q + 3] = (int)v[3]; }
            float sm[16];
#pragma unroll
            for (int hb = 0; hb < 2; ++hb) {
                u32x4 ra[8];
#pragma unroll
                for (int i = 0; i < 8; ++i) ra[i] = *(const u32x4*)(UB + (((unsigned)s * NEXP + (unsigned)ex[8 * hb + i]) * 128u + 16u * (unsigned)c));
#pragma unroll
                for (int i = 0; i < 8; ++i) {
                    f32x2 da = {0.f, 0.f}, db = {0.f, 0.f};
#pragma unroll
                    for (int q = 0; q < 4; ++q) { const f32x2 lo = __builtin_amdgcn_cvt_pk_f32_fp8((int)ra[i][q], false), hi = __builtin_amdgcn_cvt_pk_f32_fp8((int)ra[i][q], true);
                        da += xs2[2 * q] * lo; db += xs2[2 * q + 1] * hi; }
                    da += db; sm[8 * hb + i] = da[0] + da[1]; }
                __builtin_amdgcn_sched_barrier(0);
            }
            float r8[8], r4[4], r2[2];
#pragma unroll
            for (int i = 0; i < 8; ++i) { const float mine = b2 ? sm[8 + i] : sm[i], oth = b2 ? sm[i] : sm[8 + i]; r8[i] = mine + __shfl_xor(oth, 4); }
#pragma unroll
            for (int i = 0; i < 4; ++i) { const float mine = b1 ? r8[4 + i] : r8[i], oth = b1 ? r8[i] : r8[4 + i]; r4[i] = mine + __shfl_xor(oth, 2); }
#pragma unroll
            for (int i = 0; i < 2; ++i) { const float mine = b0 ? r4[2 + i] : r4[i], oth = b0 ? r4[i] : r4[2 + i]; r2[i] = mine + __shfl_xor(oth, 1); }
            LAS float* pd = PD + j * 128 + 16 * c + g;
            pd[0] += r2[0]; pd[8] += r2[1];
        }
    }
    }
    LDS_WAIT();
#pragma unroll 1
    for (int j = 0; j < TOK; ++j) {
#pragma unroll
        for (int q = 0; q < 2; ++q) { const int k = lane + 64 * q, p = (k & 7) * 16 + (k >> 3); const int ei = EI[j * 128 + p];
            const float dot = PD[j * 128 + k] * USC[ei];
            const float act = 0.5f * dot * (1.0f + erff(dot * 0.70710678118654752f));
            GW[j * 128 + p] *= act * VSC[ei]; }
    }
    LDS_WAIT();
#pragma unroll 1
    for (int s = 0; s < 8; ++s) {
#pragma unroll 1
        for (int j = 0; j < TOK; ++j) {
            int ex[16]; float wk[16];
#pragma unroll
            for (int q = 0; q < 4; ++q) { const u32x4 v = *(const LAS u32x4*)(EI + j * 128 + g * 16 + 4 * q); ex[4 * q] = (int)v[0]; ex[4 * q + 1] = (int)v[1]; ex[4 * q + 2] = (int)v[2]; ex[4 * q + 3] = (int)v[3];
                const f32x4 w = *(const LAS f32x4*)(GW + j * 128 + g * 16 + 4 * q); wk[4 * q] = w[0]; wk[4 * q + 1] = w[1]; wk[4 * q + 2] = w[2]; wk[4 * q + 3] = w[3]; }
            float acc[16];
#pragma unroll
            for (int q = 0; q < 16; ++q) acc[q] = 0.f;
#pragma unroll
            for (int hb = 0; hb < 2; ++hb) {
                u32x4 ra[8];
#pragma unroll
                for (int i = 0; i < 8; ++i) ra[i] = *(const u32x4*)(VB + (((unsigned)s * NEXP + (unsigned)ex[8 * hb + i]) * 128u + 16u * (unsigned)c));
#pragma unroll
                for (int i = 0; i < 8; ++i) { float f[16]; unpack16_fp8(ra[i], f);
#pragma unroll
                    for (int q = 0; q < 16; ++q) acc[q] += wk[8 * hb + i] * f[q]; }
                __builtin_amdgcn_sched_barrier(0);
            }
            float r8[8], r4[4], r2[2];
#pragma unroll
            for (int i = 0; i < 8; ++i) { const float mine = b5 ? acc[8 + i] : acc[i], oth = b5 ? acc[i] : acc[8 + i]; r8[i] = mine + __shfl_xor(oth, 32); }
#pragma unroll
            for (int i = 0; i < 4; ++i) { const float mine = b4 ? r8[4 + i] : r8[i], oth = b4 ? r8[i] : r8[4 + i]; r4[i] = mine + __shfl_xor(oth, 16); }
#pragma unroll
            for (int i = 0; i < 2; ++i) { const float mine = b3 ? r4[2 + i] : r4[i], oth = b3 ? r4[i] : r4[2 + i]; r2[i] = mine + __shfl_xor(oth, 8); }
            f32x2* xp = (f32x2*)(X + (size_t)(t0 + j) * D + 128 * s + 16 * c + 2 * g);
            const f32x2 xv = *xp; f32x2 o; o[0] = ALPHA * xv[0] + r2[0]; o[1] = ALPHA * xv[1] + r2[1];
            *xp = o;
        }
    }
    asm volatile("s_waitcnt vmcnt(0)" ::: "memory");
#pragma unroll 1
    for (int j = 0; j < TOK; ++j) {
        f32x4* xp = (f32x4*)(X + (size_t)(t0 + j) * D) + 4 * lane;
        f32x4 v[4]; float sum = 0.f;
#pragma unroll
        for (int q = 0; q < 4; ++q) { v[q] = xp[q]; sum += (v[q][0] + v[q][1]) + (v[q][2] + v[q][3]); }
        const float mean = wave_sum(sum) * (1.f / D); float s2 = 0.f;
#pragma unroll
        for (int q = 0; q < 4; ++q) { v[q] = v[q] - mean; s2 += (v[q][0] * v[q][0] + v[q][1] * v[q][1]) + (v[q][2] * v[q][2] + v[q][3] * v[q][3]); }
        const float rstd = 1.f / sqrtf(wave_sum(s2) * (1.f / D) + LN_EPS);
        const f32x4* gp = (const f32x4*)ln_g + 4 * lane; const f32x4* bp = (const f32x4*)ln_b + 4 * lane;
#pragma unroll
        for (int q = 0; q < 4; ++q) xp[q] = v[q] * rstd * gp[q] + bp[q];
    }
}
}

#define GAS __attribute__((address_space(1)))
typedef GAS unsigned gu32;
#define XB_TMO      128
#define XB_XCNT(j)  (256  + 64 * (j))
#define XB_XSUB(j)  (1280 + 64 * (j))
#define XB_XGEN(j)  (2304 + 64 * (j))
#define XB_TOP      3328
#define XB_TOPGEN   3392
#define XCD_BAR_WORDS 3456
#define XB_SPIN_CAP (1u << 18)

__device__ __forceinline__ unsigned xb_ld(unsigned* p)              { return __hip_atomic_load(p, __ATOMIC_RELAXED, __HIP_MEMORY_SCOPE_AGENT); }
__device__ __forceinline__ unsigned xb_add(unsigned* p, unsigned v) { return __hip_atomic_fetch_add(p, v, __ATOMIC_RELAXED, __HIP_MEMORY_SCOPE_AGENT); }
__device__ __forceinline__ unsigned xb_xcc_id() { return (unsigned)__builtin_amdgcn_s_getreg((3 << 11) | 20) & 0xFu; }
#define XB_SPIN(cond, bar) do { unsigned _sp = 0; while (cond) { __builtin_amdgcn_s_sleep(1); \
    if ((++_sp & 255u) == 0u) { if (xb_ld(&(bar)[XB_TMO])) break; if (_sp > XB_SPIN_CAP) { atomicAdd(&(bar)[XB_TMO], 1u); break; } } } } while (0)

struct XcdBarrier {
    unsigned* bar; unsigned x;
    volatile LAS unsigned* st;
};

__device__ __forceinline__ XcdBarrier xcd_barrier_post(unsigned* bar, volatile LAS unsigned* st) {
    XcdBarrier b; b.bar = bar; b.x = xb_xcc_id(); b.st = st;
    if (threadIdx.x == 0) (void)xb_add(&bar[XB_XCNT(b.x)], 1u);
    return b;
}
__device__ __forceinline__ void xcd_barrier_complete(unsigned* bar, unsigned x, unsigned& nloc, unsigned& nx) {
    const unsigned G = gridDim.x * gridDim.y * gridDim.z;
    unsigned sum, cnt, mine, sp = 0u;
    for (;;) {
        sum = 0u; cnt = 0u; mine = 0u;
#pragma unroll
        for (unsigned j = 0; j < 16; ++j) { const unsigned c = xb_ld(&bar[XB_XCNT(j)]); sum += c; cnt += (c > 0u) ? 1u : 0u; mine = (j == x) ? c : mine; }
        if (sum == G) break;
        __builtin_amdgcn_s_sleep(1);
        if ((++sp & 255u) == 0u) { if (xb_ld(&bar[XB_TMO])) break; if (sp > XB_SPIN_CAP) { atomicAdd(&bar[XB_TMO], 1u); break; } }
    }
    nloc = mine > 0u ? mine : 1u; nx = cnt > 0u ? cnt : 1u;
}

__device__ __forceinline__ void xcd_barrier(const XcdBarrier& b) {
    asm volatile("s_waitcnt vmcnt(0)" ::: "memory");
    __syncthreads();
    if (threadIdx.x == 0) {
        unsigned* bar = b.bar;
        __builtin_amdgcn_s_waitcnt(0);
        unsigned nloc = b.st[0], nx = b.st[1];
        if (nloc == 0u) { xcd_barrier_complete(bar, b.x, nloc, nx); b.st[0] = nloc; b.st[1] = nx; }
        const unsigned old = xb_add(&bar[XB_XSUB(b.x)], 1u);
        const unsigned gen = old / nloc;
        if (old + 1u == (gen + 1u) * nloc) {
            __builtin_amdgcn_fence(__ATOMIC_RELEASE, "agent");
            asm volatile("s_waitcnt vmcnt(0)" ::: "memory");
            const unsigned og = xb_add(&bar[XB_TOP], 1u);
            const unsigned tg = og / nx;
            if (og + 1u == (tg + 1u) * nx) xb_add(&bar[XB_TOPGEN], 1u);
            else XB_SPIN(xb_ld(&bar[XB_TOPGEN]) == tg, bar);
            __builtin_amdgcn_fence(__ATOMIC_ACQUIRE, "agent");
            xb_add(&bar[XB_XGEN(b.x)], 1u);
            asm volatile("s_waitcnt vmcnt(0)" ::: "memory");
        } else {
            XB_SPIN(xb_ld(&bar[XB_XGEN(b.x)]) == gen, bar);
            __builtin_amdgcn_fence(__ATOMIC_ACQUIRE, "agent");
            asm volatile("s_waitcnt vmcnt(0)" ::: "memory");
        }
    }
    __syncthreads();
}

struct Args {
    const float *x; const int* positions; const float *w_in, *conv_w, *conv_b, *gate_b, *lq1, *lk1, *lq2, *lk2, *subln_g, *w_conv_out, *w_attn_out, *w_o, *ln1_g, *ln1_b, *w_pq, *sub_keys, *u_tab, *v_tab, *ln2_g, *ln2_b;
    float* out; unsigned char* ws; int ph_lo, ph_hi;
};

__global__ void __launch_bounds__(NTHREADS, 2) fwd_kernel(Args a) {
    extern __shared__ __attribute__((aligned(16))) unsigned char lds_raw[];
    LAS unsigned char* lds = (LAS unsigned char*)lds_raw;
    const int G = gridDim.x, bx = blockIdx.x, ngw = G * NWAVES, gthreads = G * NTHREADS;
#define PH_IDS int tid = threadIdx.x; asm volatile("" : "+v"(tid)); const int lane = tid & 63, wave = __builtin_amdgcn_readfirstlane(tid >> 6), gw = bx * NWAVES + wave, gtid = bx * NTHREADS + tid; (void)lane; (void)gw; (void)gtid
    unsigned char* ws = a.ws;
    bf16_t* Wt_in = (bf16_t*)(ws + WS_WIN); bf16_t* Wt_co = (bf16_t*)(ws + WS_WCO); bf16_t* Wt_ao = (bf16_t*)(ws + WS_WAO); bf16_t* Wt_o = (bf16_t*)(ws + WS_WO); bf16_t* Wt_sc = (bf16_t*)(ws + WS_WSC);
    float* CS = (float*)(ws + WS_CS); float* RS = (float*)(ws + WS_RS);
    bf16_t* XB = (bf16_t*)(ws + WS_XB); bf16_t* Zb = (bf16_t*)(ws + WS_Z); bf16_t* BG = (bf16_t*)(ws + WS_BG); bf16_t* Qb = (bf16_t*)(ws + WS_Q); bf16_t* Kb = (bf16_t*)(ws + WS_K); bf16_t* Vb = (bf16_t*)(ws + WS_V);
    bf16_t* Gb = (bf16_t*)a.out;
    unsigned char* UB = ws + WS_UB; unsigned char* VB = ws + WS_VB; float* USC = (float*)(ws + WS_USC); float* VSC = (float*)(ws + WS_VSC); bf16_t* T1 = (bf16_t*)(ws + WS_T1); bf16_t* MG = (bf16_t*)(ws + WS_MG);
    bf16_t* X1B = (bf16_t*)(ws + WS_X1B); float* SC = (float*)(ws + WS_SC);
    const int lo = a.ph_lo, hi = a.ph_hi;
    for (int u = threadIdx.x; u < (LDS_BYTES - LDSCTL_OFF) / 4; u += NTHREADS) ((LAS unsigned*)(lds + LDSCTL_OFF))[u] = 0u;
    __syncthreads();
    XcdBarrier bar; bar.bar = (unsigned*)(ws + WS_CTL) + CW_BAR; bar.x = 0; bar.st = nullptr;
    if (MK_N_LAUNCHES == 1) bar = xcd_barrier_post((unsigned*)(ws + WS_CTL) + CW_BAR, (volatile LAS unsigned*)(lds + MISC_OFF) + 8);
#define IN(k) (lo <= (k) && (k) < hi)
#define REPS(k) for (int rep = (PROBE_REP == (k) ? 0 : 1); rep < 2; ++rep)
#define SEAM(k) do { if (IN(k) && IN((k) + 1)) xcd_barrier(bar); } while (0)

    if (IN(0)) REPS(0) { PH_IDS;
        for (int it = bx; it < 256; it += G) wsc_item(a.w_pq, a.sub_keys, Wt_sc, lds, it, tid);
        LAS float* scr = (LAS float*)(lds + wave * 16384);
        constexpr int I_IN = (D / 64) * (NIN / 32), I_SQ = (D / 64) * (D / 32);
        for (int it = gw; it < I_IN + 3 * I_SQ; it += ngw) {
            int r = it;
            if (r < I_IN) { transpose_item_f8<true>(a.w_in, D, NIN, (unsigned char*)Wt_in, scr, r, lane, W_IN_SCALE); continue; } r -= I_IN;
            if (r < I_SQ) { transpose_item<false>(a.w_conv_out, D, D, Wt_co, scr, r, lane); continue; } r -= I_SQ;
            if (r < I_SQ) { transpose_item<false>(a.w_attn_out, D, D, Wt_ao, scr, r, lane); continue; } r -= I_SQ;
            transpose_item<false>(a.w_o, D, D, Wt_o, scr, r, lane);
        }
        cvt_fp8_rows_plain(a.x, (unsigned char*)XB, RS, 1.0f / W_IN_SCALE, T, gw, ngw, lane);
        for (int i = gtid; i < T * 8; i += gthreads) { const int t = i >> 3, f = i & 7;
            const float inv_freq = powf(500000.0f, -(float)f * 0.125f); const float ang = (float)a.positions[t] * inv_freq;
            CS[t * 16 + f] = cosf(ang); CS[t * 16 + 8 + f] = sinf(ang); }
    }
    SEAM(0);
    if (IN(1)) REPS(1) {
        pg8::Gemm g{XB, Wt_in, T, NIN, D}; pg8::StaticOrder S; S.init(T, NIN, G, bx);
        pg8::EpiProj E{Zb, BG, Qb, Kb, Vb, Gb, a.gate_b, CS, RS};
        pg8::gemm_phase_f8<pg8::EpiProj, pg8::StaticOrder, true, true>(lds, g, S, E);
    }
    SEAM(1);
    if (IN(2)) REPS(2) { PH_IDS;
        bf16_t* Oatt = rep ? Qb : (bf16_t*)(ws + 12 * MiB);
        if (PROBE_SUB == 4) conv_phase(Zb, BG, (bf16_t*)(ws + 28 * MiB), a.conv_w, a.conv_b, gtid, gthreads);
        conv_phase(Zb, BG, rep ? BG : (bf16_t*)(ws + 28 * MiB), a.conv_w, a.conv_b, gtid, gthreads);
        float lam;
        { const float p1 = wave_sum(a.lq1[lane] * a.lk1[lane]), p2 = wave_sum(a.lq2[lane] * a.lk2[lane]); lam = __expf(p1) - __expf(p2) + LAM_INIT; }
        const int vcu = (G % 8 == 0) ? (bx & 7) * (G >> 3) + (bx >> 3) : bx;
        for (int ra = ((PROBE_SUB == 3 || PROBE_SUB == 5) ? 0 : 1); ra < 2; ++ra)
        for (int it = vcu; it < 512; it += G) {
            const int bh = it >> 3, pq = it & 7, b = bh >> 3, h = bh & 7;
            if (PROBE_SUB == 3 || PROBE_SUB == 5) Oatt = ra ? Qb : (bf16_t*)(ws + 12 * MiB);
            att::attn_unit(b, h, 15 - pq, Qb, Kb, Vb, Oatt, a.subln_g, lam, lds, tid);
            att::attn_unit(b, h, pq, Qb, Kb, Vb, Oatt, a.subln_g, lam, lds, tid);
        }
    }
    SEAM(2);
    if (IN(3)) REPS(3) { PH_IDS;
        cvt_fp8_rows(a.u_tab, UB, USC, NEXP, gw, ngw, lane);
        cvt_fp8_rows(a.v_tab, VB, VSC, NEXP, gw, ngw, lane);
        pg8::Gemm g{BG, Wt_co, T, D, D}; pg8::StaticOrder S; S.init(T, D, G, bx);
        pg8::EpiGate1 E{Gb, T1};
        pg8::gemm_phase<pg8::EpiGate1, pg8::StaticOrder, true, true>(lds, g, S, E);
    }
    SEAM(3);
    if (IN(4)) REPS(4) {
        pg8::Gemm g{Qb, Wt_ao, T, D, D}; pg8::StaticOrder S; S.init(T, D, G, bx);
        pg8::EpiGate2 E{Gb, T1, MG};
        pg8::gemm_phase<pg8::EpiGate2, pg8::StaticOrder, true, true>(lds, g, S, E);
    }
    SEAM(4);
    if (IN(5)) REPS(5) {
        pg8::Gemm g{MG, Wt_o, T, D, D}; pg8::StaticOrder S; S.init(T, D, G, bx);
        pg8::EpiF32<true, 1024> E{a.x, a.out};
        pg8::gemm_phase<pg8::EpiF32<true, 1024>, pg8::StaticOrder, true, true>(lds, g, S, E);
    }
    SEAM(5);
    if (IN(6)) REPS(6) { PH_IDS; ln1_phase(a.out, rep ? a.out : (float*)(ws + 124 * MiB), X1B, a.ln1_g, a.ln1_b, gw, ngw, lane); }
    SEAM(6);
    if (IN(7)) REPS(7) {
        pg8::Gemm g{X1B, Wt_sc, T, 2048, D}; pg8::StaticOrder S; S.init(T, 2048, G, bx);
        pg8::EpiF32<false, 2048> E{nullptr, SC};
        pg8::gemm_phase<pg8::EpiF32<false, 2048>, pg8::StaticOrder, true, true>(lds, g, S, E);
    }
    SEAM(7);
    if (IN(8)) REPS(8) { PH_IDS;
        LAS unsigned char* wl = lds + wave * peer::WAVE_LDS;
        for (int t0 = gw * peer::TOK; t0 < T; t0 += ngw * peer::TOK) peer::wave_tokens(t0, SC, a.out, UB, VB, USC, VSC, a.ln2_g, a.ln2_b, wl, lane);
    }
#undef IN
#undef SEAM
}

extern "C" void kernel_launch(void* const* d_in, const int* in_sizes, int n_in, void* d_out, int out_size, void* d_ws, size_t ws_size, hipStream_t stream) {
    static int grid = 0;
    if (grid == 0) {
        if (n_in != 22 || out_size != T * D || ws_size < WS_END) { fprintf(stderr, "kernel_launch: unexpected shapes (n_in %d, out %d, ws %zu); nothing launched\n", n_in, out_size, ws_size); grid = -1; return; }
        int dev = 0, cus = 0, per_cu = 0;
        if (hipGetDevice(&dev) != hipSuccess || hipDeviceGetAttribute(&cus, hipDeviceAttributeMultiprocessorCount, dev) != hipSuccess) { grid = -1; return; }
        if (hipFuncSetAttribute((const void*)fwd_kernel, hipFuncAttributeMaxDynamicSharedMemorySize, LDS_BYTES) != hipSuccess) { fprintf(stderr, "kernel_launch: hipFuncSetAttribute failed\n"); grid = -1; return; }
        if (hipOccupancyMaxActiveBlocksPerMultiprocessor(&per_cu, (const void*)fwd_kernel, NTHREADS, LDS_BYTES) != hipSuccess || per_cu < 1) { fprintf(stderr, "kernel_launch: occupancy query failed (%d)\n", per_cu); (void)hipGetLastError(); per_cu = 1; }
        grid = cus * per_cu;
    }
    if (grid < 0) return;
    if (hipMemsetAsync((char*)d_ws + WS_CTL, 0, CTL_ZERO_BYTES, stream) != hipSuccess) { fprintf(stderr, "kernel_launch: hipMemsetAsync failed\n"); return; }
    Args a{};
    a.x = (const float*)d_in[0]; a.positions = (const int*)d_in[1]; a.w_in = (const float*)d_in[2]; a.conv_w = (const float*)d_in[3]; a.conv_b = (const float*)d_in[4]; a.gate_b = (const float*)d_in[5];
    a.lq1 = (const float*)d_in[6]; a.lk1 = (const float*)d_in[7]; a.lq2 = (const float*)d_in[8]; a.lk2 = (const float*)d_in[9]; a.subln_g = (const float*)d_in[10];
    a.w_conv_out = (const float*)d_in[11]; a.w_attn_out = (const float*)d_in[12]; a.w_o = (const float*)d_in[13]; a.ln1_g = (const float*)d_in[14]; a.ln1_b = (const float*)d_in[15];
    a.w_pq = (const float*)d_in[16]; a.sub_keys = (const float*)d_in[17]; a.u_tab = (const float*)d_in[18]; a.v_tab = (const float*)d_in[19]; a.ln2_g = (const float*)d_in[20]; a.ln2_b = (const float*)d_in[21];
    a.out = (float*)d_out; a.ws = (unsigned char*)d_ws;
#if MK_N_LAUNCHES == 1
    a.ph_lo = 0; a.ph_hi = NPHASES;
    void* args[] = {&a};
    hipError_t e = hipLaunchCooperativeKernel((const void*)fwd_kernel, dim3(grid), dim3(NTHREADS), args, LDS_BYTES, stream);
    if (e != hipSuccess) fprintf(stderr, "kernel_launch: cooperative launch failed: %s (grid %d)\n", hipGetErrorString(e), grid);
#else
    for (int p = 0; p < NPHASES; ++p) { a.ph_lo = p; a.ph_hi = p + 1; hipLaunchKernelGGL(fwd_kernel, dim3(grid), dim3(NTHREADS), LDS_BYTES, stream, a); }
#endif
}
```
